# Optimizing an MI355X kernel written in HIP

```python
import jax, jax.numpy as jnp
from jax import lax
import numpy as np

D_MODEL = 2048
BATCH = 1
SEQ = 16384
DEPTH = 1
DEC_BATCH = 8
DEC_SEQ = 64
PAST_LEN = 1024

CHUNK = 64
Q_BLOCK = 128
MIX_WIDTH = D_MODEL
N_ATTN_HEADS = 8
ATTN_HEAD_DIM = MIX_WIDTH // 2 // N_ATTN_HEADS
ROPE_DIM = ATTN_HEAD_DIM // 4
ROPE_THETA = 500000.0
N_IDX_HEADS = 16
IDX_DIM = 64
IDX_ROPE_DIM = IDX_DIM // 4
TOPK_MAX = 256
GLA_HEADS = 4
GLA_DV = MIX_WIDTH // 2 // GLA_HEADS
GLA_DK = GLA_DV // 2
GLA_GATE_RANK = 16
GLA_GATE_TEMP = 16.0
D_FF = 11 * D_MODEL // 4
CONV_W = 3
EPS = 1e-6
IN_SPLITS = (N_ATTN_HEADS * ATTN_HEAD_DIM, N_ATTN_HEADS * ATTN_HEAD_DIM, N_ATTN_HEADS * ATTN_HEAD_DIM,
             N_IDX_HEADS * IDX_DIM, IDX_DIM, N_IDX_HEADS,
             GLA_HEADS * GLA_DK, GLA_HEADS * GLA_DK, GLA_HEADS * GLA_DV, GLA_HEADS * GLA_DV, GLA_GATE_RANK)
IN_DIM = sum(IN_SPLITS)

kernel_name = 'hymba_dsa_gla_convffn_stream_step'


def rmsnorm(x, g):
    xf = x.astype(jnp.float32)
    y = xf * lax.rsqrt(jnp.mean(xf * xf, axis=-1, keepdims=True) + EPS)
    return (y * g.astype(jnp.float32)).astype(x.dtype)


def rope(x, pos, rot):
    half = rot // 2
    inv = ROPE_THETA ** (-jnp.arange(half, dtype=jnp.float32) / half)
    ang = pos.astype(jnp.float32)[:, None] * inv[None, :]
    cos = jnp.cos(ang)[None, :, None, :]
    sin = jnp.sin(ang)[None, :, None, :]
    xf = x.astype(jnp.float32)
    x1 = xf[..., :half]
    x2 = xf[..., half:rot]
    out = jnp.concatenate([x1 * cos - x2 * sin, x2 * cos + x1 * sin, xf[..., rot:]], axis=-1)
    return out.astype(x.dtype)


def dsa_attend(q, k, v, qi, ki, wi, q_pos, k_pos):
    B, T, H, Dh = q.shape
    L = k.shape[1]
    topk = min(TOPK_MAX, L // 4)
    qb = min(Q_BLOCK, T)
    nb = T // qb
    ki32 = ki.astype(jnp.float32)
    k_chunk = k_pos // CHUNK
    idx_scale = (IDX_DIM * N_IDX_HEADS) ** -0.5

    def blocks(a):
        return a.reshape((B, nb, qb) + a.shape[2:]).swapaxes(0, 1)

    def one_block(args):
        qs, qis, wis, qp = args
        q_chunk = qp // CHUNK
        logits = jnp.einsum('bthd,bsd->bths', qis.astype(jnp.float32), ki32)
        score = jnp.einsum('bths,bth->bts', jax.nn.relu(logits), wis.astype(jnp.float32)) * idx_scale
        admissible = k_chunk[None, :] <= q_chunk[:, None]
        score = jnp.where(admissible[None], score, -jnp.inf)
        _, idx = lax.top_k(score, topk)
        valid = jnp.take(k_chunk, idx) <= q_chunk[None, :, None]
        k_sel = jax.vmap(lambda kk, ii: kk[ii])(k, idx)
        v_sel = jax.vmap(lambda vv, ii: vv[ii])(v, idx)
        s = jnp.einsum('bthd,btkhd->bhtk', qs.astype(jnp.float32), k_sel.astype(jnp.float32)) * Dh ** -0.5
        s = jnp.where(valid[:, None], s, -jnp.inf)
        p = jax.nn.softmax(s, axis=-1)
        o = jnp.einsum('bhtk,btkhd->bthd', p, v_sel.astype(jnp.float32))
        return o.astype(q.dtype)

    out = lax.map(one_block, (blocks(q), blocks(qi), blocks(wi), q_pos.reshape(nb, qb)))
    return out.swapaxes(0, 1).reshape(B, T, H, Dh)


def gla_attend(s0, q, k, v, lg):
    B, T, H, dk = q.shape
    dv = v.shape[-1]
    C = min(CHUNK, T)
    n = T // C
    tri = jnp.tril(jnp.ones((C, C), dtype=bool))

    def to_chunks(a):
        return a.astype(jnp.float32).reshape((B, n, C) + a.shape[2:]).swapaxes(0, 1)

    def step(S, inp):
        qc, kc, vc, gc = inp
        b = jnp.cumsum(gc, axis=1)
        inter = jnp.einsum('bthk,bhkv->bthv', qc * jnp.exp(b), S)
        diff = b[:, :, None] - b[:, None, :]
        decay = jnp.exp(jnp.where(tri[None, :, :, None, None], diff, -jnp.inf))
        A = jnp.einsum('bthk,bshk,btshk->bhts', qc, kc, decay)
        intra = jnp.einsum('bhts,bshv->bthv', A, vc)
        bl = b[:, -1]
        S = jnp.exp(bl)[..., None] * S + jnp.einsum('bshk,bshv->bhkv', kc * jnp.exp(bl[:, None] - b), vc)
        return S, inter + intra

    S, o = lax.scan(step, s0.astype(jnp.float32), (to_chunks(q), to_chunks(k), to_chunks(v), to_chunks(lg)))
    o = o.swapaxes(0, 1).reshape(B, T, H, dv)
    return o, S.astype(s0.dtype)


def layer_forward(x, c, pos, past_k, past_v, past_ik, past_pos, gla_s0, conv_buf, lw):
    (w_ada, b_ada, g_mix, g_ffn, w_in, g_q, g_k, w_gate2, b_gate2, g_gla,
     w_out, w_up, w_conv, b_conv, w_down) = lw
    B, T, _ = x.shape
    mod = jax.nn.silu(c) @ w_ada + b_ada
    sh_m, sc_m, gt_m, sh_f, sc_f, gt_f = [m[:, None, :] for m in jnp.split(mod, 6, axis=-1)]

    h = rmsnorm(x, g_mix) * (1 + sc_m) + sh_m
    proj = h @ w_in
    offsets = np.cumsum(IN_SPLITS)[:-1].tolist()
    aq, ak, av, iq, ik, iw, gq, gk, gv, gr, glr = jnp.split(proj, offsets, axis=-1)

    aq = rope(rmsnorm(aq.reshape(B, T, N_ATTN_HEADS, ATTN_HEAD_DIM), g_q), pos, ROPE_DIM)
    ak = rope(rmsnorm(ak.reshape(B, T, N_ATTN_HEADS, ATTN_HEAD_DIM), g_k), pos, ROPE_DIM)
    av = av.reshape(B, T, N_ATTN_HEADS, ATTN_HEAD_DIM)
    iq = rope(iq.reshape(B, T, N_IDX_HEADS, IDX_DIM), pos, IDX_ROPE_DIM)
    ik = rope(ik[:, :, None, :], pos, IDX_ROPE_DIM)[:, :, 0, :]
    k_all = jnp.concatenate([past_k.astype(ak.dtype), ak], axis=1)
    v_all = jnp.concatenate([past_v.astype(av.dtype), av], axis=1)
    ik_all = jnp.concatenate([past_ik.astype(ik.dtype), ik], axis=1)
    kpos_all = jnp.concatenate([past_pos, pos])
    o_a = dsa_attend(aq, k_all, v_all, iq, ik_all, iw, pos, kpos_all).reshape(B, T, N_ATTN_HEADS * ATTN_HEAD_DIM)

    gq = gq.reshape(B, T, GLA_HEADS, GLA_DK) * GLA_DK ** -0.5
    gk = gk.reshape(B, T, GLA_HEADS, GLA_DK)
    gv = gv.reshape(B, T, GLA_HEADS, GLA_DV)
    lg = jax.nn.log_sigmoid((glr @ w_gate2 + b_gate2).astype(jnp.float32)) / GLA_GATE_TEMP
    lg = lg.reshape(B, T, GLA_HEADS, GLA_DK)
    o_g, s_new = gla_attend(gla_s0, gq, gk, gv, lg)
    o_g = rmsnorm(o_g.astype(x.dtype), g_gla) * jax.nn.silu(gr.reshape(B, T, GLA_HEADS, GLA_DV))
    o_g = o_g.reshape(B, T, GLA_HEADS * GLA_DV)

    x = x + gt_m * (jnp.concatenate([o_a, o_g], axis=-1) @ w_out)

    h2 = rmsnorm(x, g_ffn) * (1 + sc_f) + sh_f
    u = h2 @ w_up
    ext = jnp.concatenate([conv_buf.astype(u.dtype), u], axis=1)
    uc = b_conv + sum(w_conv[j] * ext[:, j:j + T] for j in range(CONV_W))
    ua, ub = jnp.split(uc, 2, axis=-1)
    x = x + gt_f * ((jax.nn.silu(ua) * ub) @ w_down)
    new_buf = ext[:, T:]
    return x, ak, av, ik, s_new, new_buf


def setup_inputs(seed: int = 0) -> dict:
    key = jax.random.key(seed)
    ks = jax.random.split(key, 24)

    def nrm(k, shape, s):
        return jax.random.normal(k, shape, jnp.float32) * s

    return {
        'x_prompt': nrm(ks[0], (BATCH, SEQ, D_MODEL), 1.0),
        'x_sample': nrm(ks[1], (DEC_BATCH, DEC_SEQ, D_MODEL), 1.0),
        'c_prompt': nrm(ks[2], (BATCH, D_MODEL), 1.0),
        'c_sample': nrm(ks[3], (DEC_BATCH, D_MODEL), 1.0),
        'cache_k': nrm(ks[4], (DEPTH, DEC_BATCH, PAST_LEN, N_ATTN_HEADS, ATTN_HEAD_DIM), 1.0),
        'cache_v': nrm(ks[5], (DEPTH, DEC_BATCH, PAST_LEN, N_ATTN_HEADS, ATTN_HEAD_DIM), 1.0),
        'cache_idx_k': nrm(ks[6], (DEPTH, DEC_BATCH, PAST_LEN, IDX_DIM), 1.0),
        'state_gla': nrm(ks[7], (DEPTH, DEC_BATCH, GLA_HEADS, GLA_DK, GLA_DV), 0.5),
        'state_ffn_conv': nrm(ks[8], (DEPTH, DEC_BATCH, CONV_W - 1, 2 * D_FF), 1.0),
        'w_ada': nrm(ks[9], (DEPTH, D_MODEL, 6 * D_MODEL), 0.5 * D_MODEL ** -0.5),
        'b_ada': nrm(ks[10], (DEPTH, 6 * D_MODEL), 0.01),
        'g_mix': 1.0 + nrm(ks[11], (DEPTH, D_MODEL), 0.02),
        'g_ffn': 1.0 + nrm(ks[12], (DEPTH, D_MODEL), 0.02),
        'w_in': nrm(ks[13], (DEPTH, D_MODEL, IN_DIM), D_MODEL ** -0.5),
        'g_q': 1.0 + nrm(ks[14], (DEPTH, ATTN_HEAD_DIM), 0.02),
        'g_k': 1.0 + nrm(ks[15], (DEPTH, ATTN_HEAD_DIM), 0.02),
        'w_gate2': nrm(ks[16], (DEPTH, GLA_GATE_RANK, GLA_HEADS * GLA_DK), GLA_GATE_RANK ** -0.5),
        'b_gate2': nrm(ks[17], (DEPTH, GLA_HEADS * GLA_DK), 0.01),
        'g_gla': 1.0 + nrm(ks[18], (DEPTH, GLA_DV), 0.02),
        'w_out': nrm(ks[19], (DEPTH, MIX_WIDTH, D_MODEL), MIX_WIDTH ** -0.5),
        'w_up': nrm(ks[20], (DEPTH, D_MODEL, 2 * D_FF), D_MODEL ** -0.5),
        'w_conv': nrm(ks[21], (DEPTH, CONV_W, 2 * D_FF), CONV_W ** -0.5),
        'b_conv': nrm(ks[22], (DEPTH, 2 * D_FF), 0.01),
        'w_down': nrm(ks[23], (DEPTH, D_FF, D_MODEL), D_FF ** -0.5),
    }


def reference(x_prompt, x_sample, c_prompt, c_sample, cache_k, cache_v, cache_idx_k, state_gla,
              state_ffn_conv, w_ada, b_ada, g_mix, g_ffn, w_in, g_q, g_k, w_gate2, b_gate2, g_gla,
              w_out, w_up, w_conv, b_conv, w_down):
    B, S, _ = x_prompt.shape
    Ts = x_sample.shape[1]
    P = cache_k.shape[2]
    dt = x_prompt.dtype
    pos_p = jnp.arange(S, dtype=jnp.int32)
    pos_s = P + jnp.arange(Ts, dtype=jnp.int32)
    past_pos_s = jnp.arange(P, dtype=jnp.int32)
    empty_pos = jnp.zeros((0,), jnp.int32)
    empty_kv = jnp.zeros((B, 0, N_ATTN_HEADS, ATTN_HEAD_DIM), dt)
    empty_ik = jnp.zeros((B, 0, IDX_DIM), dt)
    gla0 = jnp.zeros((B, GLA_HEADS, GLA_DK, GLA_DV), dt)
    conv0 = jnp.zeros((B, CONV_W - 1, 2 * D_FF), dt)

    y_p, y_s = x_prompt, x_sample
    kp, vp, ikp, sp, cp = [], [], [], [], []
    ksm, vsm, iks, ssm, csm = [], [], [], [], []
    for l in range(DEPTH):
        lw = (w_ada[l], b_ada[l], g_mix[l], g_ffn[l], w_in[l], g_q[l], g_k[l], w_gate2[l], b_gate2[l],
              g_gla[l], w_out[l], w_up[l], w_conv[l], b_conv[l], w_down[l])
        y_p, k1, v1, ik1, s1, c1 = layer_forward(y_p, c_prompt, pos_p, empty_kv, empty_kv, empty_ik,
                                                 empty_pos, gla0, conv0, lw)
        y_s, k2, v2, ik2, s2, c2 = layer_forward(y_s, c_sample, pos_s, cache_k[l], cache_v[l], cache_idx_k[l],
                                                 past_pos_s, state_gla[l], state_ffn_conv[l], lw)
        kp.append(k1); vp.append(v1); ikp.append(ik1); sp.append(s1); cp.append(c1)
        ksm.append(k2); vsm.append(v2); iks.append(ik2); ssm.append(s2); csm.append(c2)

    return (y_p, y_s,
            jnp.stack(kp), jnp.stack(vp), jnp.stack(ikp), jnp.stack(sp), jnp.stack(cp),
            jnp.stack(ksm), jnp.stack(vsm), jnp.stack(iks), jnp.stack(ssm), jnp.stack(csm))
```

```cpp
#include <hip/hip_runtime.h>
#include <hip/hip_cooperative_groups.h>
#include <cstdio>
#include <cstdint>
namespace cg = cooperative_groups;
namespace pg8 {
#define PG8_LAS __attribute__((address_space(3)))
typedef unsigned short bf16_t;
typedef short bf16x8 __attribute__((ext_vector_type(8)));
typedef float f32x4 __attribute__((ext_vector_type(4)));
typedef unsigned u32x4 __attribute__((ext_vector_type(4)));
constexpr int BM = 256, BK = 64, HALF = 128, HTB = HALF * BK * 2  , STAGE_BYTES = 8 * HTB, NXCD = 8, WGM = 8;

__host__ __device__ __forceinline__ int lds_byte(int r, int c) { const int st = (r >> 4) * 2 + (c >> 5), rr = r & 15, cc = c & 31, ob = rr * 64 + cc * 2; return st * 1024 + (ob ^ (((ob >> 9) & 1) << 5)); }
__host__ __device__ __forceinline__ void stage_rc(int b, int& R, int& C) { const int st = b / 1024, sb = b % 1024, swz = sb ^ (((sb >> 9) & 1) << 5); R = (st >> 1) * 16 + swz / 64; C = (st & 1) * 32 + (swz % 64) / 2; }
__host__ __device__ __forceinline__ int perm32(int rho) { const int n = rho >> 4, i = rho & 15; return 8 * (i >> 2) + 4 * n + (i & 3); }

struct Unit { int pm, pn; };
struct Gemm { const bf16_t* A; const bf16_t* Bt; int M, N, K, lda; };

struct StaticOrder {
    int nM, nN, nwg, G, c;
    __host__ __device__ void init(int M, int N, int G_, int c_) { nM = M / BM; nN = N / BM; nwg = nM * nN; G = G_; c = c_; }
    __host__ __device__ bool next(int i, Unit& u) const {
        const long L = (long)i * G + c; if (L >= nwg) return false;
        int wgid = (int)L; { const int q = nwg / NXCD, r = nwg % NXCD, xcd = wgid % NXCD, off = wgid / NXCD; wgid = (xcd < r ? xcd * (q + 1) : r * (q + 1) + (xcd - r) * q) + off; }
        const int nig = WGM * nN, gid = wgid / nig, fm = gid * WGM, gsz = (nM - fm) < WGM ? (nM - fm) : WGM;
        u.pm = fm + ((wgid % nig) % gsz); u.pn = (wgid % nig) / gsz; return true;
    }
    __device__ __forceinline__ void a_ready(const Unit&) const {}
    __device__ __forceinline__ void done(const Unit&) const {}
};

__device__ __forceinline__ unsigned cvt_pk_bf16(float lo, float hi) { unsigned r; asm volatile("v_cvt_pk_bf16_f32 %0, %1, %2" : "=v"(r) : "v"(lo), "v"(hi)); return r; }
template <class Epi, class Sched, bool ALIGN_EPI = false, bool SP2 = false>
__device__ __forceinline__ void gemm_phase(PG8_LAS unsigned char* lds, const Gemm g, const Sched& S, const Epi& E) {
    const int tid = threadIdx.x, wid = __builtin_amdgcn_readfirstlane(tid >> 6), lane = tid & 63, wr = wid >> 2, wc = wid & 3, fr = lane & 15, fq = lane >> 4;
    const int K = g.K, nt = K / BK;
    unsigned voffA[2], voffB[2];
#pragma unroll
    for (int i = 0; i < 2; ++i) { int R, C; stage_rc(tid * 16 + i * 8192, R, C); const int Rb = Epi::PERM ? ((R & ~31) + perm32(R & 31)) : R;
        voffA[i] = (unsigned)(R * g.lda + C) * 2u; voffB[i] = (unsigned)(Rb * K + C) * 2u; }
    const size_t kstep = (size_t)(BK * 2);
    const size_t hstepA = (size_t)HALF * g.lda * 2, hstepB = (size_t)HALF * K * 2;
    const size_t tstepA = 2 * hstepA, tstepB = 2 * hstepB;
    const unsigned ldsw = (unsigned)wid * 1024u;
    const int aoff = lds_byte(wr * 64 + fr, fq * 8), boff = lds_byte(wc * 32 + fr, fq * 8);
#define PG8_SA(b, h) (((b) * 2 + (h)) * HTB)
#define PG8_SB(b, h) ((4 + (b) * 2 + (h)) * HTB)
#define PG8_STAGE(bufoff, gbase, voff) do { _Pragma("unroll") for (int _i = 0; _i < 2; ++_i) \
        __builtin_amdgcn_global_load_lds((const unsigned*)((const char*)(gbase) + (voff)[_i]), (PG8_LAS unsigned*)(lds + (bufoff) + ldsw + _i * 8192), 16, 0, 0); } while (0)
#define PG8_LDA(dst, b, h) do { _Pragma("unroll") for (int m = 0; m < 4; ++m) _Pragma("unroll") for (int k = 0; k < 2; ++k) dst[m][k] = *(const PG8_LAS bf16x8*)(lds + PG8_SA(b, h) + aoff + m * 2048 + k * 1024); } while (0)
#define PG8_LDB(dst, b, h) do { _Pragma("unroll") for (int n = 0; n < 2; ++n) _Pragma("unroll") for (int k = 0; k < 2; ++k) dst[n][k] = *(const PG8_LAS bf16x8*)(lds + PG8_SB(b, h) + boff + n * 2048 + k * 1024); } while (0)
#define PG8_MMA(ai, bj, At, Bt) do { __builtin_amdgcn_s_setprio(1); _Pragma("unroll") for (int m = 0; m < 4; ++m) _Pragma("unroll") for (int n = 0; n < 2; ++n) _Pragma("unroll") for (int k = 0; k < 2; ++k) \
        acc[ai][bj][m][n] = __builtin_amdgcn_mfma_f32_16x16x32_bf16(Bt[n][k], At[m][k], acc[ai][bj][m][n], 0, 0, 0); __builtin_amdgcn_s_setprio(0); } while (0)
#define PG8_WAIT_V(n) asm volatile("s_waitcnt vmcnt(" #n ")" ::: "memory")
#define PG8_WAIT_L(n) asm volatile("s_waitcnt lgkmcnt(" #n ")" ::: "memory")
#define PG8_BAR __builtin_amdgcn_s_barrier()
#define PG8_SCHED __builtin_amdgcn_sched_barrier(0)
    Unit cur, nxt; int ui = 0;
    if (!S.next(0, cur)) return;
    f32x4 acc[2][2][4][2];
#pragma unroll
    for (int a = 0; a < 2; ++a)
#pragma unroll
        for (int b = 0; b < 2; ++b)
#pragma unroll
            for (int m = 0; m < 4; ++m)
#pragma unroll
                for (int n = 0; n < 2; ++n) acc[a][b][m][n] = (f32x4){0.f, 0.f, 0.f, 0.f};
    bf16x8 At[4][2], B0[2][2], B1[2][2];
    const char* cA = (const char*)g.A + (size_t)cur.pm * tstepA; const char* cB = (const char*)g.Bt + (size_t)cur.pn * tstepB;
    S.a_ready(cur);
    if constexpr (SP2) {
        PG8_STAGE(PG8_SB(0, 0), cB, voffB); PG8_STAGE(PG8_SB(0, 1), cB + hstepB, voffB); PG8_STAGE(PG8_SA(0, 0), cA, voffA); PG8_STAGE(PG8_SA(0, 1), cA + hstepA, voffA);
        if (wr == 1) PG8_BAR;
        PG8_WAIT_V(2); PG8_BAR;
        PG8_STAGE(PG8_SB(1, 0), cB + kstep, voffB); PG8_STAGE(PG8_SA(1, 0), cA + kstep, voffA); PG8_STAGE(PG8_SB(1, 1), cB + hstepB + kstep, voffB);
        PG8_WAIT_V(6); PG8_BAR;
    } else {
        PG8_STAGE(PG8_SB(0, 0), cB, voffB); PG8_STAGE(PG8_SA(0, 0), cA, voffA); PG8_STAGE(PG8_SB(0, 1), cB + hstepB, voffB); PG8_STAGE(PG8_SA(0, 1), cA + hstepA, voffA);
        if (wr == 1) PG8_BAR;
        PG8_WAIT_V(4); PG8_BAR;
        PG8_STAGE(PG8_SB(1, 0), cB + kstep, voffB); PG8_STAGE(PG8_SA(1, 0), cA + kstep, voffA); PG8_STAGE(PG8_SB(1, 1), cB + hstepB + kstep, voffB);
        PG8_WAIT_V(6); PG8_BAR;
    }
    for (;;) {
        const bool has_next = S.next(ui + 1, nxt);
        const char* nA = has_next ? (const char*)g.A + (size_t)nxt.pm * tstepA : cA; const char* nB = has_next ? (const char*)g.Bt + (size_t)nxt.pn * tstepB : cB;
        for (int t = 0; t < nt; t += 2) {
            const bool last = (t == nt - 2);
            const char* a1 = cA + (size_t)(t + 1) * kstep;
            const char* a2 = last ? nA : cA + (size_t)(t + 2) * kstep; const char* b2 = last ? nB : cB + (size_t)(t + 2) * kstep;
            const char* a3 = a2 + kstep; const char* b3 = b2 + kstep;
            if (last && has_next) S.a_ready(nxt);
            if constexpr (SP2) {
            PG8_LDB(B0, 0, 0); PG8_LDB(B1, 0, 1); PG8_SCHED; PG8_LDA(At, 0, 0); PG8_STAGE(PG8_SA(1, 1), a1 + hstepA, voffA);
            PG8_WAIT_V(8); PG8_WAIT_L(0); PG8_BAR; PG8_MMA(0, 0, At, B0); PG8_MMA(0, 1, At, B1); PG8_BAR; PG8_SCHED;
            PG8_LDA(At, 0, 1); PG8_STAGE(PG8_SB(0, 0), b2, voffB); PG8_STAGE(PG8_SB(0, 1), b2 + hstepB, voffB); PG8_STAGE(PG8_SA(0, 0), a2, voffA);
            PG8_WAIT_V(8); PG8_WAIT_L(0); PG8_BAR; PG8_MMA(1, 0, At, B0); PG8_MMA(1, 1, At, B1); PG8_BAR; PG8_SCHED;
            PG8_LDB(B0, 1, 0); PG8_LDB(B1, 1, 1); PG8_SCHED; PG8_LDA(At, 1, 0); PG8_STAGE(PG8_SA(0, 1), a2 + hstepA, voffA);
            PG8_WAIT_V(8); PG8_WAIT_L(0); PG8_BAR; PG8_MMA(0, 0, At, B0); PG8_MMA(0, 1, At, B1); PG8_BAR; PG8_SCHED;
            PG8_LDA(At, 1, 1); PG8_STAGE(PG8_SB(1, 0), b3, voffB); PG8_STAGE(PG8_SB(1, 1), b3 + hstepB, voffB); PG8_STAGE(PG8_SA(1, 0), a3, voffA);
            PG8_WAIT_V(8); PG8_WAIT_L(0); PG8_BAR; PG8_MMA(1, 0, At, B0); PG8_MMA(1, 1, At, B1); PG8_BAR; PG8_SCHED;
            } else {
            PG8_LDB(B0, 0, 0); PG8_SCHED; PG8_LDA(At, 0, 0); PG8_STAGE(PG8_SA(1, 1), a1 + hstepA, voffA);
            PG8_WAIT_L(8); PG8_BAR; PG8_WAIT_L(0); PG8_MMA(0, 0, At, B0); PG8_BAR; PG8_SCHED;
            PG8_LDB(B1, 0, 1); PG8_STAGE(PG8_SB(0, 0), b2, voffB);
            PG8_BAR; PG8_WAIT_L(0); PG8_MMA(0, 1, At, B1); PG8_BAR;
            PG8_LDA(At, 0, 1); PG8_STAGE(PG8_SA(0, 0), a2, voffA);
            PG8_BAR; PG8_WAIT_L(0); PG8_MMA(1, 0, At, B0); PG8_BAR; PG8_SCHED;
            PG8_STAGE(PG8_SB(0, 1), b2 + hstepB, voffB);
            PG8_WAIT_V(6); PG8_BAR; PG8_MMA(1, 1, At, B1); PG8_BAR;
            PG8_LDB(B0, 1, 0); PG8_SCHED; PG8_LDA(At, 1, 0); PG8_STAGE(PG8_SA(0, 1), a2 + hstepA, voffA);
            PG8_WAIT_L(8); PG8_BAR; PG8_WAIT_L(0); PG8_MMA(0, 0, At, B0); PG8_BAR; PG8_SCHED;
            PG8_LDB(B1, 1, 1); PG8_STAGE(PG8_SB(1, 0), b3, voffB);
            PG8_BAR; PG8_WAIT_L(0); PG8_MMA(0, 1, At, B1); PG8_BAR;
            PG8_LDA(At, 1, 1); PG8_STAGE(PG8_SA(1, 0), a3, voffA);
            PG8_BAR; PG8_WAIT_L(0); PG8_MMA(1, 0, At, B0); PG8_BAR; PG8_SCHED;
            PG8_STAGE(PG8_SB(1, 1), b3 + hstepB, voffB);
            PG8_WAIT_V(6); PG8_BAR; PG8_MMA(1, 1, At, B1); PG8_BAR;
            }
        }
        if constexpr (ALIGN_EPI) { if (wr == 0) PG8_BAR; }
        if constexpr (!Epi::AFTER_DRAIN) { E(acc, cur, wr, wc, fr, fq); S.done(cur); }
        if (!has_next) break;
#pragma unroll
        for (int a = 0; a < 2; ++a)
#pragma unroll
            for (int b = 0; b < 2; ++b)
#pragma unroll
                for (int m = 0; m < 4; ++m)
#pragma unroll
                    for (int n = 0; n < 2; ++n) acc[a][b][m][n] = (f32x4){0.f, 0.f, 0.f, 0.f};
        cur = nxt; cA = nA; cB = nB; ++ui;
        if constexpr (ALIGN_EPI) { if (wr == 1) PG8_BAR; }
    }
    PG8_WAIT_V(0);
    if constexpr (!ALIGN_EPI) { if (wr == 0) PG8_BAR; }
    PG8_BAR;
    if constexpr (Epi::AFTER_DRAIN) { E.fused(acc, cur, wr, wc, fr, fq, lds, wid, lane); S.done(cur); }
#undef PG8_SA
#undef PG8_SB
#undef PG8_STAGE
#undef PG8_LDA
#undef PG8_LDB
#undef PG8_MMA
#undef PG8_WAIT_V
#undef PG8_WAIT_L
#undef PG8_BAR
#undef PG8_SCHED
}
}
using pg8::bf16_t; using pg8::bf16x8; using pg8::f32x4; using pg8::u32x4;
typedef float f32x16 __attribute__((ext_vector_type(16)));
typedef unsigned long long u64;

constexpr int DM = 2048, TP = 16384, TS = 512, TT = TP + TS, NBATCH = 9, MODW = 6 * DM;
constexpr int NP = 7424;
constexpr int C_AQ = 0, C_IQ = 1024, C_AK = 2048, C_AV = 3072, C_GQ = 4096, C_GK = 4608, C_GV = 5120, C_GR = 6144, C_IK = 7168, C_IW = 7232, C_GLR = 7248, C_END = 7264;
constexpr int DFF = 5632, NUP = 11264, WIN_N = 7264;
constexpr int NCH = 264;
constexpr float EPS = 1e-6f;
constexpr size_t O_Y = 0, O_KP = 34603008, O_VP = 51380224, O_IKP = 68157440, O_GSP = 69206016, O_FCP = 69337088,
                 O_KS = 69359616, O_VS = 69883904, O_IKS = 70408192, O_GSS = 70440960, O_FCS = 71489536, O_TOTAL = 71669760;
constexpr size_t MiB = 1u << 20;
constexpr size_t WS_CTL = 0, WS_MOD = 1 * MiB, WS_D = 2 * MiB, WS_WIN = 4 * MiB, WS_WOUT = 33 * MiB, WS_WUP = 41 * MiB, WS_WDN = 85 * MiB,
                 WS_ACT = 107 * MiB, WS_P = 173 * MiB, WS_CK = 413 * MiB, WS_CV = 429 * MiB, WS_CIK = 445 * MiB, WS_KV8 = 446 * MiB, WS_CKV8 = 479 * MiB, WS_END = 495 * MiB;
constexpr size_t WS_BC = WS_WUP;
constexpr size_t WS_IKC = WS_CK;
constexpr size_t WS_UF = WS_CK, WS_UH = WS_CK + 12 * MiB;
constexpr int LDS_BYTES = 149568;
constexpr int NPHASE = 11;
constexpr int IDX_ITEMS = 5184;

struct Args { const float* in[24]; float* out; unsigned char* ws; int ph_lo, ph_hi; };

__device__ __forceinline__ unsigned f2bf(float f) { unsigned u = __builtin_bit_cast(unsigned, f); return (u + 0x7fffu + ((u >> 16) & 1u)) >> 16; }
typedef float f32x2v __attribute__((ext_vector_type(2))); typedef __bf16 bf16x2v __attribute__((ext_vector_type(2)));
__device__ __forceinline__ unsigned pk2(float lo, float hi) { const f32x2v v = {lo, hi}; const bf16x2v b = __builtin_convertvector(v, bf16x2v); return __builtin_bit_cast(unsigned, b); }
__device__ __forceinline__ float bflo(unsigned w) { return __builtin_bit_cast(float, w << 16); }
__device__ __forceinline__ float bfhi(unsigned w) { return __builtin_bit_cast(float, w & 0xffff0000u); }
__device__ __forceinline__ float bf1(bf16_t h) { return __builtin_bit_cast(float, ((unsigned)h) << 16); }
__device__ __forceinline__ void unpack8(u32x4 w, float* v) { v[0] = bflo(w.x); v[1] = bfhi(w.x); v[2] = bflo(w.y); v[3] = bfhi(w.y); v[4] = bflo(w.z); v[5] = bfhi(w.z); v[6] = bflo(w.w); v[7] = bfhi(w.w); }
__device__ __forceinline__ u32x4 pack8(const float* v) { u32x4 w; w.x = pk2(v[0], v[1]); w.y = pk2(v[2], v[3]); w.z = pk2(v[4], v[5]); w.w = pk2(v[6], v[7]); return w; }
__device__ __forceinline__ float wave_sum(float v) {
#pragma unroll
    for (int o = 1; o < 64; o <<= 1) v += __shfl_xor(v, o);
    return v;
}
__device__ __forceinline__ float siluf(float x) { return x * __builtin_amdgcn_rcpf(1.f + __expf(-x)); }
typedef float f32x2 __attribute__((ext_vector_type(2)));
__device__ __forceinline__ unsigned pk4_fp8(float a, float b, float c, float d) { int w = 0; w = __builtin_amdgcn_cvt_pk_fp8_f32(a, b, w, false); w = __builtin_amdgcn_cvt_pk_fp8_f32(c, d, w, true); return (unsigned)w; }
__device__ __forceinline__ u32x4 pack16_fp8(const float* v) { u32x4 w; w.x = pk4_fp8(v[0], v[1], v[2], v[3]); w.y = pk4_fp8(v[4], v[5], v[6], v[7]); w.z = pk4_fp8(v[8], v[9], v[10], v[11]); w.w = pk4_fp8(v[12], v[13], v[14], v[15]); return w; }
__device__ __forceinline__ void unpack16_fp8(u32x4 w, float* v) {
#pragma unroll
    for (int i = 0; i < 4; ++i) { const f32x2 lo = __builtin_amdgcn_cvt_pk_f32_fp8((int)w[i], false), hi = __builtin_amdgcn_cvt_pk_f32_fp8((int)w[i], true); v[4 * i] = lo.x; v[4 * i + 1] = lo.y; v[4 * i + 2] = hi.x; v[4 * i + 3] = hi.y; }
}

template <int MAPID> __device__ __forceinline__ int colmap(int n) {
    if (MAPID == 0) return n;
    if (MAPID == 1) {
        if (n < 1024) return n;
        if (n < 2048) return 3072 + (n - 1024);
        if (n < 3072) return 1024 + (n - 2048);
        if (n < 4096) return 2048 + (n - 3072);
        if (n < 4608) return 4176 + (n - 4096);
        if (n < 5120) return 4688 + (n - 4608);
        if (n < 6144) return 5200 + (n - 5120);
        if (n < 7168) return 6224 + (n - 6144);
        if (n < 7232) return 4096 + (n - 7168);
        if (n < 7248) return 4160 + (n - 7232);
        if (n < 7264) return n;
        return -1;
    }
    { const int pn = n >> 8, w = n & 255; return w < 128 ? pn * 128 + w : DFF + pn * 128 + (w - 128); }
}
template <int MAPID> __device__ __forceinline__ void transpose_item(const float* __restrict__ W, int K, int Nsrc, bf16_t* __restrict__ WT, int nblk, float* scr, int item, int lane) {
    const int kb = item / nblk, nb = item % nblk, k0 = 64 * kb, n0 = 32 * nb;
    const int srcc = colmap<MAPID>(n0 + (lane & 31));
#pragma unroll 8
    for (int i = 0; i < 32; ++i) { const int kk = 2 * i + (lane >> 5); scr[kk * 33 + (lane & 31)] = srcc >= 0 ? W[(size_t)(k0 + kk) * Nsrc + srcc] : 0.f; }
    asm volatile("s_waitcnt lgkmcnt(0)" ::: "memory");
    const int c = lane & 7;
#pragma unroll
    for (int j = 0; j < 4; ++j) { const int n = (lane >> 3) + 8 * j; const float* s = scr + (8 * c) * 33 + n;
        u32x4 o; o.x = pk2(s[0 * 33], s[1 * 33]); o.y = pk2(s[2 * 33], s[3 * 33]); o.z = pk2(s[4 * 33], s[5 * 33]); o.w = pk2(s[6 * 33], s[7 * 33]);
        *(u32x4*)(WT + (size_t)(n0 + n) * K + k0 + 8 * c) = o; }
    asm volatile("s_waitcnt lgkmcnt(0)" ::: "memory");
}

__device__ __forceinline__ void phase0(const Args& a, unsigned char* lds, int tid, int lane, int wave) {
    unsigned char* ws = a.ws;
    if ((int)blockIdx.x < 192 || gridDim.x < 192) {
        float* sc = (float*)lds;
        float* red = (float*)(lds + 73728);
        for (int i = tid; i < NBATCH * DM; i += 512) { const int b = i >> 11, k = i & 2047; const float c = b == 0 ? a.in[2][k] : a.in[3][(b - 1) * DM + k]; sc[i] = c / (1.f + __expf(-c)); }
        __syncthreads();
        for (int item = blockIdx.x; item < 192; item += gridDim.x) {
            const int col = item * 64 + lane, k0 = wave * 256;
            float acc[NBATCH];
#pragma unroll
            for (int b = 0; b < NBATCH; ++b) acc[b] = 0.f;
            const float* wp = a.in[9] + (size_t)k0 * MODW + col;
            for (int k = 0; k < 256; k += 32) {
                float wv[32];
#pragma unroll
                for (int i = 0; i < 32; ++i) wv[i] = wp[(size_t)(k + i) * MODW];
#pragma unroll
                for (int i = 0; i < 32; ++i)
#pragma unroll
                    for (int b = 0; b < NBATCH; ++b) acc[b] += sc[b * DM + k0 + k + i] * wv[i]; }
#pragma unroll
            for (int b = 0; b < NBATCH; ++b) red[(wave * NBATCH + b) * 64 + lane] = acc[b];
            __syncthreads();
            for (int i = tid; i < NBATCH * 64; i += 512) { const int b = i >> 6, l = i & 63; float s = a.in[10][item * 64 + l];
#pragma unroll
                for (int w = 0; w < 8; ++w) s += red[(w * NBATCH + b) * 64 + l];
                ((float*)(ws + WS_MOD))[b * MODW + item * 64 + l] = s; }
            __syncthreads();
        }
    }
    __syncthreads();
    {
        float* scr = (float*)(lds + wave * 8448);
        const int gw = blockIdx.x * 8 + wave, NGW = gridDim.x * 8;
        constexpr int I_IN = 32 * (NP / 32);
        for (int it = gw; it < I_IN; it += NGW) transpose_item<1>(a.in[13], DM, WIN_N, (bf16_t*)(ws + WS_WIN), NP / 32, scr, it, lane);
    }
    {
        const size_t gt = (size_t)blockIdx.x * 512 + tid, GT = (size_t)gridDim.x * 512;
        for (size_t i = gt; i < 8388608 / 16; i += GT) {
            const size_t row = i >> 6, chk = i & 63; float v[16];
            const f32x4* s = (const f32x4*)(a.in[4] + row * 1024 + chk * 16);
#pragma unroll
            for (int j = 0; j < 4; ++j) { const f32x4 x = s[j]; v[4 * j] = x.x; v[4 * j + 1] = x.y; v[4 * j + 2] = x.z; v[4 * j + 3] = x.w; }
            *(u32x4*)(ws + WS_CKV8 + row * 2048 + chk * 16) = pack16_fp8(v);
            s = (const f32x4*)(a.in[5] + row * 1024 + chk * 16);
#pragma unroll
            for (int j = 0; j < 4; ++j) { const f32x4 x = s[j]; v[4 * j] = x.x; v[4 * j + 1] = x.y; v[4 * j + 2] = x.z; v[4 * j + 3] = x.w; }
            *(u32x4*)(ws + WS_CKV8 + row * 2048 + 1024 + chk * 16) = pack16_fp8(v); }
        for (size_t i = gt; i < 524288 / 8; i += GT) {
            const f32x4* s = (const f32x4*)a.in[6] + 2 * i; f32x4 x = s[0], y = s[1]; u32x4 o; o.x = pk2(x.x, x.y); o.y = pk2(x.z, x.w); o.z = pk2(y.x, y.y); o.w = pk2(y.z, y.w); ((u32x4*)(ws + WS_CIK))[i] = o; }
    }
}

__device__ __forceinline__ bool gemm_tail_rank(int nwg, int& rank, int& count) {
    const int G = gridDim.x, c = blockIdx.x, rounds = (nwg + G - 1) / G, nbusy = nwg - (rounds - 1) * G;
    rank = c - nbusy; count = G - nbusy; return c >= nbusy;
}
__device__ __forceinline__ void tail_wout(const Args& a, unsigned char* lds, int rank, int count, int lane, int wave) {
    float* scr = (float*)(lds + wave * 8448);
    for (int it = rank * 8 + wave; it < 32 * 64; it += count * 8) transpose_item<0>(a.in[19], DM, DM, (bf16_t*)(a.ws + WS_WOUT), 64, scr, it, lane);
}
__device__ __forceinline__ void tail_wup_wdn(const Args& a, unsigned char* lds, int rank, int count, int lane, int wave) {
    float* scr = (float*)(lds + wave * 8448);
    constexpr int I_UP = 32 * (NUP / 32), I_DN = (DFF / 64) * 64;
    for (int it = rank * 8 + wave; it < I_UP + I_DN; it += count * 8) {
        if (it < I_UP) transpose_item<2>(a.in[20], DM, NUP, (bf16_t*)(a.ws + WS_WUP), NUP / 32, scr, it, lane);
        else transpose_item<0>(a.in[23], DFF, DM, (bf16_t*)(a.ws + WS_WDN), 64, scr, it - I_UP, lane);
    }
}

__device__ __forceinline__ void normmod_phase(const float* xp, const float* xs, const float* g, const float* mod, int sh_off, int sc_off, bf16_t* dst, int lane, int wave) {
    const int gw = blockIdx.x * 8 + wave, NGW = gridDim.x * 8;
    for (int r = gw; r < TT; r += NGW) {
        const float* xrow = r < TP ? xp + (size_t)r * DM : xs + (size_t)(r - TP) * DM;
        const int b = r < TP ? 0 : 1 + ((r - TP) >> 6);
        const f32x4* xr = (const f32x4*)xrow + lane;
        f32x4 v[8]; float s = 0.f;
#pragma unroll
        for (int j = 0; j < 8; ++j) { v[j] = xr[64 * j]; s += (v[j].x * v[j].x + v[j].y * v[j].y) + (v[j].z * v[j].z + v[j].w * v[j].w); }
        const float rstd = rsqrtf(wave_sum(s) * (1.f / DM) + EPS);
        const f32x4* gp = (const f32x4*)g + lane; const f32x4* scp = (const f32x4*)(mod + (size_t)b * MODW + sc_off) + lane; const f32x4* shp = (const f32x4*)(mod + (size_t)b * MODW + sh_off) + lane;
        u64* o8 = (u64*)(dst + (size_t)r * DM) + lane;
#pragma unroll
        for (int j = 0; j < 8; ++j) { const f32x4 gg = gp[64 * j], sc = scp[64 * j], sh = shp[64 * j];
            const f32x4 y = v[j] * rstd * gg * (sc + 1.f) + sh;
            o8[64 * j] = (u64)pk2(y.x, y.y) | ((u64)pk2(y.z, y.w) << 32); }
    }
}

struct EpiP {
    static constexpr bool PERM = true, AFTER_DRAIN = false;
    bf16_t* O; int ldc;
    __device__ __forceinline__ void operator()(const f32x4 (&acc)[2][2][4][2], const pg8::Unit& u, int wr, int wc, int fr, int fq) const {
        const int row0 = u.pm * 256 + wr * 64 + fr, col0 = u.pn * 256 + wc * 32 + 8 * fq;
#pragma unroll
        for (int ai = 0; ai < 2; ++ai)
#pragma unroll
            for (int m = 0; m < 4; ++m) { bf16_t* rowp = O + (size_t)(row0 + ai * 128 + m * 16) * ldc + col0;
#pragma unroll
                for (int bj = 0; bj < 2; ++bj) { const f32x4 v0 = acc[ai][bj][m][0], v1 = acc[ai][bj][m][1]; u32x4 w;
                    w.x = pg8::cvt_pk_bf16(v0[0], v0[1]); w.y = pg8::cvt_pk_bf16(v0[2], v0[3]); w.z = pg8::cvt_pk_bf16(v1[0], v1[1]); w.w = pg8::cvt_pk_bf16(v1[2], v1[3]);
                    *(u32x4*)(rowp + bj * 128) = w; } }
    }
};
struct EpiRes {
    static constexpr bool PERM = true, AFTER_DRAIN = false;
    const float* srcP; const float* srcS; float* dst; const float* gate;
    __device__ __forceinline__ void operator()(const f32x4 (&acc)[2][2][4][2], const pg8::Unit& u, int wr, int wc, int fr, int fq) const {
        const int col0 = u.pn * 256 + wc * 32 + 8 * fq;
#pragma unroll
        for (int ai = 0; ai < 2; ++ai)
#pragma unroll
            for (int m = 0; m < 4; ++m) {
                const int row = u.pm * 256 + ai * 128 + wr * 64 + m * 16 + fr;
                const int b = row < TP ? 0 : 1 + ((row - TP) >> 6);
                const float* sp = (row < TP ? srcP + (size_t)row * DM : srcS + (size_t)(row - TP) * DM) + col0;
                const float* gp = gate + (size_t)b * MODW + col0; float* dp = dst + (size_t)row * DM + col0;
#pragma unroll
                for (int bj = 0; bj < 2; ++bj)
#pragma unroll
                    for (int n = 0; n < 2; ++n) { const f32x4 x = *(const f32x4*)(sp + bj * 128 + 4 * n), gg = *(const f32x4*)(gp + bj * 128 + 4 * n);
                        *(f32x4*)(dp + bj * 128 + 4 * n) = x + gg * acc[ai][bj][m][n]; }
            }
    }
};
template <int CTRL> __device__ __forceinline__ float dpp_ror(float v) {
    return __builtin_bit_cast(float, __builtin_amdgcn_update_dpp(0, __builtin_bit_cast(int, v), CTRL, 0xf, 0xf, false));
}
struct EpiUp {
    static constexpr bool PERM = true, AFTER_DRAIN = false;
    bf16_t* ACTF; bf16_t* Uf; bf16_t* Uh; const float* wconv; const float* bconv;
    __device__ __forceinline__ void operator()(const f32x4 (&acc)[2][2][4][2], const pg8::Unit& u, int wr, int wc, int fr, int fq) const {
        const int lane = fr + 16 * fq;
        const int ch0 = u.pn * 128 + wc * 32 + 8 * fq;
        const int src1 = (lane & 48) | ((fr + 15) & 15), src2 = (lane & 48) | ((fr + 14) & 15);
        unsigned outp[2][4][4];
#pragma unroll
        for (int cp = 0; cp < 4; ++cp) {
            const int chp = ch0 + 2 * cp;
            const f32x2 wa0 = *(const f32x2*)(wconv + chp), wa1 = *(const f32x2*)(wconv + NUP + chp), wa2 = *(const f32x2*)(wconv + 2 * NUP + chp), ba = *(const f32x2*)(bconv + chp);
            const f32x2 wb0 = *(const f32x2*)(wconv + DFF + chp), wb1 = *(const f32x2*)(wconv + NUP + DFF + chp), wb2 = *(const f32x2*)(wconv + 2 * NUP + DFF + chp), bb = *(const f32x2*)(bconv + DFF + chp);
#pragma unroll
            for (int ai = 0; ai < 2; ++ai) {
                float rr[4][2];
#pragma unroll
                for (int ii = 0; ii < 2; ++ii) {
                    const int c8 = 2 * cp + ii, n = c8 >> 2, i = c8 & 3;
                    float ua[4], ub[4], r1a[4], r2a[4], r1b[4], r2b[4];
#pragma unroll
                    for (int m = 0; m < 4; ++m) { ua[m] = acc[ai][0][m][n][i]; ub[m] = acc[ai][1][m][n][i];
                        r1a[m] = dpp_ror<0x121>(ua[m]); r2a[m] = dpp_ror<0x122>(ua[m]); r1b[m] = dpp_ror<0x121>(ub[m]); r2b[m] = dpp_ror<0x122>(ub[m]); }
#pragma unroll
                    for (int m = 0; m < 4; ++m) {
                        const float p1a = fr >= 1 ? r1a[m] : r1a[(m + 3) & 3], p2a = fr >= 2 ? r2a[m] : r2a[(m + 3) & 3];
                        const float p1b = fr >= 1 ? r1b[m] : r1b[(m + 3) & 3], p2b = fr >= 2 ? r2b[m] : r2b[(m + 3) & 3];
                        const float ca = ba[ii] + wa2[ii] * ua[m] + wa1[ii] * p1a + wa0[ii] * p2a;
                        const float cb = bb[ii] + wb2[ii] * ub[m] + wb1[ii] * p1b + wb0[ii] * p2b;
                        rr[m][ii] = siluf(ca) * cb;
                    }
                }
#pragma unroll
                for (int m = 0; m < 4; ++m) outp[ai][m][cp] = pg8::cvt_pk_bf16(rr[m][0], rr[m][1]);
            }
        }
#pragma unroll
        for (int ai = 0; ai < 2; ++ai) {
            const int g = u.pm * 4 + ai * 2 + wr;
#pragma unroll
            for (int m = 0; m < 4; ++m) { const int row = g * 64 + 16 * m + fr;
                u32x4 w; w.x = outp[ai][m][0]; w.y = outp[ai][m][1]; w.z = outp[ai][m][2]; w.w = outp[ai][m][3];
                *(u32x4*)(ACTF + (size_t)row * DFF + ch0) = w; }
            if (fr < 2) { bf16_t* p = Uf + (size_t)(g * 2 + fr) * NUP + ch0;
#pragma unroll
                for (int bj = 0; bj < 2; ++bj) { const f32x4 v0 = acc[ai][bj][0][0], v1 = acc[ai][bj][0][1]; u32x4 w;
                    w.x = pg8::cvt_pk_bf16(v0[0], v0[1]); w.y = pg8::cvt_pk_bf16(v0[2], v0[3]); w.z = pg8::cvt_pk_bf16(v1[0], v1[1]); w.w = pg8::cvt_pk_bf16(v1[2], v1[3]);
                    *(u32x4*)(p + bj * DFF) = w; } }
            if (fr >= 14) { bf16_t* p = Uh + (size_t)(g * 2 + fr - 14) * NUP + ch0;
#pragma unroll
                for (int bj = 0; bj < 2; ++bj) { const f32x4 v0 = acc[ai][bj][3][0], v1 = acc[ai][bj][3][1]; u32x4 w;
                    w.x = pg8::cvt_pk_bf16(v0[0], v0[1]); w.y = pg8::cvt_pk_bf16(v0[2], v0[3]); w.z = pg8::cvt_pk_bf16(v1[0], v1[1]); w.w = pg8::cvt_pk_bf16(v1[2], v1[3]);
                    *(u32x4*)(p + bj * DFF) = w; } }
        }
    }
};

__device__ __forceinline__ void post_rows(const Args& a, unsigned char* lds, int tid, int lane, int wave) {
    double* inv16 = (double*)lds; double* inv8 = inv16 + 16;
    if (tid < 16) inv16[tid] = exp(-(double)tid * (1.0 / 16.0) * 13.122363377404328);
    else if (tid < 24) inv8[tid - 16] = exp(-(double)(tid - 16) * (1.0 / 8.0) * 13.122363377404328);
    __syncthreads();
    bf16_t* P = (bf16_t*)(a.ws + WS_P);
    const float* gq = a.in[14]; const float* gk = a.in[15];
    const int sub = lane & 7;
    float gqv[16], gkv[16];
#pragma unroll
    for (int i = 0; i < 16; ++i) { gqv[i] = gq[sub * 16 + i]; gkv[i] = gk[sub * 16 + i]; }
    const int gw = blockIdx.x * 8 + wave, NGW = gridDim.x * 8;
    for (int r = gw; r < TT; r += NGW) {
        bf16_t* prow = P + (size_t)r * NP;
        const int pos = r < TP ? r : 1024 + ((r - TP) & 63);
        float* kout = r < TP ? a.out + O_KP + (size_t)r * 1024 : a.out + O_KS + (size_t)(r - TP) * 1024;
        float* vout = r < TP ? a.out + O_VP + (size_t)r * 1024 : a.out + O_VS + (size_t)(r - TP) * 1024;
        float* ikout = r < TP ? a.out + O_IKP + (size_t)r * 64 : a.out + O_IKS + (size_t)(r - TP) * 64;
        float cs[16], sn[16];
#pragma unroll
        for (int i = 0; i < 16; ++i) { double rev = (double)pos * inv16[i] * 0.15915494309189535; rev -= rint(rev); const float rf = (float)rev; cs[i] = __builtin_amdgcn_cosf(rf); sn[i] = __builtin_amdgcn_sinf(rf); }
#pragma unroll
        for (int which = 0; which < 2; ++which) {
            bf16_t* p = prow + (which ? C_AK : C_AQ) + lane * 16;
            float v[16]; unpack8(*(const u32x4*)p, v); unpack8(*(const u32x4*)(p + 8), v + 8);
            float ss = 0.f;
#pragma unroll
            for (int i = 0; i < 16; ++i) ss += v[i] * v[i];
            ss += __shfl_xor(ss, 1); ss += __shfl_xor(ss, 2); ss += __shfl_xor(ss, 4);
            const float rstd = rsqrtf(ss * (1.f / 128.f) + EPS);
#pragma unroll
            for (int i = 0; i < 16; ++i) v[i] = v[i] * rstd * (which ? gkv[i] : gqv[i]);
#pragma unroll
            for (int i = 0; i < 16; ++i) { const float pv = __shfl_xor(v[i], 1);
                if (sub == 0) v[i] = v[i] * cs[i] - pv * sn[i]; else if (sub == 1) v[i] = v[i] * cs[i] + pv * sn[i]; }
            if (which) {
#pragma unroll
                for (int i = 0; i < 4; ++i) *(f32x4*)(kout + lane * 16 + 4 * i) = (f32x4){v[4 * i], v[4 * i + 1], v[4 * i + 2], v[4 * i + 3]};
                *(u32x4*)(a.ws + WS_KV8 + (size_t)r * 2048 + lane * 16) = pack16_fp8(v);
            } else {
#pragma unroll
                for (int i = 0; i < 16; ++i) v[i] *= 0.12751743074602468f;
            }
            *(u32x4*)p = pack8(v); *(u32x4*)(p + 8) = pack8(v + 8);
        }
        {
            const bf16_t* p = prow + C_AV + lane * 16; float v[16]; unpack8(*(const u32x4*)p, v); unpack8(*(const u32x4*)(p + 8), v + 8);
#pragma unroll
            for (int i = 0; i < 4; ++i) *(f32x4*)(vout + lane * 16 + 4 * i) = (f32x4){v[4 * i], v[4 * i + 1], v[4 * i + 2], v[4 * i + 3]};
            *(u32x4*)(a.ws + WS_KV8 + (size_t)r * 2048 + 1024 + lane * 16) = pack16_fp8(v);
        }
        float c8[8], s8[8];
#pragma unroll
        for (int i = 0; i < 8; ++i) { double rev = (double)pos * inv8[i] * 0.15915494309189535; rev -= rint(rev); const float rf = (float)rev; c8[i] = __builtin_amdgcn_cosf(rf); s8[i] = __builtin_amdgcn_sinf(rf); }
        {
            bf16_t* p = prow + C_IQ + lane * 16; float v[16]; unpack8(*(const u32x4*)p, v); unpack8(*(const u32x4*)(p + 8), v + 8);
            if ((lane & 3) == 0) {
#pragma unroll
                for (int i = 0; i < 8; ++i) { const float x1 = v[i], x2 = v[i + 8]; v[i] = x1 * c8[i] - x2 * s8[i]; v[i + 8] = x2 * c8[i] + x1 * s8[i]; }
                *(u32x4*)p = pack8(v); *(u32x4*)(p + 8) = pack8(v + 8);
            }
        }
        if (lane < 4) {
            bf16_t* p = prow + C_IK + lane * 16; float v[16]; unpack8(*(const u32x4*)p, v); unpack8(*(const u32x4*)(p + 8), v + 8);
            if (lane == 0) {
#pragma unroll
                for (int i = 0; i < 8; ++i) { const float x1 = v[i], x2 = v[i + 8]; v[i] = x1 * c8[i] - x2 * s8[i]; v[i + 8] = x2 * c8[i] + x1 * s8[i]; }
                *(u32x4*)p = pack8(v); *(u32x4*)(p + 8) = pack8(v + 8);
            }
            { bf16_t* pc = (bf16_t*)(a.ws + WS_IKC) + (size_t)r * 64 + lane * 16; *(u32x4*)pc = pack8(v); *(u32x4*)(pc + 8) = pack8(v + 8); }
#pragma unroll
            for (int i = 0; i < 4; ++i) *(f32x4*)(ikout + lane * 16 + 4 * i) = (f32x4){v[4 * i], v[4 * i + 1], v[4 * i + 2], v[4 * i + 3]};
        }
    }
    __syncthreads();
}

__device__ __forceinline__ f32x4 mfma16(bf16x8 a, bf16x8 b, f32x4 c) { return __builtin_amdgcn_mfma_f32_16x16x32_bf16(a, b, c, 0, 0, 0); }
constexpr int L_GLR = 0, L_BC = 4096, L_TOT = 36864, L_A = 38912;
__device__ __forceinline__ int tsw(int row) { return ((row >> 3) & 7) << 3; }
__device__ __forceinline__ void gla_bcum(const Args& a, unsigned char* lds, int n, int h, int tid) {
    const bf16_t* P = (const bf16_t*)(a.ws + WS_P);
    float* glr = (float*)(lds + L_GLR); float* bc = (float*)(lds + L_BC); float* tot = (float*)(lds + L_TOT);
    for (int e = tid; e < 1024; e += 512) { const int t = e >> 4, rr = e & 15; glr[e] = bf1(P[(size_t)(n * 64 + t) * NP + C_GLR + rr]); }
    __syncthreads();
    const int dk = tid & 127, tq = tid >> 7;
    float w[16];
#pragma unroll
    for (int rr = 0; rr < 16; ++rr) w[rr] = a.in[16][rr * 512 + h * 128 + dk];
    const float bias = a.in[17][h * 128 + dk];
    float run = 0.f;
#pragma unroll 4
    for (int tt = 0; tt < 16; ++tt) { const int t = tq * 16 + tt; float x = bias;
#pragma unroll
        for (int rr = 0; rr < 16; ++rr) x += glr[t * 16 + rr] * w[rr];
        const float ls = fminf(x, 0.f) - log1pf(__expf(-fabsf(x)));
        run += ls * (1.f / 16.f); bc[t * 128 + dk] = run; }
    tot[tq * 128 + dk] = run;
    __syncthreads();
    float off = 0.f;
    for (int g = 0; g < tq; ++g) off += tot[g * 128 + dk];
    if (tq > 0) { for (int tt = 0; tt < 16; ++tt) bc[(tq * 16 + tt) * 128 + dk] += off; }
    __syncthreads();
}
__device__ __forceinline__ void gla_g1(const Args& a, unsigned char* lds, int tid, int lane, int wave) {
    const bf16_t* P = (const bf16_t*)(a.ws + WS_P);
    float* Dd = (float*)(a.ws + WS_D);
    const float* bc = (const float*)(lds + L_BC);
    bf16_t* KT = (bf16_t*)(lds + L_A);
    bf16_t* VT = (bf16_t*)(lds + L_A + 18432);
    for (int it = blockIdx.x; it < NCH * 4; it += gridDim.x) {
        const int n = it >> 2, h = it & 3;
        gla_bcum(a, lds, n, h, tid);
        { f32x4* bcg = (f32x4*)(a.ws + WS_BC) + (size_t)it * 2048;
#pragma unroll
          for (int i = 0; i < 4; ++i) bcg[tid + 512 * i] = ((const f32x4*)bc)[tid + 512 * i]; }
        for (int ch = tid; ch < 1024; ch += 512) { const int s = ch >> 4, d0 = (ch & 15) * 8; float v[8]; unpack8(*(const u32x4*)(P + (size_t)(n * 64 + s) * NP + C_GK + h * 128 + d0), v);
#pragma unroll
            for (int i = 0; i < 8; ++i) KT[(d0 + i) * 72 + (s ^ tsw(d0))] = (bf16_t)f2bf(v[i] * __expf(bc[63 * 128 + d0 + i] - bc[s * 128 + d0 + i])); }
        for (int ch = tid; ch < 2048; ch += 512) { const int s = ch >> 5, d0 = (ch & 31) * 8; const u32x4 w = *(const u32x4*)(P + (size_t)(n * 64 + s) * NP + C_GV + h * 256 + d0);
            VT[(d0 + 0) * 72 + (s ^ tsw(d0))] = (bf16_t)(w.x & 0xffff); VT[(d0 + 1) * 72 + (s ^ tsw(d0))] = (bf16_t)(w.x >> 16); VT[(d0 + 2) * 72 + (s ^ tsw(d0))] = (bf16_t)(w.y & 0xffff); VT[(d0 + 3) * 72 + (s ^ tsw(d0))] = (bf16_t)(w.y >> 16);
            VT[(d0 + 4) * 72 + (s ^ tsw(d0))] = (bf16_t)(w.z & 0xffff); VT[(d0 + 5) * 72 + (s ^ tsw(d0))] = (bf16_t)(w.z >> 16); VT[(d0 + 6) * 72 + (s ^ tsw(d0))] = (bf16_t)(w.w & 0xffff); VT[(d0 + 7) * 72 + (s ^ tsw(d0))] = (bf16_t)(w.w >> 16); }
        if (tid < 128) Dd[it * 128 + tid] = __expf(bc[63 * 128 + tid]);
        __syncthreads();
        const int l15 = lane & 15, q = lane >> 4;
        bf16_t* Uo = (bf16_t*)a.out + (size_t)it * 32768;
        {   const int mt = wave;
            const int kr = mt * 16 + l15; const bf16x8 a0 = *(const bf16x8*)(KT + kr * 72 + ((q * 8) ^ tsw(kr))), a1 = *(const bf16x8*)(KT + kr * 72 + ((32 + q * 8) ^ tsw(kr)));
#pragma unroll
            for (int nt = 0; nt < 16; ++nt) {
                const int vr = nt * 16 + l15; const bf16x8 b0 = *(const bf16x8*)(VT + vr * 72 + ((q * 8) ^ tsw(vr))), b1 = *(const bf16x8*)(VT + vr * 72 + ((32 + q * 8) ^ tsw(vr)));
                f32x4 c = {0.f, 0.f, 0.f, 0.f}; c = mfma16(a0, b0, c); c = mfma16(a1, b1, c);
                *(u64*)(Uo + (nt * 16 + l15) * 128 + mt * 16 + q * 4) = (u64)pk2(c[0], c[1]) | ((u64)pk2(c[2], c[3]) << 32);
            } }
        __syncthreads();
    }
}
__device__ __forceinline__ void gla_g2(const Args& a, int tid) {
    unsigned* US2 = (unsigned*)a.out;
    const float* Dd = (const float*)(a.ws + WS_D);
    const size_t gt = (size_t)blockIdx.x * 512 + tid, GT = (size_t)gridDim.x * 512;
    for (size_t e = gt; e < 65536; e += GT) {
        const int h = (int)(e >> 14), rem2 = (int)(e & 16383), dk = (2 * rem2) & 127, dv = (2 * rem2) >> 7;
        float S0 = 0.f, S1 = 0.f;
        for (int n0 = 0; n0 < 256; n0 += 32) {
            unsigned u[32]; f32x2 d[32];
#pragma unroll
            for (int i = 0; i < 32; ++i) { const int it = (n0 + i) * 4 + h; u[i] = US2[(size_t)it * 16384 + rem2]; d[i] = *(const f32x2*)(Dd + it * 128 + dk); }
#pragma unroll
            for (int i = 0; i < 32; ++i) { const int it = (n0 + i) * 4 + h; US2[(size_t)it * 16384 + rem2] = pk2(S0, S1); S0 = d[i].x * S0 + bflo(u[i]); S1 = d[i].y * S1 + bfhi(u[i]); }
        }
        a.out[O_GSP + (size_t)h * 32768 + dk * 256 + dv] = S0; a.out[O_GSP + (size_t)h * 32768 + (dk + 1) * 256 + dv] = S1;
    }
    for (size_t e2 = gt; e2 < 8 * 65536; e2 += GT) {
        const int b = (int)(e2 >> 16), e = (int)(e2 & 65535), h = e >> 14, rem2 = e & 16383, dk = (2 * rem2) & 127, dv = (2 * rem2) >> 7;
        const int it = (256 + b) * 4 + h;
        const size_t so = ((size_t)(b * 4 + h) * 128 + dk) * 256 + dv;
        const float S0 = a.in[7][so], S1 = a.in[7][so + 256]; const unsigned u = US2[(size_t)it * 16384 + rem2];
        US2[(size_t)it * 16384 + rem2] = pk2(S0, S1);
        const f32x2 d = *(const f32x2*)(Dd + it * 128 + dk);
        a.out[O_GSS + so] = d.x * S0 + bflo(u); a.out[O_GSS + so + 256] = d.y * S1 + bfhi(u);
    }
}
__device__ __forceinline__ void gla_g3(const Args& a, unsigned char* lds, int tid, int lane, int wave) {
    bf16_t* P = (bf16_t*)(a.ws + WS_P);
    const float* bc = (const float*)(lds + L_BC);
    bf16_t* Q = (bf16_t*)(lds + L_A);
    bf16_t* Kk = (bf16_t*)(lds + L_A + 17408);
    bf16_t* VT = (bf16_t*)(lds + L_A + 34816);
    bf16_t* ATS = (bf16_t*)(lds + L_A + 71680);
    float* RS = (float*)(lds + L_A + 80896);
    const int l15 = lane & 15, q = lane >> 4;
    for (int it = gridDim.x - 1 - blockIdx.x; it < NCH * 4; it += gridDim.x) {
        const int n = it >> 2, h = it & 3;
        { const f32x4* bcg = (const f32x4*)(a.ws + WS_BC) + (size_t)it * 2048; f32x4* bcl = (f32x4*)(lds + L_BC);
#pragma unroll
          for (int i = 0; i < 4; ++i) bcl[tid + 512 * i] = bcg[tid + 512 * i]; }
        __syncthreads();
        for (int ch = tid; ch < 1024; ch += 512) { const int s = ch >> 4, d0 = (ch & 15) * 8; float v[8], o[8];
            unpack8(*(const u32x4*)(P + (size_t)(n * 64 + s) * NP + C_GQ + h * 128 + d0), v);
#pragma unroll
            for (int i = 0; i < 8; ++i) o[i] = v[i] * 0.08838834764831845f * __expf(bc[s * 128 + d0 + i]);
            *(u32x4*)(Q + s * 136 + d0) = pack8(o);
            unpack8(*(const u32x4*)(P + (size_t)(n * 64 + s) * NP + C_GK + h * 128 + d0), v);
#pragma unroll
            for (int i = 0; i < 8; ++i) o[i] = v[i] * __expf(-bc[s * 128 + d0 + i]);
            *(u32x4*)(Kk + s * 136 + d0) = pack8(o); }
        for (int ch = tid; ch < 2048; ch += 512) { const int s = ch >> 5, d0 = (ch & 31) * 8; const u32x4 w = *(const u32x4*)(P + (size_t)(n * 64 + s) * NP + C_GV + h * 256 + d0);
            VT[(d0 + 0) * 72 + (s ^ tsw(d0))] = (bf16_t)(w.x & 0xffff); VT[(d0 + 1) * 72 + (s ^ tsw(d0))] = (bf16_t)(w.x >> 16); VT[(d0 + 2) * 72 + (s ^ tsw(d0))] = (bf16_t)(w.y & 0xffff); VT[(d0 + 3) * 72 + (s ^ tsw(d0))] = (bf16_t)(w.y >> 16);
            VT[(d0 + 4) * 72 + (s ^ tsw(d0))] = (bf16_t)(w.z & 0xffff); VT[(d0 + 5) * 72 + (s ^ tsw(d0))] = (bf16_t)(w.z >> 16); VT[(d0 + 6) * 72 + (s ^ tsw(d0))] = (bf16_t)(w.w & 0xffff); VT[(d0 + 7) * 72 + (s ^ tsw(d0))] = (bf16_t)(w.w >> 16); }
        __syncthreads();
#pragma unroll
        for (int ti = 0; ti < 2; ++ti) { const int id = wave * 2 + ti, mt = id >> 2, nt = id & 3;
            f32x4 c = {0.f, 0.f, 0.f, 0.f};
#pragma unroll
            for (int ks = 0; ks < 4; ++ks) c = mfma16(*(const bf16x8*)(Q + (mt * 16 + l15) * 136 + ks * 32 + q * 8), *(const bf16x8*)(Kk + (nt * 16 + l15) * 136 + ks * 32 + q * 8), c);
#pragma unroll
            for (int j = 0; j < 4; ++j) { const int t = mt * 16 + q * 4 + j, s = nt * 16 + l15; ATS[t * 72 + s] = (bf16_t)f2bf(s <= t ? c[j] : 0.f); } }
        __syncthreads();
        const int mt = wave & 3, half = wave >> 2;
        bf16_t grv[4][8];
#pragma unroll
        for (int j = 0; j < 4; ++j)
#pragma unroll
            for (int i = 0; i < 8; ++i) grv[j][i] = P[(size_t)(n * 64 + mt * 16 + q * 4 + j) * NP + C_GR + h * 256 + (half * 8 + i) * 16 + l15];
        f32x4 acc[8];
#pragma unroll
        for (int i = 0; i < 8; ++i) acc[i] = (f32x4){0.f, 0.f, 0.f, 0.f};
        const bf16_t* Sg = (const bf16_t*)a.out + (size_t)it * 32768;
#pragma unroll
        for (int ks = 0; ks < 4; ++ks) { const bf16x8 aq = *(const bf16x8*)(Q + (mt * 16 + l15) * 136 + ks * 32 + q * 8);
#pragma unroll
            for (int i = 0; i < 8; ++i) acc[i] = mfma16(aq, *(const bf16x8*)(Sg + ((half * 8 + i) * 16 + l15) * 128 + ks * 32 + q * 8), acc[i]); }
#pragma unroll
        for (int ks = 0; ks < 2; ++ks) { const bf16x8 at = *(const bf16x8*)(ATS + (mt * 16 + l15) * 72 + ks * 32 + q * 8);
#pragma unroll
            for (int i = 0; i < 8; ++i) { const int vr = (half * 8 + i) * 16 + l15; acc[i] = mfma16(at, *(const bf16x8*)(VT + vr * 72 + ((ks * 32 + q * 8) ^ tsw(vr))), acc[i]); } }
        float ssq[4];
#pragma unroll
        for (int j = 0; j < 4; ++j) { float s = 0.f;
#pragma unroll
            for (int i = 0; i < 8; ++i) s += acc[i][j] * acc[i][j];
            s += __shfl_xor(s, 1); s += __shfl_xor(s, 2); s += __shfl_xor(s, 4); s += __shfl_xor(s, 8); ssq[j] = s; }
        if (l15 == 0) {
#pragma unroll
            for (int j = 0; j < 4; ++j) RS[(mt * 16 + q * 4 + j) * 2 + half] = ssq[j]; }
        __syncthreads();
#pragma unroll
        for (int j = 0; j < 4; ++j) { const int t = mt * 16 + q * 4 + j; const float rstd = rsqrtf((RS[t * 2] + RS[t * 2 + 1]) * (1.f / 256.f) + EPS);
            bf16_t* prow = P + (size_t)(n * 64 + t) * NP;
#pragma unroll
            for (int i = 0; i < 8; ++i) { const int dv = (half * 8 + i) * 16 + l15; const float gr = bf1(grv[j][i]);
                prow[1024 + h * 256 + dv] = (bf16_t)f2bf(acc[i][j] * rstd * a.in[18][dv] * siluf(gr)); } }
        __syncthreads();
    }
}

__device__ __forceinline__ unsigned mono_key(float f) { const unsigned u = __builtin_bit_cast(unsigned, f); return (u & 0x80000000u) ? ~u : (u | 0x80000000u); }
template <int NE> __device__ __forceinline__ unsigned select_kth(const unsigned (&e)[NE], int kth, int lowbit = 0) {
    unsigned mx = 0u, mn = 0xFFFFFFFFu;
#pragma unroll
    for (int j = 0; j < NE; ++j) { mx = max(mx, e[j]); mn = min(mn, e[j] ? e[j] : 0xFFFFFFFFu); }
#pragma unroll
    for (int o = 1; o < 64; o <<= 1) { mx = max(mx, (unsigned)__shfl_xor((int)mx, o)); mn = min(mn, (unsigned)__shfl_xor((int)mn, o)); }
    const unsigned dif = mx ^ mn;
    const int hb = dif ? 31 - __clz((int)dif) : -1;
    unsigned tau = hb >= 31 ? 0u : (hb < 0 ? mx : (mx & ~((2u << hb) - 1u)));
    for (int bit = hb; bit >= lowbit; --bit) { const unsigned cand = tau | (1u << bit); int c = 0;
#pragma unroll
        for (int j = 0; j < NE; ++j) c += __popcll(__ballot(e[j] >= cand));
        if (c >= kth) tau = cand; }
    return tau;
}
__device__ __forceinline__ unsigned compact1024(unsigned* base, int n, int lane, int lowbit, int& newcnt) {
    unsigned e[16];
#pragma unroll
    for (int j = 0; j < 16; ++j) { const int i = j * 64 + lane; e[j] = i < n ? base[i] : 0u; }
    const unsigned tau = select_kth<16>(e, 256, lowbit);
    const u64 lt = (1ull << lane) - 1ull; int run = 0;
#pragma unroll
    for (int j = 0; j < 16; ++j) { const bool p = e[j] >= tau; const u64 m = __ballot(p); if (p) base[run + __popcll(m & lt)] = e[j]; run += __popcll(m); }
    newcnt = run;
    return tau;
}
__device__ __forceinline__ void compact_final(unsigned* base, int n, int lane, int& newcnt) {
    unsigned e[16];
#pragma unroll
    for (int j = 0; j < 16; ++j) { const int i = j * 64 + lane; e[j] = i < n ? base[i] : 0u; }
    const unsigned t18 = select_kth<16>(e, 256, 14) >> 14;
    int cgt = 0;
#pragma unroll
    for (int j = 0; j < 16; ++j) cgt += __popcll(__ballot((e[j] >> 14) > t18));
    const int need = 256 - cgt;
    const u64 lt = (1ull << lane) - 1ull; int run = 0, trun = 0;
#pragma unroll
    for (int j = 0; j < 16; ++j) { const bool gt = (e[j] >> 14) > t18, tie = (e[j] >> 14) == t18 && e[j] != 0u;
        const u64 mt = __ballot(tie); const int trank = trun + __popcll(mt & lt);
        const bool keep = gt || (tie && trank < need);
        const u64 mk = __ballot(keep); if (keep) base[run + __popcll(mk & lt)] = e[j]; run += __popcll(mk); trun += __popcll(mt); }
    newcnt = run;
}
__device__ __forceinline__ const bf16_t* ik_row(const bf16_t* IKC, const bf16_t* CIK, bool sample, int b, int k) {
    if (!sample) return IKC + (size_t)k * 64;
    return k < 1024 ? CIK + (size_t)(b * 1024 + k) * 64 : IKC + (size_t)(TP + b * 64 + (k - 1024)) * 64;
}
__device__ __forceinline__ float relu_i(float x) { const int b = __builtin_bit_cast(int, x); return __builtin_bit_cast(float, b > 0 ? b : 0); }
constexpr int IDX_TAB_N = 3;
__device__ const unsigned short IDX_TAB[256][IDX_TAB_N] = {{510,8,65535},{511,10,65535},{506,17,65535},{509,15,65535},{508,13,65535},{507,19,65535},{504,21,65535},{505,20,65535},{502,18,65535},{503,22,65535},{500,24,65535},{501,23,65535},{498,26,65535},{499,27,65535},{496,28,65535},{497,29,65535},{492,526,65535},{495,31,65535},{494,30,65535},{493,525,65535},{490,522,65535},{491,523,65535},{488,520,65535},{485,512,65535},{486,518,65535},{487,519,65535},{483,36,65535},{489,517,65535},{482,34,65535},{481,38,65535},{480,39,65535},{484,35,65535},{478,32,11},{477,33,12},{460,514,25},{479,515,9},{448,516,524},{475,521,14},{472,513,16},{446,37,527},{473,40,4},{471,41,7},{464,45,6},{470,43,5},{474,42,2},{467,47,3},{468,46,0},{465,48,1},{476,44,65535},{463,53,65535},{466,50,65535},{462,51,65535},{458,54,65535},{461,52,65535},{469,49,65535},{457,56,65535},{452,60,65535},{455,57,65535},{456,58,65535},{454,59,65535},{459,55,65535},{453,61,65535},{450,62,65535},{451,63,65535},{449,64,65535},{447,65,65535},{444,66,65535},{445,67,65535},{442,68,65535},{443,69,65535},{440,70,65535},{441,71,65535},{438,72,65535},{439,73,65535},{436,74,65535},{437,75,65535},{434,76,65535},{435,77,65535},{432,78,65535},{433,79,65535},{430,80,65535},{431,81,65535},{428,82,65535},{429,83,65535},{426,84,65535},{427,85,65535},{424,86,65535},{425,87,65535},{422,88,65535},{423,89,65535},{420,90,65535},{421,91,65535},{418,92,65535},{419,93,65535},{416,94,65535},{417,95,65535},{414,96,65535},{415,97,65535},{412,98,65535},{413,99,65535},{410,100,65535},{411,101,65535},{408,102,65535},{409,103,65535},{406,104,65535},{407,105,65535},{404,106,65535},{405,107,65535},{402,108,65535},{403,109,65535},{400,110,65535},{401,111,65535},{398,112,65535},{399,113,65535},{396,114,65535},{397,115,65535},{394,116,65535},{395,117,65535},{392,118,65535},{393,119,65535},{390,120,65535},{391,121,65535},{388,122,65535},{389,123,65535},{386,124,65535},{387,125,65535},{384,126,65535},{385,127,65535},{382,128,65535},{383,129,65535},{380,130,65535},{381,131,65535},{378,132,65535},{379,133,65535},{376,134,65535},{377,135,65535},{374,136,65535},{375,137,65535},{372,138,65535},{373,139,65535},{370,140,65535},{371,141,65535},{368,142,65535},{369,143,65535},{366,144,65535},{367,145,65535},{364,146,65535},{365,147,65535},{362,148,65535},{363,149,65535},{360,150,65535},{361,151,65535},{358,152,65535},{359,153,65535},{356,154,65535},{357,155,65535},{354,156,65535},{355,157,65535},{352,158,65535},{353,159,65535},{350,160,65535},{351,161,65535},{348,162,65535},{349,163,65535},{346,164,65535},{347,165,65535},{344,166,65535},{345,167,65535},{342,168,65535},{343,169,65535},{340,170,65535},{341,171,65535},{338,172,65535},{339,173,65535},{336,174,65535},{337,175,65535},{334,176,65535},{335,177,65535},{332,178,65535},{333,179,65535},{330,180,65535},{331,181,65535},{328,182,65535},{329,183,65535},{326,184,65535},{327,185,65535},{324,186,65535},{325,187,65535},{322,188,65535},{323,189,65535},{320,190,65535},{321,191,65535},{318,192,65535},{319,193,65535},{316,194,65535},{317,195,65535},{314,196,65535},{315,197,65535},{312,198,65535},{313,199,65535},{310,200,65535},{311,201,65535},{308,202,65535},{309,203,65535},{306,204,65535},{307,205,65535},{304,206,65535},{305,207,65535},{302,208,65535},{303,209,65535},{300,210,65535},{301,211,65535},{298,212,65535},{299,213,65535},{296,214,65535},{297,215,65535},{294,216,65535},{295,217,65535},{292,218,65535},{293,219,65535},{290,220,65535},{291,221,65535},{288,222,65535},{289,223,65535},{286,224,65535},{287,225,65535},{284,226,65535},{285,227,65535},{282,228,65535},{283,229,65535},{280,230,65535},{281,231,65535},{278,232,65535},{279,233,65535},{276,234,65535},{277,235,65535},{274,236,65535},{275,237,65535},{272,238,65535},{273,239,65535},{270,240,65535},{271,241,65535},{268,242,65535},{269,243,65535},{266,244,65535},{267,245,65535},{264,246,65535},{265,247,65535},{262,248,65535},{263,249,65535},{260,250,65535},{261,251,65535},{258,252,65535},{259,253,65535},{256,254,65535},{257,255,65535}};
constexpr int IKP = 144;
__device__ __forceinline__ void idx_phase(const Args& a, unsigned char* lds, int tid, int lane, int wave) {
    const bf16_t* P = (const bf16_t*)(a.ws + WS_P); const bf16_t* CIK = (const bf16_t*)(a.ws + WS_CIK); const bf16_t* IKC = (const bf16_t*)(a.ws + WS_IKC);
    unsigned* CAND = (unsigned*)(a.ws + WS_ACT);
    unsigned* lst = (unsigned*)(lds + wave * 16384);
    unsigned char* kbuf = lds + 131072;
    const int r = lane & 31, hf = lane >> 5;
    const int qsel = (r >> 2) & 1, head = (r & 3) + 4 * (r >> 3);
    const int skey = tid >> 3, schk = tid & 7;
    const bool use_tab = gridDim.x == 256;
    for (int kk = 0; ; ++kk) {
        int id;
        if (use_tab) { if (kk >= IDX_TAB_N) break; id = IDX_TAB[blockIdx.x][kk]; if (id == 0xFFFF) break; }
        else { const int it = blockIdx.x + kk * gridDim.x; if (it >= 528) break;
               id = it < 256 ? (255 - (it >> 1)) * 2 + (it & 1) : (it < 512 ? ((it - 256) >> 1) * 2 + (it & 1) : it); }
        int c, half = id & 1, bb = 0; bool sample = false;
        if (id < 512) c = id >> 1;
        else { sample = true; bb = (id - 512) >> 1; c = 256 + bb; }
        const int L = sample ? 1088 : 64 * (c + 1), ntile = L >> 6;
        const int t0 = c * 64 + half * 32 + wave * 4;
        bf16x8 af[2][4]; float w[2][16];
#pragma unroll
        for (int rb = 0; rb < 2; ++rb) {
            const bf16_t* qp = P + (size_t)(t0 + 2 * rb + qsel) * NP + C_IQ + head * 64 + hf * 8;
#pragma unroll
            for (int ks = 0; ks < 4; ++ks) af[rb][ks] = *(const bf16x8*)(qp + ks * 16);
            const bf16_t* wp = P + (size_t)(t0 + 2 * rb + hf) * NP + C_IW;
            unpack8(*(const u32x4*)wp, w[rb]); unpack8(*(const u32x4*)(wp + 8), w[rb] + 8);
        }
        unsigned tau[2], cnt[2];
#pragma unroll
        for (int rb = 0; rb < 2; ++rb) { tau[rb] = 0u; cnt[rb] = 0u; }
        { const u32x4 v = *(const u32x4*)(ik_row(IKC, CIK, sample, bb, skey) + schk * 8); *(u32x4*)(kbuf + skey * IKP + schk * 16) = v; }
        u32x4 p1 = {0u, 0u, 0u, 0u}, p2 = p1, p3 = p1;
        if (1 < ntile) p1 = *(const u32x4*)(ik_row(IKC, CIK, sample, bb, 1 * 64 + skey) + schk * 8);
        if (2 < ntile) p2 = *(const u32x4*)(ik_row(IKC, CIK, sample, bb, 2 * 64 + skey) + schk * 8);
        if (3 < ntile) p3 = *(const u32x4*)(ik_row(IKC, CIK, sample, bb, 3 * 64 + skey) + schk * 8);
        __syncthreads();
#define IDX_MFMA8(ACC, KBP, SUB) do { bf16x8 bfr[4]; \
            _Pragma("unroll") for (int ks = 0; ks < 4; ++ks) bfr[ks] = *(const bf16x8*)((KBP) + ((SUB) * 32 + r) * IKP + ks * 32 + hf * 16); \
            _Pragma("unroll") for (int i = 0; i < 16; ++i) { ACC[0][i] = 0.f; ACC[1][i] = 0.f; } \
            __builtin_amdgcn_s_setprio(1); \
            _Pragma("unroll") for (int ks = 0; ks < 4; ++ks) { ACC[0] = __builtin_amdgcn_mfma_f32_32x32x16_bf16(af[0][ks], bfr[ks], ACC[0], 0, 0, 0); ACC[1] = __builtin_amdgcn_mfma_f32_32x32x16_bf16(af[1][ks], bfr[ks], ACC[1], 0, 0, 0); } \
            __builtin_amdgcn_s_setprio(0); } while (0)
#define IDX_SCORE(ACC, ENT, KEY) do { _Pragma("unroll") for (int rb = 0; rb < 2; ++rb) { float s0 = 0.f, s1 = 0.f; \
            _Pragma("unroll") for (int i = 0; i < 16; i += 2) { s0 += relu_i(ACC[rb][i]) * w[rb][i]; s1 += relu_i(ACC[rb][i + 1]) * w[rb][i + 1]; } \
            ENT[rb] = (mono_key(s0 + s1) & 0xFFFFC000u) | (KEY); } } while (0)
#define IDX_INTERLEAVE() do { _Pragma("unroll") for (int i_ = 0; i_ < 8; ++i_) { __builtin_amdgcn_sched_group_barrier(0x008, 1, 0); __builtin_amdgcn_sched_group_barrier(0x002, 9, 0); } } while (0)
#define IDX_INSERT(ENT) do { _Pragma("unroll") for (int rb = 0; rb < 2; ++rb) { \
            const unsigned ent = ENT[rb]; const bool p = ent > tau[rb]; const u64 m = __ballot(p); \
            if (m) { const unsigned mh = hf ? (unsigned)(m >> 32) : (unsigned)m; \
                if (p) lst[(2 * rb + hf) * 1024 + cnt[rb] + __popc(mh & ((1u << r) - 1u))] = ent; \
                cnt[rb] += __popc(mh); \
                if (__any(cnt[rb] > 992u)) { \
                    _Pragma("unroll") for (int hh = 0; hh < 2; ++hh) { const int cc = __builtin_amdgcn_readlane((int)cnt[rb], hh * 32); \
                        if (cc > 992) { int nc; const unsigned nt_ = compact1024(lst + (2 * rb + hh) * 1024, cc, lane, 14, nc); if (hf == hh) { tau[rb] = nt_; cnt[rb] = (unsigned)nc; } } } } } } } while (0)
        f32x16 accA[2], accB[2];
        IDX_MFMA8(accA, kbuf, 0);
        for (int tl = 0; tl < ntile; ++tl) {
            u32x4 p4 = {0u, 0u, 0u, 0u};
            if (tl + 4 < ntile) p4 = *(const u32x4*)(ik_row(IKC, CIK, sample, bb, (tl + 4) * 64 + skey) + schk * 8);
            const unsigned char* kb = kbuf + (tl & 1) * (64 * IKP);
            const unsigned char* kbn = kbuf + ((tl + 1) & 1) * (64 * IKP);
            unsigned entA[2], entB[2];
            IDX_MFMA8(accB, kb, 1);
            IDX_SCORE(accA, entA, (unsigned)(tl * 64 + r));
            IDX_INTERLEAVE();
            IDX_INSERT(entA);
            if (tl + 1 < ntile) *(u32x4*)(kbuf + ((tl + 1) & 1) * (64 * IKP) + skey * IKP + schk * 16) = p1;
            __syncthreads();
            if (tl + 1 < ntile) { IDX_MFMA8(accA, kbn, 0); IDX_SCORE(accB, entB, (unsigned)(tl * 64 + 32 + r)); IDX_INTERLEAVE(); }
            else { IDX_SCORE(accB, entB, (unsigned)(tl * 64 + 32 + r)); }
            IDX_INSERT(entB);
            if (tl == 14 || tl == 50 || tl == 174) {
#pragma unroll
                for (int rb = 0; rb < 2; ++rb)
#pragma unroll
                    for (int hh = 0; hh < 2; ++hh) { const int cc = __builtin_amdgcn_readlane((int)cnt[rb], hh * 32);
                        if (cc > 256) { int nc; const unsigned nt_ = compact1024(lst + (2 * rb + hh) * 1024, cc, lane, 14, nc); if (hf == hh) { tau[rb] = nt_; cnt[rb] = (unsigned)nc; } } }
            }
            p1 = p2; p2 = p3; p3 = p4;
        }
#pragma unroll
        for (int rb = 0; rb < 2; ++rb)
#pragma unroll
            for (int hh = 0; hh < 2; ++hh) { int cc = __builtin_amdgcn_readlane((int)cnt[rb], hh * 32); unsigned* base = lst + (2 * rb + hh) * 1024;
                if (cc > 256) { int nc; compact_final(base, cc, lane, nc); cc = nc; }
                unsigned* dst = CAND + (size_t)(t0 + 2 * rb + hh) * 256;
                for (int j = lane; j < cc; j += 64) dst[j] = base[j]; }
    }
}

__device__ __forceinline__ void attn_phase(const Args& a, unsigned char* lds, int lane, int wave) {
    bf16_t* P = (bf16_t*)(a.ws + WS_P);
    const unsigned char* KV8 = a.ws + WS_KV8; const unsigned char* CKV8 = a.ws + WS_CKV8;
    const unsigned* CAND = (const unsigned*)(a.ws + WS_ACT);
    unsigned* sel = (unsigned*)(lds + 122880 + wave * 1024);
    const int gw = blockIdx.x * 8 + wave, NGW = gridDim.x * 8;
    for (int t = gw; t < TT; t += NGW) {
        const bool sample = t >= TP; const int bb = sample ? (t - TP) >> 6 : 0;
        const int c = t >> 6; const int L = sample ? 1088 : 64 * (c + 1);
        const int nsel = min(256, L);
        const unsigned* cand = CAND + (size_t)t * 256;
#pragma unroll
        for (int j = 0; j < 4; ++j) { const int i = j * 64 + lane; if (i < nsel) sel[i] = cand[i] & 0x3FFFu; }
        bf16_t* qp = P + (size_t)t * NP + lane * 16;
        float q[16]; unpack8(*(const u32x4*)qp, q); unpack8(*(const u32x4*)(qp + 8), q + 8);
        float mx = -INFINITY, l = 0.f, o[16];
#pragma unroll
        for (int d = 0; d < 16; ++d) o[d] = 0.f;
        for (int j = 0; j < nsel; j += 8) {
            const u32x4 ida = *(const u32x4*)(sel + j), idb = *(const u32x4*)(sel + j + 4);
            u32x4 kk[8], vv[8];
#pragma unroll
            for (int i = 0; i < 8; ++i) { const int idx = (int)(i < 4 ? ida[i & 3] : idb[i & 3]); const unsigned char* kp;
                if (!sample) kp = KV8 + (size_t)idx * 2048;
                else if (idx < 1024) kp = CKV8 + (size_t)(bb * 1024 + idx) * 2048;
                else kp = KV8 + (size_t)(TP + bb * 64 + idx - 1024) * 2048;
                kk[i] = *(const u32x4*)(kp + lane * 16); vv[i] = *(const u32x4*)(kp + 1024 + lane * 16); }
            float s[8];
#pragma unroll
            for (int i = 0; i < 8; ++i) { float kf[16]; unpack16_fp8(kk[i], kf); float d0 = 0.f, d1 = 0.f;
#pragma unroll
                for (int x = 0; x < 16; x += 2) { d0 += q[x] * kf[x]; d1 += q[x + 1] * kf[x + 1]; }
                float d = d0 + d1;
                d += __shfl_xor(d, 1); d += __shfl_xor(d, 2); d += __shfl_xor(d, 4); s[i] = d; }
            const float mn = fmaxf(fmaxf(fmaxf(mx, fmaxf(s[0], s[1])), fmaxf(s[2], s[3])), fmaxf(fmaxf(s[4], s[5]), fmaxf(s[6], s[7])));
            const float al = __builtin_amdgcn_exp2f(mx - mn);
            float p[8];
#pragma unroll
            for (int i = 0; i < 8; ++i) p[i] = __builtin_amdgcn_exp2f(s[i] - mn);
            l = l * al + ((p[0] + p[1]) + (p[2] + p[3])) + ((p[4] + p[5]) + (p[6] + p[7]));
#pragma unroll
            for (int d = 0; d < 16; ++d) o[d] *= al;
#pragma unroll
            for (int i = 0; i < 8; ++i) { float vf[16]; unpack16_fp8(vv[i], vf);
#pragma unroll
                for (int d = 0; d < 16; ++d) o[d] += p[i] * vf[d]; }
            mx = mn;
        }
        const float il = 1.f / l;
#pragma unroll
        for (int d = 0; d < 16; ++d) o[d] *= il;
        *(u32x4*)qp = pack8(o); *(u32x4*)(qp + 8) = pack8(o + 8);
    }
}

__device__ __forceinline__ void fixup_phase(const Args& a, int tid) {
    const bf16_t* Uf = (const bf16_t*)(a.ws + WS_UF); const bf16_t* Uh = (const bf16_t*)(a.ws + WS_UH);
    bf16_t* ACTF = (bf16_t*)(a.ws + WS_P);
    const float* wconv = a.in[21]; const float* bconv = a.in[22];
    const size_t gt = (size_t)blockIdx.x * 512 + tid, GT = (size_t)gridDim.x * 512;
    for (size_t e = gt; e < (size_t)NCH * DFF; e += GT) {
        const int g = (int)(e / DFF), ch = (int)(e % DFF);
        float pa[2], pb[2];
        if (g >= 256) { const float* st = a.in[8] + (size_t)(g - 256) * 2 * NUP; pa[0] = st[ch]; pa[1] = st[NUP + ch]; pb[0] = st[DFF + ch]; pb[1] = st[NUP + DFF + ch]; }
        else if (g == 0) { pa[0] = pa[1] = pb[0] = pb[1] = 0.f; }
        else { const bf16_t* st = Uh + (size_t)(g - 1) * 2 * NUP; pa[0] = bf1(st[ch]); pa[1] = bf1(st[NUP + ch]); pb[0] = bf1(st[DFF + ch]); pb[1] = bf1(st[NUP + DFF + ch]); }
        const bf16_t* uf = Uf + (size_t)g * 2 * NUP;
        const float a0 = bf1(uf[ch]), a1 = bf1(uf[NUP + ch]), b0 = bf1(uf[DFF + ch]), b1 = bf1(uf[NUP + DFF + ch]);
        const float wa0 = wconv[ch], wa1 = wconv[NUP + ch], wa2 = wconv[2 * NUP + ch], ba = bconv[ch];
        const float wb0 = wconv[DFF + ch], wb1 = wconv[NUP + DFF + ch], wb2 = wconv[2 * NUP + DFF + ch], bb = bconv[DFF + ch];
        const float ca0 = ba + wa2 * a0 + wa1 * pa[1] + wa0 * pa[0], cb0 = bb + wb2 * b0 + wb1 * pb[1] + wb0 * pb[0];
        const float ca1 = ba + wa2 * a1 + wa1 * a0 + wa0 * pa[1], cb1 = bb + wb2 * b1 + wb1 * b0 + wb0 * pb[1];
        ACTF[(size_t)(g * 64) * DFF + ch] = (bf16_t)f2bf(siluf(ca0) * cb0);
        ACTF[(size_t)(g * 64 + 1) * DFF + ch] = (bf16_t)f2bf(siluf(ca1) * cb1);
    }
    for (size_t e = gt; e < (size_t)9 * 2 * NUP; e += GT) {
        const int s = (int)(e / (2 * NUP)), rem = (int)(e % (2 * NUP));
        const int g = s == 0 ? 255 : 255 + s;
        const float v = bf1(Uh[(size_t)g * 2 * NUP + rem]);
        if (s == 0) a.out[O_FCP + rem] = v; else a.out[O_FCS + (size_t)(s - 1) * 2 * NUP + rem] = v;
    }
}

#define LAS __attribute__((address_space(3)))
#define XB_TMO      128
#define XB_XCNT(j)  (256  + 64 * (j))
#define XB_XSUB(j)  (1280 + 64 * (j))
#define XB_XGEN(j)  (2304 + 64 * (j))
#define XB_TOP      3328
#define XB_TOPGEN   3392
#define XCD_BAR_WORDS 3456
#define XB_SPIN_CAP (1u << 18)

__device__ __forceinline__ unsigned xb_ld(unsigned* p)              { return __hip_atomic_load(p, __ATOMIC_RELAXED, __HIP_MEMORY_SCOPE_AGENT); }
__device__ __forceinline__ unsigned xb_add(unsigned* p, unsigned v) { return __hip_atomic_fetch_add(p, v, __ATOMIC_RELAXED, __HIP_MEMORY_SCOPE_AGENT); }
__device__ __forceinline__ unsigned xb_xcc_id() { return (unsigned)__builtin_amdgcn_s_getreg((3 << 11) | 20) & 0xFu; }
#define XB_SPIN(cond, bar) do { unsigned _sp = 0; while (cond) { __builtin_amdgcn_s_sleep(1); \
    if ((++_sp & 255u) == 0u) { if (xb_ld(&(bar)[XB_TMO])) break; if (_sp > XB_SPIN_CAP) { atomicAdd(&(bar)[XB_TMO], 1u); break; } } } } while (0)

struct XcdBarrier {
    unsigned* bar; unsigned x;
    volatile LAS unsigned* st;
};

__device__ __forceinline__ XcdBarrier xcd_barrier_post(unsigned* bar, volatile LAS unsigned* st) {
    XcdBarrier b; b.bar = bar; b.x = xb_xcc_id(); b.st = st;
    if (threadIdx.x == 0) (void)xb_add(&bar[XB_XCNT(b.x)], 1u);
    return b;
}
__device__ __forceinline__ void xcd_barrier_complete(unsigned* bar, unsigned x, unsigned& nloc, unsigned& nx) {
    const unsigned G = gridDim.x * gridDim.y * gridDim.z;
    unsigned sum, cnt, mine, sp = 0u;
    for (;;) {
        sum = 0u; cnt = 0u; mine = 0u;
#pragma unroll
        for (unsigned j = 0; j < 16; ++j) { const unsigned c = xb_ld(&bar[XB_XCNT(j)]); sum += c; cnt += (c > 0u) ? 1u : 0u; mine = (j == x) ? c : mine; }
        if (sum == G) break;
        __builtin_amdgcn_s_sleep(1);
        if ((++sp & 255u) == 0u) { if (xb_ld(&bar[XB_TMO])) break; if (sp > XB_SPIN_CAP) { atomicAdd(&bar[XB_TMO], 1u); break; } }
    }
    nloc = mine > 0u ? mine : 1u; nx = cnt > 0u ? cnt : 1u;
}

__device__ __forceinline__ void xcd_barrier(const XcdBarrier& b) {
    asm volatile("s_waitcnt vmcnt(0)" ::: "memory");
    __syncthreads();
    if (threadIdx.x == 0) {
        unsigned* bar = b.bar;
        __builtin_amdgcn_s_waitcnt(0);
        unsigned nloc = b.st[0], nx = b.st[1];
        if (nloc == 0u) { xcd_barrier_complete(bar, b.x, nloc, nx); b.st[0] = nloc; b.st[1] = nx; }
        const unsigned old = xb_add(&bar[XB_XSUB(b.x)], 1u);
        const unsigned gen = old / nloc;
        if (old + 1u == (gen + 1u) * nloc) {
            __builtin_amdgcn_fence(__ATOMIC_RELEASE, "agent");
            asm volatile("s_waitcnt vmcnt(0)" ::: "memory");
            const unsigned og = xb_add(&bar[XB_TOP], 1u);
            const unsigned tg = og / nx;
            if (og + 1u == (tg + 1u) * nx) xb_add(&bar[XB_TOPGEN], 1u);
            else XB_SPIN(xb_ld(&bar[XB_TOPGEN]) == tg, bar);
            __builtin_amdgcn_fence(__ATOMIC_ACQUIRE, "agent");
            xb_add(&bar[XB_XGEN(b.x)], 1u);
            asm volatile("s_waitcnt vmcnt(0)" ::: "memory");
        } else {
            XB_SPIN(xb_ld(&bar[XB_XGEN(b.x)]) == gen, bar);
            __builtin_amdgcn_fence(__ATOMIC_ACQUIRE, "agent");
            asm volatile("s_waitcnt vmcnt(0)" ::: "memory");
        }
    }
    __syncthreads();
}

__global__ void __launch_bounds__(512, 2) mega_fwd(Args a) {
    extern __shared__ __attribute__((aligned(16))) unsigned char lds[];
    cg::grid_group grid = cg::this_grid();
    const int tid = threadIdx.x, lane = tid & 63, wave = __builtin_amdgcn_readfirstlane(tid >> 6);
    unsigned char* ws = a.ws;
    const float* MOD = (const float*)(ws + WS_MOD);
#ifndef ONLY_PH
#define ONLY_PH -1
#endif
#define PHON(k) ((ONLY_PH < 0 || ONLY_PH == (k)) && lo <= (k) && (k) <= hi)
    volatile LAS unsigned* bst = (volatile LAS unsigned*)((PG8_LAS unsigned char*)lds + (LDS_BYTES - 64));
    if (tid == 0) { bst[0] = 0u; bst[1] = 0u; }
    __syncthreads();
    const XcdBarrier xbar = xcd_barrier_post((unsigned*)(ws + WS_CTL) + 1024, bst);
    if (a.ph_lo > NPHASE) grid.sync();
#define SEAM(k) do { if ((k) < hi) xcd_barrier(xbar); } while (0)
    const int lo = a.ph_lo, hi = a.ph_hi;
    if (PHON(0)) { phase0(a, lds, tid, lane, wave);
        SEAM(0); }
    if (PHON(1)) { normmod_phase(a.in[0], a.in[1], a.in[11], MOD, 0 * DM, 1 * DM, (bf16_t*)(ws + WS_ACT), lane, wave); SEAM(1); }
    if (PHON(2)) {
        pg8::Gemm g{(const bf16_t*)(ws + WS_ACT), (const bf16_t*)(ws + WS_WIN), TT, NP, DM, DM}; pg8::StaticOrder S; S.init(TT, NP, gridDim.x, blockIdx.x);
        EpiP E{(bf16_t*)(ws + WS_P), NP};
        pg8::gemm_phase<EpiP, pg8::StaticOrder, true, true>((PG8_LAS unsigned char*)lds, g, S, E);
        { int rank, count; if (gemm_tail_rank(S.nwg, rank, count)) tail_wout(a, lds, rank, count, lane, wave); else if (count <= 0 && blockIdx.x == 0) tail_wout(a, lds, 0, 1, lane, wave); }
        SEAM(2);
    }
    const bool swap_order = ((blockIdx.x >> 3) & 1) != 0;
    if (PHON(3)) {
        if (swap_order) { gla_g1(a, lds, tid, lane, wave); __syncthreads(); post_rows(a, lds, tid, lane, wave); }
        else { post_rows(a, lds, tid, lane, wave); gla_g1(a, lds, tid, lane, wave); }
        SEAM(3); }
    if (PHON(4)) { gla_g2(a, tid); idx_phase(a, lds, tid, lane, wave); SEAM(4); }
    if (PHON(5)) {
        attn_phase(a, lds, lane, wave); __syncthreads(); gla_g3(a, lds, tid, lane, wave);
        SEAM(5); }
    if (PHON(6)) {
        pg8::Gemm g{(const bf16_t*)(ws + WS_P), (const bf16_t*)(ws + WS_WOUT), TT, DM, DM, NP}; pg8::StaticOrder S; S.init(TT, DM, gridDim.x, blockIdx.x);
        EpiRes E{a.in[0], a.in[1], a.out + O_Y, MOD + 2 * DM};
        pg8::gemm_phase<EpiRes, pg8::StaticOrder, true, true>((PG8_LAS unsigned char*)lds, g, S, E);
        { int rank, count; if (gemm_tail_rank(S.nwg, rank, count)) tail_wup_wdn(a, lds, rank, count, lane, wave); else if (count <= 0 && blockIdx.x == 0) tail_wup_wdn(a, lds, 0, 1, lane, wave); }
        SEAM(6);
    }
    if (PHON(7)) { normmod_phase(a.out + O_Y, a.out + O_Y + (size_t)TP * DM, a.in[12], MOD, 3 * DM, 4 * DM, (bf16_t*)(ws + WS_ACT), lane, wave); SEAM(7); }
    if (PHON(8)) {
        pg8::Gemm g{(const bf16_t*)(ws + WS_ACT), (const bf16_t*)(ws + WS_WUP), TT, NUP, DM, DM}; pg8::StaticOrder S; S.init(TT, NUP, gridDim.x, blockIdx.x);
        EpiUp E{(bf16_t*)(ws + WS_P), (bf16_t*)(ws + WS_UF), (bf16_t*)(ws + WS_UH), a.in[21], a.in[22]};
        pg8::gemm_phase<EpiUp, pg8::StaticOrder, true, true>((PG8_LAS unsigned char*)lds, g, S, E);
        SEAM(8);
    }
    if (PHON(9)) { fixup_phase(a, tid); SEAM(9); }
    if (PHON(10)) {
        pg8::Gemm g{(const bf16_t*)(ws + WS_P), (const bf16_t*)(ws + WS_WDN), TT, DM, DFF, DFF}; pg8::StaticOrder S; S.init(TT, DM, gridDim.x, blockIdx.x);
        EpiRes E{a.out + O_Y, a.out + O_Y + (size_t)TP * DM, a.out + O_Y, MOD + 5 * DM};
        pg8::gemm_phase<EpiRes, pg8::StaticOrder, true, true>((PG8_LAS unsigned char*)lds, g, S, E);
    }
}

#ifndef MK_MULTI
#define MK_MULTI 0
#endif
extern "C" void kernel_launch(void* const* d_in, const int* in_sizes, int n_in, void* d_out, int out_size, void* d_ws, size_t ws_size, hipStream_t stream) {
    static int grid = 0;
    if (grid == 0) {
        if (n_in != 24 || (size_t)out_size != O_TOTAL || ws_size < WS_END) { fprintf(stderr, "kernel_launch: unexpected shapes: n_in %d out %d ws %zu\n", n_in, out_size, ws_size); grid = -1; return; }
        int dev = 0, cus = 0, per_cu = 0;
        hipGetDevice(&dev); hipDeviceGetAttribute(&cus, hipDeviceAttributeMultiprocessorCount, dev);
        if (hipFuncSetAttribute((const void*)mega_fwd, hipFuncAttributeMaxDynamicSharedMemorySize, LDS_BYTES) != hipSuccess) { fprintf(stderr, "kernel_launch: hipFuncSetAttribute failed\n"); grid = -1; return; }
        hipOccupancyMaxActiveBlocksPerMultiprocessor(&per_cu, (const void*)mega_fwd, 512, LDS_BYTES);
        if (per_cu < 1) per_cu = 1;
        (void)hipGetLastError();
        grid = cus * 1;
        if (grid <= 0) grid = 256;
    }
    if (grid < 0) return;
    hipMemsetAsync((char*)d_ws + WS_CTL, 0, 32768, stream);
    Args a{};
    for (int i = 0; i < 24; ++i) a.in[i] = (const float*)d_in[i];
    a.out = (float*)d_out; a.ws = (unsigned char*)d_ws;
#if MK_MULTI
    for (int ph = 0; ph < NPHASE; ++ph) { a.ph_lo = ph; a.ph_hi = ph; hipLaunchKernelGGL(mega_fwd, dim3(grid), dim3(512), LDS_BYTES, stream, a); }
#else
    a.ph_lo = 0; a.ph_hi = NPHASE - 1;
    void* args[] = {&a};
    hipError_t e = hipLaunchCooperativeKernel((const void*)mega_fwd, dim3(grid), dim3(512), args, LDS_BYTES, stream);
    if (e != hipSuccess) fprintf(stderr, "cooperative launch failed: %s (grid %d)\n", hipGetErrorString(e), grid);
#endif
}
```

```cpp
#include <hip/hip_runtime.h>
#include <hip/hip_cooperative_groups.h>
#include <cstdio>
#include <cstdint>
namespace cg = cooperative_groups;
namespace pg8 {
#define PG8_LAS __attribute__((address_space(3)))
typedef unsigned short bf16_t;
typedef short bf16x8 __attribute__((ext_vector_type(8)));
typedef float f32x4 __attribute__((ext_vector_type(4)));
typedef unsigned u32x4 __attribute__((ext_vector_type(4)));
constexpr int BM = 256, BK = 64, HALF = 128, HTB = HALF * BK * 2  , STAGE_BYTES = 8 * HTB, NXCD = 8, WGM = 8;

__host__ __device__ __forceinline__ int lds_byte(int r, int c) { const int st = (r >> 4) * 2 + (c >> 5), rr = r & 15, cc = c & 31, ob = rr * 64 + cc * 2; return st * 1024 + (ob ^ (((ob >> 9) & 1) << 5)); }
__host__ __device__ __forceinline__ void stage_rc(int b, int& R, int& C) { const int st = b / 1024, sb = b % 1024, swz = sb ^ (((sb >> 9) & 1) << 5); R = (st >> 1) * 16 + swz / 64; C = (st & 1) * 32 + (swz % 64) / 2; }
__host__ __device__ __forceinline__ int perm32(int rho) { const int n = rho >> 4, i = rho & 15; return 8 * (i >> 2) + 4 * n + (i & 3); }

struct Unit { int pm, pn; };
struct Gemm { const bf16_t* A; const bf16_t* Bt; int M, N, K, lda; };

struct StaticOrder {
    int nM, nN, nwg, G, c;
    __host__ __device__ void init(int M, int N, int G_, int c_) { nM = M / BM; nN = N / BM; nwg = nM * nN; G = G_; c = c_; }
    __host__ __device__ bool next(int i, Unit& u) const {
        const long L = (long)i * G + c; if (L >= nwg) return false;
        int wgid = (int)L; { const int q = nwg / NXCD, r = nwg % NXCD, xcd = wgid % NXCD, off = wgid / NXCD; wgid = (xcd < r ? xcd * (q + 1) : r * (q + 1) + (xcd - r) * q) + off; }
        const int nig = WGM * nN, gid = wgid / nig, fm = gid * WGM, gsz = (nM - fm) < WGM ? (nM - fm) : WGM;
        u.pm = fm + ((wgid % nig) % gsz); u.pn = (wgid % nig) / gsz; return true;
    }
    __device__ __forceinline__ void a_ready(const Unit&) const {}
    __device__ __forceinline__ void done(const Unit&) const {}
};

__device__ __forceinline__ unsigned cvt_pk_bf16(float lo, float hi) { unsigned r; asm volatile("v_cvt_pk_bf16_f32 %0, %1, %2" : "=v"(r) : "v"(lo), "v"(hi)); return r; }
template <class Epi, class Sched, bool ALIGN_EPI = false, bool SP2 = false>
__device__ __forceinline__ void gemm_phase(PG8_LAS unsigned char* lds, const Gemm g, const Sched& S, const Epi& E) {
    const int tid = threadIdx.x, wid = __builtin_amdgcn_readfirstlane(tid >> 6), lane = tid & 63, wr = wid >> 2, wc = wid & 3, fr = lane & 15, fq = lane >> 4;
    const int K = g.K, nt = K / BK;
    unsigned voffA[2], voffB[2];
#pragma unroll
    for (int i = 0; i < 2; ++i) { int R, C; stage_rc(tid * 16 + i * 8192, R, C); const int Rb = Epi::PERM ? ((R & ~31) + perm32(R & 31)) : R;
        voffA[i] = (unsigned)(R * g.lda + C) * 2u; voffB[i] = (unsigned)(Rb * K + C) * 2u; }
    const size_t kstep = (size_t)(BK * 2);
    const size_t hstepA = (size_t)HALF * g.lda * 2, hstepB = (size_t)HALF * K * 2;
    const size_t tstepA = 2 * hstepA, tstepB = 2 * hstepB;
    const unsigned ldsw = (unsigned)wid * 1024u;
    const int aoff = lds_byte(wr * 64 + fr, fq * 8), boff = lds_byte(wc * 32 + fr, fq * 8);
#define PG8_SA(b, h) (((b) * 2 + (h)) * HTB)
#define PG8_SB(b, h) ((4 + (b) * 2 + (h)) * HTB)
#define PG8_STAGE(bufoff, gbase, voff) do { _Pragma("unroll") for (int _i = 0; _i < 2; ++_i) \
        __builtin_amdgcn_global_load_lds((const unsigned*)((const char*)(gbase) + (voff)[_i]), (PG8_LAS unsigned*)(lds + (bufoff) + ldsw + _i * 8192), 16, 0, 0); } while (0)
#define PG8_LDA(dst, b, h) do { _Pragma("unroll") for (int m = 0; m < 4; ++m) _Pragma("unroll") for (int k = 0; k < 2; ++k) dst[m][k] = *(const PG8_LAS bf16x8*)(lds + PG8_SA(b, h) + aoff + m * 2048 + k * 1024); } while (0)
#define PG8_LDB(dst, b, h) do { _Pragma("unroll") for (int n = 0; n < 2; ++n) _Pragma("unroll") for (int k = 0; k < 2; ++k) dst[n][k] = *(const PG8_LAS bf16x8*)(lds + PG8_SB(b, h) + boff + n * 2048 + k * 1024); } while (0)
#define PG8_MMA(ai, bj, At, Bt) do { __builtin_amdgcn_s_setprio(1); _Pragma("unroll") for (int m = 0; m < 4; ++m) _Pragma("unroll") for (int n = 0; n < 2; ++n) _Pragma("unroll") for (int k = 0; k < 2; ++k) \
        acc[ai][bj][m][n] = __builtin_amdgcn_mfma_f32_16x16x32_bf16(Bt[n][k], At[m][k], acc[ai][bj][m][n], 0, 0, 0); __builtin_amdgcn_s_setprio(0); } while (0)
#define PG8_WAIT_V(n) asm volatile("s_waitcnt vmcnt(" #n ")" ::: "memory")
#define PG8_WAIT_L(n) asm volatile("s_waitcnt lgkmcnt(" #n ")" ::: "memory")
#define PG8_BAR __builtin_amdgcn_s_barrier()
#define PG8_SCHED __builtin_amdgcn_sched_barrier(0)
    Unit cur, nxt; int ui = 0;
    if (!S.next(0, cur)) return;
    f32x4 acc[2][2][4][2];
#pragma unroll
    for (int a = 0; a < 2; ++a)
#pragma unroll
        for (int b = 0; b < 2; ++b)
#pragma unroll
            for (int m = 0; m < 4; ++m)
#pragma unroll
                for (int n = 0; n < 2; ++n) acc[a][b][m][n] = (f32x4){0.f, 0.f, 0.f, 0.f};
    bf16x8 At[4][2], B0[2][2], B1[2][2];
    const char* cA = (const char*)g.A + (size_t)cur.pm * tstepA; const char* cB = (const char*)g.Bt + (size_t)cur.pn * tstepB;
    S.a_ready(cur);
    if constexpr (SP2) {
        PG8_STAGE(PG8_SB(0, 0), cB, voffB); PG8_STAGE(PG8_SB(0, 1), cB + hstepB, voffB); PG8_STAGE(PG8_SA(0, 0), cA, voffA); PG8_STAGE(PG8_SA(0, 1), cA + hstepA, voffA);
        if (wr == 1) PG8_BAR;
        PG8_WAIT_V(2); PG8_BAR;
        PG8_STAGE(PG8_SB(1, 0), cB + kstep, voffB); PG8_STAGE(PG8_SA(1, 0), cA + kstep, voffA); PG8_STAGE(PG8_SB(1, 1), cB + hstepB + kstep, voffB);
        PG8_WAIT_V(6); PG8_BAR;
    } else {
        PG8_STAGE(PG8_SB(0, 0), cB, voffB); PG8_STAGE(PG8_SA(0, 0), cA, voffA); PG8_STAGE(PG8_SB(0, 1), cB + hstepB, voffB); PG8_STAGE(PG8_SA(0, 1), cA + hstepA, voffA);
        if (wr == 1) PG8_BAR;
        PG8_WAIT_V(4); PG8_BAR;
        PG8_STAGE(PG8_SB(1, 0), cB + kstep, voffB); PG8_STAGE(PG8_SA(1, 0), cA + kstep, voffA); PG8_STAGE(PG8_SB(1, 1), cB + hstepB + kstep, voffB);
        PG8_WAIT_V(6); PG8_BAR;
    }
    for (;;) {
        const bool has_next = S.next(ui + 1, nxt);
        const char* nA = has_next ? (const char*)g.A + (size_t)nxt.pm * tstepA : cA; const char* nB = has_next ? (const char*)g.Bt + (size_t)nxt.pn * tstepB : cB;
        for (int t = 0; t < nt; t += 2) {
            const bool last = (t == nt - 2);
            const char* a1 = cA + (size_t)(t + 1) * kstep;
            const char* a2 = last ? nA : cA + (size_t)(t + 2) * kstep; const char* b2 = last ? nB : cB + (size_t)(t + 2) * kstep;
            const char* a3 = a2 + kstep; const char* b3 = b2 + kstep;
            if (last && has_next) S.a_ready(nxt);
            if constexpr (SP2) {
            PG8_LDB(B0, 0, 0); PG8_LDB(B1, 0, 1); PG8_SCHED; PG8_LDA(At, 0, 0); PG8_STAGE(PG8_SA(1, 1), a1 + hstepA, voffA);
            PG8_WAIT_V(8); PG8_WAIT_L(0); PG8_BAR; PG8_MMA(0, 0, At, B0); PG8_MMA(0, 1, At, B1); PG8_BAR; PG8_SCHED;
            PG8_LDA(At, 0, 1); PG8_STAGE(PG8_SB(0, 0), b2, voffB); PG8_STAGE(PG8_SB(0, 1), b2 + hstepB, voffB); PG8_STAGE(PG8_SA(0, 0), a2, voffA);
            PG8_WAIT_V(8); PG8_WAIT_L(0); PG8_BAR; PG8_MMA(1, 0, At, B0); PG8_MMA(1, 1, At, B1); PG8_BAR; PG8_SCHED;
            PG8_LDB(B0, 1, 0); PG8_LDB(B1, 1, 1); PG8_SCHED; PG8_LDA(At, 1, 0); PG8_STAGE(PG8_SA(0, 1), a2 + hstepA, voffA);
            PG8_WAIT_V(8); PG8_WAIT_L(0); PG8_BAR; PG8_MMA(0, 0, At, B0); PG8_MMA(0, 1, At, B1); PG8_BAR; PG8_SCHED;
            PG8_LDA(At, 1, 1); PG8_STAGE(PG8_SB(1, 0), b3, voffB); PG8_STAGE(PG8_SB(1, 1), b3 + hstepB, voffB); PG8_STAGE(PG8_SA(1, 0), a3, voffA);
            PG8_WAIT_V(8); PG8_WAIT_L(0); PG8_BAR; PG8_MMA(1, 0, At, B0); PG8_MMA(1, 1, At, B1); PG8_BAR; PG8_SCHED;
            } else {
            PG8_LDB(B0, 0, 0); PG8_SCHED; PG8_LDA(At, 0, 0); PG8_STAGE(PG8_SA(1, 1), a1 + hstepA, voffA);
            PG8_WAIT_L(8); PG8_BAR; PG8_WAIT_L(0); PG8_MMA(0, 0, At, B0); PG8_BAR; PG8_SCHED;
            PG8_LDB(B1, 0, 1); PG8_STAGE(PG8_SB(0, 0), b2, voffB);
            PG8_BAR; PG8_WAIT_L(0); PG8_MMA(0, 1, At, B1); PG8_BAR;
            PG8_LDA(At, 0, 1); PG8_STAGE(PG8_SA(0, 0), a2, voffA);
            PG8_BAR; PG8_WAIT_L(0); PG8_MMA(1, 0, At, B0); PG8_BAR; PG8_SCHED;
            PG8_STAGE(PG8_SB(0, 1), b2 + hstepB, voffB);
            PG8_WAIT_V(6); PG8_BAR; PG8_MMA(1, 1, At, B1); PG8_BAR;
            PG8_LDB(B0, 1, 0); PG8_SCHED; PG8_LDA(At, 1, 0); PG8_STAGE(PG8_SA(0, 1), a2 + hstepA, voffA);
            PG8_WAIT_L(8); PG8_BAR; PG8_WAIT_L(0); PG8_MMA(0, 0, At, B0); PG8_BAR; PG8_SCHED;
            PG8_LDB(B1, 1, 1); PG8_STAGE(PG8_SB(1, 0), b3, voffB);
            PG8_BAR; PG8_WAIT_L(0); PG8_MMA(0, 1, At, B1); PG8_BAR;
            PG8_LDA(At, 1, 1); PG8_STAGE(PG8_SA(1, 0), a3, voffA);
            PG8_BAR; PG8_WAIT_L(0); PG8_MMA(1, 0, At, B0); PG8_BAR; PG8_SCHED;
            PG8_STAGE(PG8_SB(1, 1), b3 + hstepB, voffB);
            PG8_WAIT_V(6); PG8_BAR; PG8_MMA(1, 1, At, B1); PG8_BAR;
            }
        }
        if constexpr (ALIGN_EPI) { if (wr == 0) PG8_BAR; }
        if constexpr (!Epi::AFTER_DRAIN) { E(acc, cur, wr, wc, fr, fq); S.done(cur); }
        if (!has_next) break;
#pragma unroll
        for (int a = 0; a < 2; ++a)
#pragma unroll
            for (int b = 0; b < 2; ++b)
#pragma unroll
                for (int m = 0; m < 4; ++m)
#pragma unroll
                    for (int n = 0; n < 2; ++n) acc[a][b][m][n] = (f32x4){0.f, 0.f, 0.f, 0.f};
        cur = nxt; cA = nA; cB = nB; ++ui;
        if constexpr (ALIGN_EPI) { if (wr == 1) PG8_BAR; }
    }
    PG8_WAIT_V(0);
    if constexpr (!ALIGN_EPI) { if (wr == 0) PG8_BAR; }
    PG8_BAR;
    if constexpr (Epi::AFTER_DRAIN) { E.fused(acc, cur, wr, wc, fr, fq, lds, wid, lane); S.done(cur); }
#undef PG8_SA
#undef PG8_SB
#undef PG8_STAGE
#undef PG8_LDA
#undef PG8_LDB
#undef PG8_MMA
#undef PG8_WAIT_V
#undef PG8_WAIT_L
#undef PG8_BAR
#undef PG8_SCHED
}
}
using pg8::bf16_t; using pg8::bf16x8; using pg8::f32x4; using pg8::u32x4;
typedef float f32x16 __attribute__((ext_vector_type(16)));
typedef unsigned long long u64;

constexpr int DM = 2048, TP = 16384, TS = 512, TT = TP + TS, NBATCH = 9, MODW = 6 * DM;
constexpr int NP = 7424;
constexpr int C_AQ = 0, C_IQ = 1024, C_AK = 2048, C_AV = 3072, C_GQ = 4096, C_GK = 4608, C_GV = 5120, C_GR = 6144, C_IK = 7168, C_IW = 7232, C_GLR = 7248, C_END = 7264;
constexpr int DFF = 5632, NUP = 11264, WIN_N = 7264;
constexpr int NCH = 264;
constexpr float EPS = 1e-6f;
constexpr size_t O_Y = 0, O_KP = 34603008, O_VP = 51380224, O_IKP = 68157440, O_GSP = 69206016, O_FCP = 69337088,
                 O_KS = 69359616, O_VS = 69883904, O_IKS = 70408192, O_GSS = 70440960, O_FCS = 71489536, O_TOTAL = 71669760;
constexpr size_t MiB = 1u << 20;
constexpr size_t WS_CTL = 0, WS_MOD = 1 * MiB, WS_D = 2 * MiB, WS_WIN = 4 * MiB, WS_WOUT = 33 * MiB, WS_WUP = 41 * MiB, WS_WDN = 85 * MiB,
                 WS_ACT = 107 * MiB, WS_P = 173 * MiB, WS_CK = 413 * MiB, WS_CV = 429 * MiB, WS_CIK = 445 * MiB, WS_KV8 = 446 * MiB, WS_CKV8 = 479 * MiB, WS_END = 495 * MiB;
constexpr size_t WS_BC = WS_WUP;
constexpr size_t WS_IKC = WS_CK;
constexpr size_t WS_UF = WS_CK, WS_UH = WS_CK + 12 * MiB;
constexpr int LDS_BYTES = 149568;
constexpr int NPHASE = 11;
constexpr int IDX_ITEMS = 5184;

struct Args { const float* in[24]; float* out; unsigned char* ws; int ph_lo, ph_hi; };

__device__ __forceinline__ unsigned f2bf(float f) { unsigned u = __builtin_bit_cast(unsigned, f); return (u + 0x7fffu + ((u >> 16) & 1u)) >> 16; }
typedef float f32x2v __attribute__((ext_vector_type(2))); typedef __bf16 bf16x2v __attribute__((ext_vector_type(2)));
__device__ __forceinline__ unsigned pk2(float lo, float hi) { const f32x2v v = {lo, hi}; const bf16x2v b = __builtin_convertvector(v, bf16x2v); return __builtin_bit_cast(unsigned, b); }
__device__ __forceinline__ float bflo(unsigned w) { return __builtin_bit_cast(float, w << 16); }
__device__ __forceinline__ float bfhi(unsigned w) { return __builtin_bit_cast(float, w & 0xffff0000u); }
__device__ __forceinline__ float bf1(bf16_t h) { return __builtin_bit_cast(float, ((unsigned)h) << 16); }
__device__ __forceinline__ void unpack8(u32x4 w, float* v) { v[0] = bflo(w.x); v[1] = bfhi(w.x); v[2] = bflo(w.y); v[3] = bfhi(w.y); v[4] = bflo(w.z); v[5] = bfhi(w.z); v[6] = bflo(w.w); v[7] = bfhi(w.w); }
__device__ __forceinline__ u32x4 pack8(const float* v) { u32x4 w; w.x = pk2(v[0], v[1]); w.y = pk2(v[2], v[3]); w.z = pk2(v[4], v[5]); w.w = pk2(v[6], v[7]); return w; }
__device__ __forceinline__ float wave_sum(float v) {
#pragma unroll
    for (int o = 1; o < 64; o <<= 1) v += __shfl_xor(v, o);
    return v;
}
__device__ __forceinline__ float siluf(float x) { return x * __builtin_amdgcn_rcpf(1.f + __expf(-x)); }
typedef float f32x2 __attribute__((ext_vector_type(2)));
__device__ __forceinline__ unsigned pk4_fp8(float a, float b, float c, float d) { int w = 0; w = __builtin_amdgcn_cvt_pk_fp8_f32(a, b, w, false); w = __builtin_amdgcn_cvt_pk_fp8_f32(c, d, w, true); return (unsigned)w; }
__device__ __forceinline__ u32x4 pack16_fp8(const float* v) { u32x4 w; w.x = pk4_fp8(v[0], v[1], v[2], v[3]); w.y = pk4_fp8(v[4], v[5], v[6], v[7]); w.z = pk4_fp8(v[8], v[9], v[10], v[11]); w.w = pk4_fp8(v[12], v[13], v[14], v[15]); return w; }
__device__ __forceinline__ void unpack16_fp8(u32x4 w, float* v) {
#pragma unroll
    for (int i = 0; i < 4; ++i) { const f32x2 lo = __builtin_amdgcn_cvt_pk_f32_fp8((int)w[i], false), hi = __builtin_amdgcn_cvt_pk_f32_fp8((int)w[i], true); v[4 * i] = lo.x; v[4 * i + 1] = lo.y; v[4 * i + 2] = hi.x; v[4 * i + 3] = hi.y; }
}

template <int MAPID> __device__ __forceinline__ int colmap(int n) {
    if (MAPID == 0) return n;
    if (MAPID == 1) {
        if (n < 1024) return n;
        if (n < 2048) return 3072 + (n - 1024);
        if (n < 3072) return 1024 + (n - 2048);
        if (n < 4096) return 2048 + (n - 3072);
        if (n < 4608) return 4176 + (n - 4096);
        if (n < 5120) return 4688 + (n - 4608);
        if (n < 6144) return 5200 + (n - 5120);
        if (n < 7168) return 6224 + (n - 6144);
        if (n < 7232) return 4096 + (n - 7168);
        if (n < 7248) return 4160 + (n - 7232);
        if (n < 7264) return n;
        return -1;
    }
    { const int pn = n >> 8, w = n & 255; return w < 128 ? pn * 128 + w : DFF + pn * 128 + (w - 128); }
}
template <int MAPID> __device__ __forceinline__ void transpose_item(const float* __restrict__ W, int K, int Nsrc, bf16_t* __restrict__ WT, int nblk, float* scr, int item, int lane) {
    const int kb = item / nblk, nb = item % nblk, k0 = 64 * kb, n0 = 32 * nb;
    const int srcc = colmap<MAPID>(n0 + (lane & 31));
#pragma unroll 8
    for (int i = 0; i < 32; ++i) { const int kk = 2 * i + (lane >> 5); scr[kk * 33 + (lane & 31)] = srcc >= 0 ? W[(size_t)(k0 + kk) * Nsrc + srcc] : 0.f; }
    asm volatile("s_waitcnt lgkmcnt(0)" ::: "memory");
    const int c = lane & 7;
#pragma unroll
    for (int j = 0; j < 4; ++j) { const int n = (lane >> 3) + 8 * j; const float* s = scr + (8 * c) * 33 + n;
        u32x4 o; o.x = pk2(s[0 * 33], s[1 * 33]); o.y = pk2(s[2 * 33], s[3 * 33]); o.z = pk2(s[4 * 33], s[5 * 33]); o.w = pk2(s[6 * 33], s[7 * 33]);
        *(u32x4*)(WT + (size_t)(n0 + n) * K + k0 + 8 * c) = o; }
    asm volatile("s_waitcnt lgkmcnt(0)" ::: "memory");
}

__device__ __forceinline__ void phase0(const Args& a, unsigned char* lds, int tid, int lane, int wave) {
    unsigned char* ws = a.ws;
    if ((int)blockIdx.x < 192 || gridDim.x < 192) {
        float* sc = (float*)lds;
        float* red = (float*)(lds + 73728);
        for (int i = tid; i < NBATCH * DM; i += 512) { const int b = i >> 11, k = i & 2047; const float c = b == 0 ? a.in[2][k] : a.in[3][(b - 1) * DM + k]; sc[i] = c / (1.f + __expf(-c)); }
        __syncthreads();
        for (int item = blockIdx.x; item < 192; item += gridDim.x) {
            const int col = item * 64 + lane, k0 = wave * 256;
            float acc[NBATCH];
#pragma unroll
            for (int b = 0; b < NBATCH; ++b) acc[b] = 0.f;
            const float* wp = a.in[9] + (size_t)k0 * MODW + col;
            for (int k = 0; k < 256; k += 32) {
                float wv[32];
#pragma unroll
                for (int i = 0; i < 32; ++i) wv[i] = wp[(size_t)(k + i) * MODW];
#pragma unroll
                for (int i = 0; i < 32; ++i)
#pragma unroll
                    for (int b = 0; b < NBATCH; ++b) acc[b] += sc[b * DM + k0 + k + i] * wv[i]; }
#pragma unroll
            for (int b = 0; b < NBATCH; ++b) red[(wave * NBATCH + b) * 64 + lane] = acc[b];
            __syncthreads();
            for (int i = tid; i < NBATCH * 64; i += 512) { const int b = i >> 6, l = i & 63; float s = a.in[10][item * 64 + l];
#pragma unroll
                for (int w = 0; w < 8; ++w) s += red[(w * NBATCH + b) * 64 + l];
                ((float*)(ws + WS_MOD))[b * MODW + item * 64 + l] = s; }
            __syncthreads();
        }
    }
    __syncthreads();
    {
        float* scr = (float*)(lds + wave * 8448);
        const int gw = blockIdx.x * 8 + wave, NGW = gridDim.x * 8;
        constexpr int I_IN = 32 * (NP / 32);
        for (int it = gw; it < I_IN; it += NGW) transpose_item<1>(a.in[13], DM, WIN_N, (bf16_t*)(ws + WS_WIN), NP / 32, scr, it, lane);
    }
    {
        const size_t gt = (size_t)blockIdx.x * 512 + tid, GT = (size_t)gridDim.x * 512;
        for (size_t i = gt; i < 8388608 / 16; i += GT) {
            const size_t row = i >> 6, chk = i & 63; float v[16];
            const f32x4* s = (const f32x4*)(a.in[4] + row * 1024 + chk * 16);
#pragma unroll
            for (int j = 0; j < 4; ++j) { const f32x4 x = s[j]; v[4 * j] = x.x; v[4 * j + 1] = x.y; v[4 * j + 2] = x.z; v[4 * j + 3] = x.w; }
            *(u32x4*)(ws + WS_CKV8 + row * 2048 + chk * 16) = pack16_fp8(v);
            s = (const f32x4*)(a.in[5] + row * 1024 + chk * 16);
#pragma unroll
            for (int j = 0; j < 4; ++j) { const f32x4 x = s[j]; v[4 * j] = x.x; v[4 * j + 1] = x.y; v[4 * j + 2] = x.z; v[4 * j + 3] = x.w; }
            *(u32x4*)(ws + WS_CKV8 + row * 2048 + 1024 + chk * 16) = pack16_fp8(v); }
        for (size_t i = gt; i < 524288 / 8; i += GT) {
            const f32x4* s = (const f32x4*)a.in[6] + 2 * i; f32x4 x = s[0], y = s[1]; u32x4 o; o.x = pk2(x.x, x.y); o.y = pk2(x.z, x.w); o.z = pk2(y.x, y.y); o.w = pk2(y.z, y.w); ((u32x4*)(ws + WS_CIK))[i] = o; }
    }
}

__device__ __forceinline__ bool gemm_tail_rank(int nwg, int& rank, int& count) {
    const int G = gridDim.x, c = blockIdx.x, rounds = (nwg + G - 1) / G, nbusy = nwg - (rounds - 1) * G;
    rank = c - nbusy; count = G - nbusy; return c >= nbusy;
}
__device__ __forceinline__ void tail_wout(const Args& a, unsigned char* lds, int rank, int count, int lane, int wave) {
    float* scr = (float*)(lds + wave * 8448);
    for (int it = rank * 8 + wave; it < 32 * 64; it += count * 8) transpose_item<0>(a.in[19], DM, DM, (bf16_t*)(a.ws + WS_WOUT), 64, scr, it, lane);
}
__device__ __forceinline__ void tail_wup_wdn(const Args& a, unsigned char* lds, int rank, int count, int lane, int wave) {
    float* scr = (float*)(lds + wave * 8448);
    constexpr int I_UP = 32 * (NUP / 32), I_DN = (DFF / 64) * 64;
    for (int it = rank * 8 + wave; it < I_UP + I_DN; it += count * 8) {
        if (it < I_UP) transpose_item<2>(a.in[20], DM, NUP, (bf16_t*)(a.ws + WS_WUP), NUP / 32, scr, it, lane);
        else transpose_item<0>(a.in[23], DFF, DM, (bf16_t*)(a.ws + WS_WDN), 64, scr, it - I_UP, lane);
    }
}

__device__ __forceinline__ void normmod_phase(const float* xp, const float* xs, const float* g, const float* mod, int sh_off, int sc_off, bf16_t* dst, int lane, int wave) {
    const int gw = blockIdx.x * 8 + wave, NGW = gridDim.x * 8;
    for (int r = gw; r < TT; r += NGW) {
        const float* xrow = r < TP ? xp + (size_t)r * DM : xs + (size_t)(r - TP) * DM;
        const int b = r < TP ? 0 : 1 + ((r - TP) >> 6);
        const f32x4* xr = (const f32x4*)xrow + lane;
        f32x4 v[8]; float s = 0.f;
#pragma unroll
        for (int j = 0; j < 8; ++j) { v[j] = xr[64 * j]; s += (v[j].x * v[j].x + v[j].y * v[j].y) + (v[j].z * v[j].z + v[j].w * v[j].w); }
        const float rstd = rsqrtf(wave_sum(s) * (1.f / DM) + EPS);
        const f32x4* gp = (const f32x4*)g + lane; const f32x4* scp = (const f32x4*)(mod + (size_t)b * MODW + sc_off) + lane; const f32x4* shp = (const f32x4*)(mod + (size_t)b * MODW + sh_off) + lane;
        u64* o8 = (u64*)(dst + (size_t)r * DM) + lane;
#pragma unroll
        for (int j = 0; j < 8; ++j) { const f32x4 gg = gp[64 * j], sc = scp[64 * j], sh = shp[64 * j];
            const f32x4 y = v[j] * rstd * gg * (sc + 1.f) + sh;
            o8[64 * j] = (u64)pk2(y.x, y.y) | ((u64)pk2(y.z, y.w) << 32); }
    }
}

struct EpiP {
    static constexpr bool PERM = true, AFTER_DRAIN = false;
    bf16_t* O; int ldc;
    __device__ __forceinline__ void operator()(const f32x4 (&acc)[2][2][4][2], const pg8::Unit& u, int wr, int wc, int fr, int fq) const {
        const int row0 = u.pm * 256 + wr * 64 + fr, col0 = u.pn * 256 + wc * 32 + 8 * fq;
#pragma unroll
        for (int ai = 0; ai < 2; ++ai)
#pragma unroll
            for (int m = 0; m < 4; ++m) { bf16_t* rowp = O + (size_t)(row0 + ai * 128 + m * 16) * ldc + col0;
#pragma unroll
                for (int bj = 0; bj < 2; ++bj) { const f32x4 v0 = acc[ai][bj][m][0], v1 = acc[ai][bj][m][1]; u32x4 w;
                    w.x = pg8::cvt_pk_bf16(v0[0], v0[1]); w.y = pg8::cvt_pk_bf16(v0[2], v0[3]); w.z = pg8::cvt_pk_bf16(v1[0], v1[1]); w.w = pg8::cvt_pk_bf16(v1[2], v1[3]);
                    *(u32x4*)(rowp + bj * 128) = w; } }
    }
};
struct EpiRes {
    static constexpr bool PERM = true, AFTER_DRAIN = false;
    const float* srcP; const float* srcS; float* dst; const float* gate;
    __device__ __forceinline__ void operator()(const f32x4 (&acc)[2][2][4][2], const pg8::Unit& u, int wr, int wc, int fr, int fq) const {
        const int col0 = u.pn * 256 + wc * 32 + 8 * fq;
#pragma unroll
        for (int ai = 0; ai < 2; ++ai)
#pragma unroll
            for (int m = 0; m < 4; ++m) {
                const int row = u.pm * 256 + ai * 128 + wr * 64 + m * 16 + fr;
                const int b = row < TP ? 0 : 1 + ((row - TP) >> 6);
                const float* sp = (row < TP ? srcP + (size_t)row * DM : srcS + (size_t)(row - TP) * DM) + col0;
                const float* gp = gate + (size_t)b * MODW + col0; float* dp = dst + (size_t)row * DM + col0;
#pragma unroll
                for (int bj = 0; bj < 2; ++bj)
#pragma unroll
                    for (int n = 0; n < 2; ++n) { const f32x4 x = *(const f32x4*)(sp + bj * 128 + 4 * n), gg = *(const f32x4*)(gp + bj * 128 + 4 * n);
                        *(f32x4*)(dp + bj * 128 + 4 * n) = x + gg * acc[ai][bj][m][n]; }
            }
    }
};
template <int CTRL> __device__ __forceinline__ float dpp_ror(float v) {
    return __builtin_bit_cast(float, __builtin_amdgcn_update_dpp(0, __builtin_bit_cast(int, v), CTRL, 0xf, 0xf, false));
}
struct EpiUp {
    static constexpr bool PERM = true, AFTER_DRAIN = false;
    bf16_t* ACTF; bf16_t* Uf; bf16_t* Uh; const float* wconv; const float* bconv;
    __device__ __forceinline__ void operator()(const f32x4 (&acc)[2][2][4][2], const pg8::Unit& u, int wr, int wc, int fr, int fq) const {
        const int lane = fr + 16 * fq;
        const int ch0 = u.pn * 128 + wc * 32 + 8 * fq;
        const int src1 = (lane & 48) | ((fr + 15) & 15), src2 = (lane & 48) | ((fr + 14) & 15);
#pragma unroll
        for (int ai = 0; ai < 2; ++ai) {
            const int g = u.pm * 4 + ai * 2 + wr;
            unsigned outp[4][4];
#pragma unroll
            for (int cp = 0; cp < 4; ++cp) {
                float rr[4][2];
#pragma unroll
                for (int ii = 0; ii < 2; ++ii) {
                    const int c8 = 2 * cp + ii, n = c8 >> 2, i = c8 & 3, ch = ch0 + c8;
                    const float wa0 = wconv[ch], wa1 = wconv[NUP + ch], wa2 = wconv[2 * NUP + ch], ba = bconv[ch];
                    const float wb0 = wconv[DFF + ch], wb1 = wconv[NUP + DFF + ch], wb2 = wconv[2 * NUP + DFF + ch], bb = bconv[DFF + ch];
                    float ua[4], ub[4], r1a[4], r2a[4], r1b[4], r2b[4];
#pragma unroll
                    for (int m = 0; m < 4; ++m) { ua[m] = acc[ai][0][m][n][i]; ub[m] = acc[ai][1][m][n][i];
                        r1a[m] = dpp_ror<0x121>(ua[m]); r2a[m] = dpp_ror<0x122>(ua[m]); r1b[m] = dpp_ror<0x121>(ub[m]); r2b[m] = dpp_ror<0x122>(ub[m]); }
#pragma unroll
                    for (int m = 0; m < 4; ++m) {
                        const float p1a = fr >= 1 ? r1a[m] : r1a[(m + 3) & 3], p2a = fr >= 2 ? r2a[m] : r2a[(m + 3) & 3];
                        const float p1b = fr >= 1 ? r1b[m] : r1b[(m + 3) & 3], p2b = fr >= 2 ? r2b[m] : r2b[(m + 3) & 3];
                        const float ca = ba + wa2 * ua[m] + wa1 * p1a + wa0 * p2a;
                        const float cb = bb + wb2 * ub[m] + wb1 * p1b + wb0 * p2b;
                        rr[m][ii] = siluf(ca) * cb;
                    }
                }
#pragma unroll
                for (int m = 0; m < 4; ++m) outp[m][cp] = pg8::cvt_pk_bf16(rr[m][0], rr[m][1]);
            }
#pragma unroll
            for (int m = 0; m < 4; ++m) { const int row = g * 64 + 16 * m + fr;
                u32x4 w; w.x = outp[m][0]; w.y = outp[m][1]; w.z = outp[m][2]; w.w = outp[m][3];
                *(u32x4*)(ACTF + (size_t)row * DFF + ch0) = w; }
            if (fr < 2) { bf16_t* p = Uf + (size_t)(g * 2 + fr) * NUP + ch0;
#pragma unroll
                for (int bj = 0; bj < 2; ++bj) { const f32x4 v0 = acc[ai][bj][0][0], v1 = acc[ai][bj][0][1]; u32x4 w;
                    w.x = pg8::cvt_pk_bf16(v0[0], v0[1]); w.y = pg8::cvt_pk_bf16(v0[2], v0[3]); w.z = pg8::cvt_pk_bf16(v1[0], v1[1]); w.w = pg8::cvt_pk_bf16(v1[2], v1[3]);
                    *(u32x4*)(p + bj * DFF) = w; } }
            if (fr >= 14) { bf16_t* p = Uh + (size_t)(g * 2 + fr - 14) * NUP + ch0;
#pragma unroll
                for (int bj = 0; bj < 2; ++bj) { const f32x4 v0 = acc[ai][bj][3][0], v1 = acc[ai][bj][3][1]; u32x4 w;
                    w.x = pg8::cvt_pk_bf16(v0[0], v0[1]); w.y = pg8::cvt_pk_bf16(v0[2], v0[3]); w.z = pg8::cvt_pk_bf16(v1[0], v1[1]); w.w = pg8::cvt_pk_bf16(v1[2], v1[3]);
                    *(u32x4*)(p + bj * DFF) = w; } }
        }
    }
};

__device__ __forceinline__ void post_rows(const Args& a, unsigned char* lds, int tid, int lane, int wave) {
    double* inv16 = (double*)lds; double* inv8 = inv16 + 16;
    if (tid < 16) inv16[tid] = exp(-(double)tid * (1.0 / 16.0) * 13.122363377404328);
    else if (tid < 24) inv8[tid - 16] = exp(-(double)(tid - 16) * (1.0 / 8.0) * 13.122363377404328);
    __syncthreads();
    bf16_t* P = (bf16_t*)(a.ws + WS_P);
    const float* gq = a.in[14]; const float* gk = a.in[15];
    const int sub = lane & 7;
    float gqv[16], gkv[16];
#pragma unroll
    for (int i = 0; i < 16; ++i) { gqv[i] = gq[sub * 16 + i]; gkv[i] = gk[sub * 16 + i]; }
    const int gw = blockIdx.x * 8 + wave, NGW = gridDim.x * 8;
    for (int r = gw; r < TT; r += NGW) {
        bf16_t* prow = P + (size_t)r * NP;
        const int pos = r < TP ? r : 1024 + ((r - TP) & 63);
        float* kout = r < TP ? a.out + O_KP + (size_t)r * 1024 : a.out + O_KS + (size_t)(r - TP) * 1024;
        float* vout = r < TP ? a.out + O_VP + (size_t)r * 1024 : a.out + O_VS + (size_t)(r - TP) * 1024;
        float* ikout = r < TP ? a.out + O_IKP + (size_t)r * 64 : a.out + O_IKS + (size_t)(r - TP) * 64;
        float cs[16], sn[16];
#pragma unroll
        for (int i = 0; i < 16; ++i) { double rev = (double)pos * inv16[i] * 0.15915494309189535; rev -= rint(rev); const float rf = (float)rev; cs[i] = __builtin_amdgcn_cosf(rf); sn[i] = __builtin_amdgcn_sinf(rf); }
#pragma unroll
        for (int which = 0; which < 2; ++which) {
            bf16_t* p = prow + (which ? C_AK : C_AQ) + lane * 16;
            float v[16]; unpack8(*(const u32x4*)p, v); unpack8(*(const u32x4*)(p + 8), v + 8);
            float ss = 0.f;
#pragma unroll
            for (int i = 0; i < 16; ++i) ss += v[i] * v[i];
            ss += __shfl_xor(ss, 1); ss += __shfl_xor(ss, 2); ss += __shfl_xor(ss, 4);
            const float rstd = rsqrtf(ss * (1.f / 128.f) + EPS);
#pragma unroll
            for (int i = 0; i < 16; ++i) v[i] = v[i] * rstd * (which ? gkv[i] : gqv[i]);
#pragma unroll
            for (int i = 0; i < 16; ++i) { const float pv = __shfl_xor(v[i], 1);
                if (sub == 0) v[i] = v[i] * cs[i] - pv * sn[i]; else if (sub == 1) v[i] = v[i] * cs[i] + pv * sn[i]; }
            if (which) {
#pragma unroll
                for (int i = 0; i < 4; ++i) *(f32x4*)(kout + lane * 16 + 4 * i) = (f32x4){v[4 * i], v[4 * i + 1], v[4 * i + 2], v[4 * i + 3]};
                *(u32x4*)(a.ws + WS_KV8 + (size_t)r * 2048 + lane * 16) = pack16_fp8(v);
            } else {
#pragma unroll
                for (int i = 0; i < 16; ++i) v[i] *= 0.12751743074602468f;
            }
            *(u32x4*)p = pack8(v); *(u32x4*)(p + 8) = pack8(v + 8);
        }
        {
            const bf16_t* p = prow + C_AV + lane * 16; float v[16]; unpack8(*(const u32x4*)p, v); unpack8(*(const u32x4*)(p + 8), v + 8);
#pragma unroll
            for (int i = 0; i < 4; ++i) *(f32x4*)(vout + lane * 16 + 4 * i) = (f32x4){v[4 * i], v[4 * i + 1], v[4 * i + 2], v[4 * i + 3]};
            *(u32x4*)(a.ws + WS_KV8 + (size_t)r * 2048 + 1024 + lane * 16) = pack16_fp8(v);
        }
        float c8[8], s8[8];
#pragma unroll
        for (int i = 0; i < 8; ++i) { double rev = (double)pos * inv8[i] * 0.15915494309189535; rev -= rint(rev); const float rf = (float)rev; c8[i] = __builtin_amdgcn_cosf(rf); s8[i] = __builtin_amdgcn_sinf(rf); }
        {
            bf16_t* p = prow + C_IQ + lane * 16; float v[16]; unpack8(*(const u32x4*)p, v); unpack8(*(const u32x4*)(p + 8), v + 8);
            if ((lane & 3) == 0) {
#pragma unroll
                for (int i = 0; i < 8; ++i) { const float x1 = v[i], x2 = v[i + 8]; v[i] = x1 * c8[i] - x2 * s8[i]; v[i + 8] = x2 * c8[i] + x1 * s8[i]; }
                *(u32x4*)p = pack8(v); *(u32x4*)(p + 8) = pack8(v + 8);
            }
        }
        if (lane < 4) {
            bf16_t* p = prow + C_IK + lane * 16; float v[16]; unpack8(*(const u32x4*)p, v); unpack8(*(const u32x4*)(p + 8), v + 8);
            if (lane == 0) {
#pragma unroll
                for (int i = 0; i < 8; ++i) { const float x1 = v[i], x2 = v[i + 8]; v[i] = x1 * c8[i] - x2 * s8[i]; v[i + 8] = x2 * c8[i] + x1 * s8[i]; }
                *(u32x4*)p = pack8(v); *(u32x4*)(p + 8) = pack8(v + 8);
            }
            { bf16_t* pc = (bf16_t*)(a.ws + WS_IKC) + (size_t)r * 64 + lane * 16; *(u32x4*)pc = pack8(v); *(u32x4*)(pc + 8) = pack8(v + 8); }
#pragma unroll
            for (int i = 0; i < 4; ++i) *(f32x4*)(ikout + lane * 16 + 4 * i) = (f32x4){v[4 * i], v[4 * i + 1], v[4 * i + 2], v[4 * i + 3]};
        }
    }
    __syncthreads();
}

__device__ __forceinline__ f32x4 mfma16(bf16x8 a, bf16x8 b, f32x4 c) { return __builtin_amdgcn_mfma_f32_16x16x32_bf16(a, b, c, 0, 0, 0); }
constexpr int L_GLR = 0, L_BC = 4096, L_TOT = 36864, L_A = 38912;
__device__ __forceinline__ int tsw(int row) { return ((row >> 3) & 7) << 3; }
__device__ __forceinline__ void gla_bcum(const Args& a, unsigned char* lds, int n, int h, int tid) {
    const bf16_t* P = (const bf16_t*)(a.ws + WS_P);
    float* glr = (float*)(lds + L_GLR); float* bc = (float*)(lds + L_BC); float* tot = (float*)(lds + L_TOT);
    for (int e = tid; e < 1024; e += 512) { const int t = e >> 4, rr = e & 15; glr[e] = bf1(P[(size_t)(n * 64 + t) * NP + C_GLR + rr]); }
    __syncthreads();
    const int dk = tid & 127, tq = tid >> 7;
    float w[16];
#pragma unroll
    for (int rr = 0; rr < 16; ++rr) w[rr] = a.in[16][rr * 512 + h * 128 + dk];
    const float bias = a.in[17][h * 128 + dk];
    float run = 0.f;
#pragma unroll 4
    for (int tt = 0; tt < 16; ++tt) { const int t = tq * 16 + tt; float x = bias;
#pragma unroll
        for (int rr = 0; rr < 16; ++rr) x += glr[t * 16 + rr] * w[rr];
        const float ls = fminf(x, 0.f) - log1pf(__expf(-fabsf(x)));
        run += ls * (1.f / 16.f); bc[t * 128 + dk] = run; }
    tot[tq * 128 + dk] = run;
    __syncthreads();
    float off = 0.f;
    for (int g = 0; g < tq; ++g) off += tot[g * 128 + dk];
    if (tq > 0) { for (int tt = 0; tt < 16; ++tt) bc[(tq * 16 + tt) * 128 + dk] += off; }
    __syncthreads();
}
__device__ __forceinline__ void gla_g1(const Args& a, unsigned char* lds, int tid, int lane, int wave) {
    const bf16_t* P = (const bf16_t*)(a.ws + WS_P);
    float* Dd = (float*)(a.ws + WS_D);
    const float* bc = (const float*)(lds + L_BC);
    bf16_t* KT = (bf16_t*)(lds + L_A);
    bf16_t* VT = (bf16_t*)(lds + L_A + 18432);
    for (int it = blockIdx.x; it < NCH * 4; it += gridDim.x) {
        const int n = it >> 2, h = it & 3;
        gla_bcum(a, lds, n, h, tid);
        { f32x4* bcg = (f32x4*)(a.ws + WS_BC) + (size_t)it * 2048;
#pragma unroll
          for (int i = 0; i < 4; ++i) bcg[tid + 512 * i] = ((const f32x4*)bc)[tid + 512 * i]; }
        for (int ch = tid; ch < 1024; ch += 512) { const int s = ch >> 4, d0 = (ch & 15) * 8; float v[8]; unpack8(*(const u32x4*)(P + (size_t)(n * 64 + s) * NP + C_GK + h * 128 + d0), v);
#pragma unroll
            for (int i = 0; i < 8; ++i) KT[(d0 + i) * 72 + (s ^ tsw(d0))] = (bf16_t)f2bf(v[i] * __expf(bc[63 * 128 + d0 + i] - bc[s * 128 + d0 + i])); }
        for (int ch = tid; ch < 2048; ch += 512) { const int s = ch >> 5, d0 = (ch & 31) * 8; const u32x4 w = *(const u32x4*)(P + (size_t)(n * 64 + s) * NP + C_GV + h * 256 + d0);
            VT[(d0 + 0) * 72 + (s ^ tsw(d0))] = (bf16_t)(w.x & 0xffff); VT[(d0 + 1) * 72 + (s ^ tsw(d0))] = (bf16_t)(w.x >> 16); VT[(d0 + 2) * 72 + (s ^ tsw(d0))] = (bf16_t)(w.y & 0xffff); VT[(d0 + 3) * 72 + (s ^ tsw(d0))] = (bf16_t)(w.y >> 16);
            VT[(d0 + 4) * 72 + (s ^ tsw(d0))] = (bf16_t)(w.z & 0xffff); VT[(d0 + 5) * 72 + (s ^ tsw(d0))] = (bf16_t)(w.z >> 16); VT[(d0 + 6) * 72 + (s ^ tsw(d0))] = (bf16_t)(w.w & 0xffff); VT[(d0 + 7) * 72 + (s ^ tsw(d0))] = (bf16_t)(w.w >> 16); }
        if (tid < 128) Dd[it * 128 + tid] = __expf(bc[63 * 128 + tid]);
        __syncthreads();
        const int l15 = lane & 15, q = lane >> 4;
        bf16_t* Uo = (bf16_t*)a.out + (size_t)it * 32768;
        {   const int mt = wave;
            const int kr = mt * 16 + l15; const bf16x8 a0 = *(const bf16x8*)(KT + kr * 72 + ((q * 8) ^ tsw(kr))), a1 = *(const bf16x8*)(KT + kr * 72 + ((32 + q * 8) ^ tsw(kr)));
#pragma unroll
            for (int nt = 0; nt < 16; ++nt) {
                const int vr = nt * 16 + l15; const bf16x8 b0 = *(const bf16x8*)(VT + vr * 72 + ((q * 8) ^ tsw(vr))), b1 = *(const bf16x8*)(VT + vr * 72 + ((32 + q * 8) ^ tsw(vr)));
                f32x4 c = {0.f, 0.f, 0.f, 0.f}; c = mfma16(a0, b0, c); c = mfma16(a1, b1, c);
                *(u64*)(Uo + (nt * 16 + l15) * 128 + mt * 16 + q * 4) = (u64)pk2(c[0], c[1]) | ((u64)pk2(c[2], c[3]) << 32);
            } }
        __syncthreads();
    }
}
__device__ __forceinline__ void gla_g2(const Args& a, int tid) {
    unsigned* US2 = (unsigned*)a.out;
    const float* Dd = (const float*)(a.ws + WS_D);
    const size_t gt = (size_t)blockIdx.x * 512 + tid, GT = (size_t)gridDim.x * 512;
    for (size_t e = gt; e < 65536; e += GT) {
        const int h = (int)(e >> 14), rem2 = (int)(e & 16383), dk = (2 * rem2) & 127, dv = (2 * rem2) >> 7;
        float S0 = 0.f, S1 = 0.f;
        for (int n0 = 0; n0 < 256; n0 += 32) {
            unsigned u[32]; f32x2 d[32];
#pragma unroll
            for (int i = 0; i < 32; ++i) { const int it = (n0 + i) * 4 + h; u[i] = US2[(size_t)it * 16384 + rem2]; d[i] = *(const f32x2*)(Dd + it * 128 + dk); }
#pragma unroll
            for (int i = 0; i < 32; ++i) { const int it = (n0 + i) * 4 + h; US2[(size_t)it * 16384 + rem2] = pk2(S0, S1); S0 = d[i].x * S0 + bflo(u[i]); S1 = d[i].y * S1 + bfhi(u[i]); }
        }
        a.out[O_GSP + (size_t)h * 32768 + dk * 256 + dv] = S0; a.out[O_GSP + (size_t)h * 32768 + (dk + 1) * 256 + dv] = S1;
    }
    for (size_t e2 = gt; e2 < 8 * 65536; e2 += GT) {
        const int b = (int)(e2 >> 16), e = (int)(e2 & 65535), h = e >> 14, rem2 = e & 16383, dk = (2 * rem2) & 127, dv = (2 * rem2) >> 7;
        const int it = (256 + b) * 4 + h;
        const size_t so = ((size_t)(b * 4 + h) * 128 + dk) * 256 + dv;
        const float S0 = a.in[7][so], S1 = a.in[7][so + 256]; const unsigned u = US2[(size_t)it * 16384 + rem2];
        US2[(size_t)it * 16384 + rem2] = pk2(S0, S1);
        const f32x2 d = *(const f32x2*)(Dd + it * 128 + dk);
        a.out[O_GSS + so] = d.x * S0 + bflo(u); a.out[O_GSS + so + 256] = d.y * S1 + bfhi(u);
    }
}
__device__ __forceinline__ void gla_g3(const Args& a, unsigned char* lds, int tid, int lane, int wave) {
    bf16_t* P = (bf16_t*)(a.ws + WS_P);
    const float* bc = (const float*)(lds + L_BC);
    bf16_t* Q = (bf16_t*)(lds + L_A);
    bf16_t* Kk = (bf16_t*)(lds + L_A + 17408);
    bf16_t* VT = (bf16_t*)(lds + L_A + 34816);
    bf16_t* ATS = (bf16_t*)(lds + L_A + 71680);
    float* RS = (float*)(lds + L_A + 80896);
    const int l15 = lane & 15, q = lane >> 4;
    for (int it = gridDim.x - 1 - blockIdx.x; it < NCH * 4; it += gridDim.x) {
        const int n = it >> 2, h = it & 3;
        { const f32x4* bcg = (const f32x4*)(a.ws + WS_BC) + (size_t)it * 2048; f32x4* bcl = (f32x4*)(lds + L_BC);
#pragma unroll
          for (int i = 0; i < 4; ++i) bcl[tid + 512 * i] = bcg[tid + 512 * i]; }
        __syncthreads();
        for (int ch = tid; ch < 1024; ch += 512) { const int s = ch >> 4, d0 = (ch & 15) * 8; float v[8], o[8];
            unpack8(*(const u32x4*)(P + (size_t)(n * 64 + s) * NP + C_GQ + h * 128 + d0), v);
#pragma unroll
            for (int i = 0; i < 8; ++i) o[i] = v[i] * 0.08838834764831845f * __expf(bc[s * 128 + d0 + i]);
            *(u32x4*)(Q + s * 136 + d0) = pack8(o);
            unpack8(*(const u32x4*)(P + (size_t)(n * 64 + s) * NP + C_GK + h * 128 + d0), v);
#pragma unroll
            for (int i = 0; i < 8; ++i) o[i] = v[i] * __expf(-bc[s * 128 + d0 + i]);
            *(u32x4*)(Kk + s * 136 + d0) = pack8(o); }
        for (int ch = tid; ch < 2048; ch += 512) { const int s = ch >> 5, d0 = (ch & 31) * 8; const u32x4 w = *(const u32x4*)(P + (size_t)(n * 64 + s) * NP + C_GV + h * 256 + d0);
            VT[(d0 + 0) * 72 + (s ^ tsw(d0))] = (bf16_t)(w.x & 0xffff); VT[(d0 + 1) * 72 + (s ^ tsw(d0))] = (bf16_t)(w.x >> 16); VT[(d0 + 2) * 72 + (s ^ tsw(d0))] = (bf16_t)(w.y & 0xffff); VT[(d0 + 3) * 72 + (s ^ tsw(d0))] = (bf16_t)(w.y >> 16);
            VT[(d0 + 4) * 72 + (s ^ tsw(d0))] = (bf16_t)(w.z & 0xffff); VT[(d0 + 5) * 72 + (s ^ tsw(d0))] = (bf16_t)(w.z >> 16); VT[(d0 + 6) * 72 + (s ^ tsw(d0))] = (bf16_t)(w.w & 0xffff); VT[(d0 + 7) * 72 + (s ^ tsw(d0))] = (bf16_t)(w.w >> 16); }
        __syncthreads();
#pragma unroll
        for (int ti = 0; ti < 2; ++ti) { const int id = wave * 2 + ti, mt = id >> 2, nt = id & 3;
            f32x4 c = {0.f, 0.f, 0.f, 0.f};
#pragma unroll
            for (int ks = 0; ks < 4; ++ks) c = mfma16(*(const bf16x8*)(Q + (mt * 16 + l15) * 136 + ks * 32 + q * 8), *(const bf16x8*)(Kk + (nt * 16 + l15) * 136 + ks * 32 + q * 8), c);
#pragma unroll
            for (int j = 0; j < 4; ++j) { const int t = mt * 16 + q * 4 + j, s = nt * 16 + l15; ATS[t * 72 + s] = (bf16_t)f2bf(s <= t ? c[j] : 0.f); } }
        __syncthreads();
        const int mt = wave & 3, half = wave >> 2;
        bf16_t grv[4][8];
#pragma unroll
        for (int j = 0; j < 4; ++j)
#pragma unroll
            for (int i = 0; i < 8; ++i) grv[j][i] = P[(size_t)(n * 64 + mt * 16 + q * 4 + j) * NP + C_GR + h * 256 + (half * 8 + i) * 16 + l15];
        f32x4 acc[8];
#pragma unroll
        for (int i = 0; i < 8; ++i) acc[i] = (f32x4){0.f, 0.f, 0.f, 0.f};
        const bf16_t* Sg = (const bf16_t*)a.out + (size_t)it * 32768;
#pragma unroll
        for (int ks = 0; ks < 4; ++ks) { const bf16x8 aq = *(const bf16x8*)(Q + (mt * 16 + l15) * 136 + ks * 32 + q * 8);
#pragma unroll
            for (int i = 0; i < 8; ++i) acc[i] = mfma16(aq, *(const bf16x8*)(Sg + ((half * 8 + i) * 16 + l15) * 128 + ks * 32 + q * 8), acc[i]); }
#pragma unroll
        for (int ks = 0; ks < 2; ++ks) { const bf16x8 at = *(const bf16x8*)(ATS + (mt * 16 + l15) * 72 + ks * 32 + q * 8);
#pragma unroll
            for (int i = 0; i < 8; ++i) { const int vr = (half * 8 + i) * 16 + l15; acc[i] = mfma16(at, *(const bf16x8*)(VT + vr * 72 + ((ks * 32 + q * 8) ^ tsw(vr))), acc[i]); } }
        float ssq[4];
#pragma unroll
        for (int j = 0; j < 4; ++j) { float s = 0.f;
#pragma unroll
            for (int i = 0; i < 8; ++i) s += acc[i][j] * acc[i][j];
            s += __shfl_xor(s, 1); s += __shfl_xor(s, 2); s += __shfl_xor(s, 4); s += __shfl_xor(s, 8); ssq[j] = s; }
        if (l15 == 0) {
#pragma unroll
            for (int j = 0; j < 4; ++j) RS[(mt * 16 + q * 4 + j) * 2 + half] = ssq[j]; }
        __syncthreads();
#pragma unroll
        for (int j = 0; j < 4; ++j) { const int t = mt * 16 + q * 4 + j; const float rstd = rsqrtf((RS[t * 2] + RS[t * 2 + 1]) * (1.f / 256.f) + EPS);
            bf16_t* prow = P + (size_t)(n * 64 + t) * NP;
#pragma unroll
            for (int i = 0; i < 8; ++i) { const int dv = (half * 8 + i) * 16 + l15; const float gr = bf1(grv[j][i]);
                prow[1024 + h * 256 + dv] = (bf16_t)f2bf(acc[i][j] * rstd * a.in[18][dv] * siluf(gr)); } }
        __syncthreads();
    }
}

__device__ __forceinline__ unsigned mono_key(float f) { const unsigned u = __builtin_bit_cast(unsigned, f); return (u & 0x80000000u) ? ~u : (u | 0x80000000u); }
template <int NE> __device__ __forceinline__ unsigned select_kth(const unsigned (&e)[NE], int kth, int lowbit = 0) {
    unsigned mx = 0u, mn = 0xFFFFFFFFu;
#pragma unroll
    for (int j = 0; j < NE; ++j) { mx = max(mx, e[j]); mn = min(mn, e[j] ? e[j] : 0xFFFFFFFFu); }
#pragma unroll
    for (int o = 1; o < 64; o <<= 1) { mx = max(mx, (unsigned)__shfl_xor((int)mx, o)); mn = min(mn, (unsigned)__shfl_xor((int)mn, o)); }
    const unsigned dif = mx ^ mn;
    const int hb = dif ? 31 - __clz((int)dif) : -1;
    unsigned tau = hb >= 31 ? 0u : (hb < 0 ? mx : (mx & ~((2u << hb) - 1u)));
    for (int bit = hb; bit >= lowbit; --bit) { const unsigned cand = tau | (1u << bit); int c = 0;
#pragma unroll
        for (int j = 0; j < NE; ++j) c += __popcll(__ballot(e[j] >= cand));
        if (c >= kth) tau = cand; }
    return tau;
}
__device__ __forceinline__ unsigned compact1024(unsigned* base, int n, int lane, int lowbit, int& newcnt) {
    unsigned e[16];
#pragma unroll
    for (int j = 0; j < 16; ++j) { const int i = j * 64 + lane; e[j] = i < n ? base[i] : 0u; }
    const unsigned tau = select_kth<16>(e, 256, lowbit);
    const u64 lt = (1ull << lane) - 1ull; int run = 0;
#pragma unroll
    for (int j = 0; j < 16; ++j) { const bool p = e[j] >= tau; const u64 m = __ballot(p); if (p) base[run + __popcll(m & lt)] = e[j]; run += __popcll(m); }
    newcnt = run;
    return tau;
}
__device__ __forceinline__ void compact_final(unsigned* base, int n, int lane, int& newcnt) {
    unsigned e[16];
#pragma unroll
    for (int j = 0; j < 16; ++j) { const int i = j * 64 + lane; e[j] = i < n ? base[i] : 0u; }
    const unsigned t18 = select_kth<16>(e, 256, 14) >> 14;
    int cgt = 0;
#pragma unroll
    for (int j = 0; j < 16; ++j) cgt += __popcll(__ballot((e[j] >> 14) > t18));
    const int need = 256 - cgt;
    const u64 lt = (1ull << lane) - 1ull; int run = 0, trun = 0;
#pragma unroll
    for (int j = 0; j < 16; ++j) { const bool gt = (e[j] >> 14) > t18, tie = (e[j] >> 14) == t18 && e[j] != 0u;
        const u64 mt = __ballot(tie); const int trank = trun + __popcll(mt & lt);
        const bool keep = gt || (tie && trank < need);
        const u64 mk = __ballot(keep); if (keep) base[run + __popcll(mk & lt)] = e[j]; run += __popcll(mk); trun += __popcll(mt); }
    newcnt = run;
}
__device__ __forceinline__ const bf16_t* ik_row(const bf16_t* IKC, const bf16_t* CIK, bool sample, int b, int k) {
    if (!sample) return IKC + (size_t)k * 64;
    return k < 1024 ? CIK + (size_t)(b * 1024 + k) * 64 : IKC + (size_t)(TP + b * 64 + (k - 1024)) * 64;
}
__device__ __forceinline__ float relu_i(float x) { const int b = __builtin_bit_cast(int, x); return __builtin_bit_cast(float, b > 0 ? b : 0); }
constexpr int IDX_TAB_N = 3;
__device__ const unsigned short IDX_TAB[256][IDX_TAB_N] = {{401,86,65535},{416,72,65535},{395,101,65535},{393,96,65535},{399,95,65535},{390,100,65535},{391,102,65535},{410,75,65535},{406,80,65535},{384,113,65535},{385,108,65535},{377,121,65535},{388,106,65535},{378,118,65535},{371,127,65535},{381,114,65535},{369,132,65535},{370,126,65535},{374,120,65535},{364,135,65535},{373,125,65535},{362,136,65535},{368,133,65535},{354,148,65535},{359,145,65535},{363,138,65535},{356,143,65535},{358,140,65535},{365,139,65535},{360,147,65535},{355,149,65535},{353,152,65535},{350,155,65535},{352,150,65535},{348,156,65535},{347,158,65535},{346,159,65535},{349,157,65535},{344,161,65535},{345,162,65535},{341,166,65535},{343,163,65535},{340,168,65535},{342,164,65535},{338,171,65535},{339,170,65535},{336,172,65535},{337,173,65535},{334,175,65535},{335,174,65535},{332,176,65535},{333,177,65535},{329,180,65535},{331,179,65535},{328,182,65535},{330,178,65535},{326,184,65535},{327,185,65535},{324,186,65535},{325,183,65535},{322,188,65535},{323,189,65535},{320,190,65535},{321,191,65535},{318,192,65535},{319,193,65535},{316,194,65535},{317,195,65535},{314,196,65535},{315,197,65535},{312,198,65535},{313,199,65535},{310,200,65535},{311,201,65535},{308,202,65535},{309,203,65535},{306,204,65535},{307,205,65535},{304,206,65535},{305,207,65535},{302,208,65535},{303,209,65535},{300,210,65535},{301,211,65535},{298,212,65535},{299,213,65535},{296,214,65535},{297,215,65535},{294,216,65535},{295,217,65535},{292,218,65535},{293,219,65535},{290,220,65535},{291,221,65535},{288,222,65535},{289,223,65535},{286,224,65535},{287,225,65535},{284,226,65535},{285,227,65535},{282,228,65535},{283,229,65535},{280,230,65535},{281,231,65535},{278,232,65535},{279,233,65535},{276,234,65535},{277,235,65535},{274,236,65535},{275,237,65535},{272,238,65535},{273,239,65535},{270,240,65535},{271,241,65535},{268,242,65535},{269,243,65535},{266,244,65535},{267,245,65535},{264,246,65535},{265,247,65535},{262,248,65535},{263,249,65535},{260,250,65535},{261,251,65535},{258,252,65535},{259,253,65535},{256,254,65535},{257,255,65535},{508,16,65535},{511,10,65535},{510,12,65535},{509,15,65535},{506,20,65535},{507,19,65535},{504,22,65535},{500,24,65535},{502,23,65535},{503,25,65535},{505,21,65535},{501,27,65535},{498,18,65535},{499,29,65535},{496,30,65535},{497,28,65535},{491,526,65535},{495,527,65535},{492,524,65535},{493,525,65535},{490,522,65535},{494,31,65535},{488,520,65535},{483,513,65535},{486,518,65535},{482,37,65535},{484,516,65535},{489,517,65535},{487,514,65535},{485,515,65535},{480,38,65535},{481,36,65535},{478,32,9},{479,35,3},{472,521,17},{463,519,26},{474,523,11},{476,512,13},{475,33,8},{439,42,34},{470,40,6},{471,39,7},{467,45,4},{469,43,5},{466,47,2},{458,46,14},{464,51,0},{465,49,1},{468,48,65535},{477,41,65535},{460,50,65535},{473,44,65535},{462,52,65535},{461,53,65535},{456,57,65535},{457,55,65535},{454,56,65535},{455,59,65535},{452,58,65535},{459,54,65535},{453,60,65535},{451,61,65535},{448,62,65535},{450,63,65535},{449,64,65535},{447,65,65535},{444,66,65535},{446,67,65535},{442,68,65535},{445,69,65535},{443,70,65535},{441,71,65535},{438,76,65535},{440,73,65535},{436,74,65535},{437,77,65535},{434,79,65535},{430,84,65535},{435,78,65535},{433,81,65535},{432,82,65535},{431,83,65535},{428,85,65535},{426,89,65535},{429,87,65535},{427,88,65535},{424,91,65535},{422,92,65535},{425,90,65535},{423,93,65535},{418,98,65535},{421,97,65535},{420,94,65535},{419,99,65535},{413,104,65535},{417,103,65535},{407,115,65535},{408,112,65535},{414,107,65535},{415,105,65535},{403,119,65535},{412,109,65535},{411,110,65535},{400,123,65535},{404,116,65535},{409,111,65535},{398,124,65535},{405,117,65535},{402,122,65535},{396,131,65535},{392,130,65535},{394,128,65535},{383,142,65535},{389,134,65535},{387,137,65535},{397,129,65535},{386,141,65535},{376,151,65535},{375,154,65535},{372,160,65535},{380,146,65535},{379,153,65535},{382,144,65535},{366,165,65535},{357,181,65535},{351,187,65535},{361,169,65535},{367,167,65535}};
constexpr int IKP = 144;
__device__ __forceinline__ void idx_phase(const Args& a, unsigned char* lds, int tid, int lane, int wave) {
    const bf16_t* P = (const bf16_t*)(a.ws + WS_P); const bf16_t* CIK = (const bf16_t*)(a.ws + WS_CIK); const bf16_t* IKC = (const bf16_t*)(a.ws + WS_IKC);
    unsigned* CAND = (unsigned*)(a.ws + WS_ACT);
    unsigned* lst = (unsigned*)(lds + wave * 16384);
    unsigned char* kbuf = lds + 131072;
    const int r = lane & 31, hf = lane >> 5;
    const int qsel = (r >> 2) & 1, head = (r & 3) + 4 * (r >> 3);
    const int skey = tid >> 3, schk = tid & 7;
    const bool use_tab = gridDim.x == 256;
    for (int kk = 0; ; ++kk) {
        int id;
        if (use_tab) { if (kk >= IDX_TAB_N) break; id = IDX_TAB[blockIdx.x][kk]; if (id == 0xFFFF) break; }
        else { const int it = blockIdx.x + kk * gridDim.x; if (it >= 528) break;
               id = it < 256 ? (255 - (it >> 1)) * 2 + (it & 1) : (it < 512 ? ((it - 256) >> 1) * 2 + (it & 1) : it); }
        int c, half = id & 1, bb = 0; bool sample = false;
        if (id < 512) c = id >> 1;
        else { sample = true; bb = (id - 512) >> 1; c = 256 + bb; }
        const int L = sample ? 1088 : 64 * (c + 1), ntile = L >> 6;
        const int t0 = c * 64 + half * 32 + wave * 4;
        bf16x8 af[2][4]; float w[2][16];
#pragma unroll
        for (int rb = 0; rb < 2; ++rb) {
            const bf16_t* qp = P + (size_t)(t0 + 2 * rb + qsel) * NP + C_IQ + head * 64 + hf * 8;
#pragma unroll
            for (int ks = 0; ks < 4; ++ks) af[rb][ks] = *(const bf16x8*)(qp + ks * 16);
            const bf16_t* wp = P + (size_t)(t0 + 2 * rb + hf) * NP + C_IW;
            unpack8(*(const u32x4*)wp, w[rb]); unpack8(*(const u32x4*)(wp + 8), w[rb] + 8);
        }
        unsigned tau[2], cnt[2];
#pragma unroll
        for (int rb = 0; rb < 2; ++rb) { tau[rb] = 0u; cnt[rb] = 0u; }
        { const u32x4 v = *(const u32x4*)(ik_row(IKC, CIK, sample, bb, skey) + schk * 8); *(u32x4*)(kbuf + skey * IKP + schk * 16) = v; }
        u32x4 p1 = {0u, 0u, 0u, 0u}, p2 = p1, p3 = p1;
        if (1 < ntile) p1 = *(const u32x4*)(ik_row(IKC, CIK, sample, bb, 1 * 64 + skey) + schk * 8);
        if (2 < ntile) p2 = *(const u32x4*)(ik_row(IKC, CIK, sample, bb, 2 * 64 + skey) + schk * 8);
        if (3 < ntile) p3 = *(const u32x4*)(ik_row(IKC, CIK, sample, bb, 3 * 64 + skey) + schk * 8);
        __syncthreads();
#define IDX_MFMA8(ACC, KBP, SUB) do { bf16x8 bfr[4]; \
            _Pragma("unroll") for (int ks = 0; ks < 4; ++ks) bfr[ks] = *(const bf16x8*)((KBP) + ((SUB) * 32 + r) * IKP + ks * 32 + hf * 16); \
            _Pragma("unroll") for (int i = 0; i < 16; ++i) { ACC[0][i] = 0.f; ACC[1][i] = 0.f; } \
            __builtin_amdgcn_s_setprio(1); \
            _Pragma("unroll") for (int ks = 0; ks < 4; ++ks) { ACC[0] = __builtin_amdgcn_mfma_f32_32x32x16_bf16(af[0][ks], bfr[ks], ACC[0], 0, 0, 0); ACC[1] = __builtin_amdgcn_mfma_f32_32x32x16_bf16(af[1][ks], bfr[ks], ACC[1], 0, 0, 0); } \
            __builtin_amdgcn_s_setprio(0); } while (0)
#define IDX_SCORE(ACC, ENT, KEY) do { _Pragma("unroll") for (int rb = 0; rb < 2; ++rb) { float s0 = 0.f, s1 = 0.f; \
            _Pragma("unroll") for (int i = 0; i < 16; i += 2) { s0 += relu_i(ACC[rb][i]) * w[rb][i]; s1 += relu_i(ACC[rb][i + 1]) * w[rb][i + 1]; } \
            ENT[rb] = (mono_key(s0 + s1) & 0xFFFFC000u) | (KEY); } } while (0)
#define IDX_INTERLEAVE() do { _Pragma("unroll") for (int i_ = 0; i_ < 8; ++i_) { __builtin_amdgcn_sched_group_barrier(0x008, 1, 0); __builtin_amdgcn_sched_group_barrier(0x002, 9, 0); } } while (0)
#define IDX_INSERT(ENT) do { _Pragma("unroll") for (int rb = 0; rb < 2; ++rb) { \
            const unsigned ent = ENT[rb]; const bool p = ent > tau[rb]; const u64 m = __ballot(p); \
            if (m) { const unsigned mh = hf ? (unsigned)(m >> 32) : (unsigned)m; \
                if (p) lst[(2 * rb + hf) * 1024 + cnt[rb] + __popc(mh & ((1u << r) - 1u))] = ent; \
                cnt[rb] += __popc(mh); \
                if (__any(cnt[rb] > 992u)) { \
                    _Pragma("unroll") for (int hh = 0; hh < 2; ++hh) { const int cc = __builtin_amdgcn_readlane((int)cnt[rb], hh * 32); \
                        if (cc > 992) { int nc; const unsigned nt_ = compact1024(lst + (2 * rb + hh) * 1024, cc, lane, 14, nc); if (hf == hh) { tau[rb] = nt_; cnt[rb] = (unsigned)nc; } } } } } } } while (0)
        f32x16 accA[2], accB[2];
        IDX_MFMA8(accA, kbuf, 0);
        for (int tl = 0; tl < ntile; ++tl) {
            u32x4 p4 = {0u, 0u, 0u, 0u};
            if (tl + 4 < ntile) p4 = *(const u32x4*)(ik_row(IKC, CIK, sample, bb, (tl + 4) * 64 + skey) + schk * 8);
            const unsigned char* kb = kbuf + (tl & 1) * (64 * IKP);
            const unsigned char* kbn = kbuf + ((tl + 1) & 1) * (64 * IKP);
            unsigned entA[2], entB[2];
            IDX_MFMA8(accB, kb, 1);
            IDX_SCORE(accA, entA, (unsigned)(tl * 64 + r));
            IDX_INTERLEAVE();
            IDX_INSERT(entA);
            if (tl + 1 < ntile) *(u32x4*)(kbuf + ((tl + 1) & 1) * (64 * IKP) + skey * IKP + schk * 16) = p1;
            __syncthreads();
            if (tl + 1 < ntile) { IDX_MFMA8(accA, kbn, 0); IDX_SCORE(accB, entB, (unsigned)(tl * 64 + 32 + r)); IDX_INTERLEAVE(); }
            else { IDX_SCORE(accB, entB, (unsigned)(tl * 64 + 32 + r)); }
            IDX_INSERT(entB);
            if (tl == 14 || tl == 50 || tl == 174) {
#pragma unroll
                for (int rb = 0; rb < 2; ++rb)
#pragma unroll
                    for (int hh = 0; hh < 2; ++hh) { const int cc = __builtin_amdgcn_readlane((int)cnt[rb], hh * 32);
                        if (cc > 256) { int nc; const unsigned nt_ = compact1024(lst + (2 * rb + hh) * 1024, cc, lane, 14, nc); if (hf == hh) { tau[rb] = nt_; cnt[rb] = (unsigned)nc; } } }
            }
            p1 = p2; p2 = p3; p3 = p4;
        }
#pragma unroll
        for (int rb = 0; rb < 2; ++rb)
#pragma unroll
            for (int hh = 0; hh < 2; ++hh) { int cc = __builtin_amdgcn_readlane((int)cnt[rb], hh * 32); unsigned* base = lst + (2 * rb + hh) * 1024;
                if (cc > 256) { int nc; compact_final(base, cc, lane, nc); cc = nc; }
                unsigned* dst = CAND + (size_t)(t0 + 2 * rb + hh) * 256;
                for (int j = lane; j < cc; j += 64) dst[j] = base[j]; }
    }
}

__device__ __forceinline__ void attn_phase(const Args& a, unsigned char* lds, int lane, int wave) {
    bf16_t* P = (bf16_t*)(a.ws + WS_P);
    const unsigned char* KV8 = a.ws + WS_KV8; const unsigned char* CKV8 = a.ws + WS_CKV8;
    const unsigned* CAND = (const unsigned*)(a.ws + WS_ACT);
    unsigned* sel = (unsigned*)(lds + 122880 + wave * 1024);
    const int gw = blockIdx.x * 8 + wave, NGW = gridDim.x * 8;
    for (int t = gw; t < TT; t += NGW) {
        const bool sample = t >= TP; const int bb = sample ? (t - TP) >> 6 : 0;
        const int c = t >> 6; const int L = sample ? 1088 : 64 * (c + 1);
        const int nsel = min(256, L);
        const unsigned* cand = CAND + (size_t)t * 256;
#pragma unroll
        for (int j = 0; j < 4; ++j) { const int i = j * 64 + lane; if (i < nsel) sel[i] = cand[i] & 0x3FFFu; }
        bf16_t* qp = P + (size_t)t * NP + lane * 16;
        float q[16]; unpack8(*(const u32x4*)qp, q); unpack8(*(const u32x4*)(qp + 8), q + 8);
        float mx = -INFINITY, l = 0.f, o[16];
#pragma unroll
        for (int d = 0; d < 16; ++d) o[d] = 0.f;
        for (int j = 0; j < nsel; j += 8) {
            const u32x4 ida = *(const u32x4*)(sel + j), idb = *(const u32x4*)(sel + j + 4);
            u32x4 kk[8], vv[8];
#pragma unroll
            for (int i = 0; i < 8; ++i) { const int idx = (int)(i < 4 ? ida[i & 3] : idb[i & 3]); const unsigned char* kp;
                if (!sample) kp = KV8 + (size_t)idx * 2048;
                else if (idx < 1024) kp = CKV8 + (size_t)(bb * 1024 + idx) * 2048;
                else kp = KV8 + (size_t)(TP + bb * 64 + idx - 1024) * 2048;
                kk[i] = *(const u32x4*)(kp + lane * 16); vv[i] = *(const u32x4*)(kp + 1024 + lane * 16); }
            float s[8];
#pragma unroll
            for (int i = 0; i < 8; ++i) { float kf[16]; unpack16_fp8(kk[i], kf); float d0 = 0.f, d1 = 0.f;
#pragma unroll
                for (int x = 0; x < 16; x += 2) { d0 += q[x] * kf[x]; d1 += q[x + 1] * kf[x + 1]; }
                float d = d0 + d1;
                d += __shfl_xor(d, 1); d += __shfl_xor(d, 2); d += __shfl_xor(d, 4); s[i] = d; }
            const float mn = fmaxf(fmaxf(fmaxf(mx, fmaxf(s[0], s[1])), fmaxf(s[2], s[3])), fmaxf(fmaxf(s[4], s[5]), fmaxf(s[6], s[7])));
            const float al = __builtin_amdgcn_exp2f(mx - mn);
            float p[8];
#pragma unroll
            for (int i = 0; i < 8; ++i) p[i] = __builtin_amdgcn_exp2f(s[i] - mn);
            l = l * al + ((p[0] + p[1]) + (p[2] + p[3])) + ((p[4] + p[5]) + (p[6] + p[7]));
#pragma unroll
            for (int d = 0; d < 16; ++d) o[d] *= al;
#pragma unroll
            for (int i = 0; i < 8; ++i) { float vf[16]; unpack16_fp8(vv[i], vf);
#pragma unroll
                for (int d = 0; d < 16; ++d) o[d] += p[i] * vf[d]; }
            mx = mn;
        }
        const float il = 1.f / l;
#pragma unroll
        for (int d = 0; d < 16; ++d) o[d] *= il;
        *(u32x4*)qp = pack8(o); *(u32x4*)(qp + 8) = pack8(o + 8);
    }
}

__device__ __forceinline__ void fixup_phase(const Args& a, int tid) {
    const bf16_t* Uf = (const bf16_t*)(a.ws + WS_UF); const bf16_t* Uh = (const bf16_t*)(a.ws + WS_UH);
    bf16_t* ACTF = (bf16_t*)(a.ws + WS_P);
    const float* wconv = a.in[21]; const float* bconv = a.in[22];
    const size_t gt = (size_t)blockIdx.x * 512 + tid, GT = (size_t)gridDim.x * 512;
    for (size_t e = gt; e < (size_t)NCH * DFF; e += GT) {
        const int g = (int)(e / DFF), ch = (int)(e % DFF);
        float pa[2], pb[2];
        if (g >= 256) { const float* st = a.in[8] + (size_t)(g - 256) * 2 * NUP; pa[0] = st[ch]; pa[1] = st[NUP + ch]; pb[0] = st[DFF + ch]; pb[1] = st[NUP + DFF + ch]; }
        else if (g == 0) { pa[0] = pa[1] = pb[0] = pb[1] = 0.f; }
        else { const bf16_t* st = Uh + (size_t)(g - 1) * 2 * NUP; pa[0] = bf1(st[ch]); pa[1] = bf1(st[NUP + ch]); pb[0] = bf1(st[DFF + ch]); pb[1] = bf1(st[NUP + DFF + ch]); }
        const bf16_t* uf = Uf + (size_t)g * 2 * NUP;
        const float a0 = bf1(uf[ch]), a1 = bf1(uf[NUP + ch]), b0 = bf1(uf[DFF + ch]), b1 = bf1(uf[NUP + DFF + ch]);
        const float wa0 = wconv[ch], wa1 = wconv[NUP + ch], wa2 = wconv[2 * NUP + ch], ba = bconv[ch];
        const float wb0 = wconv[DFF + ch], wb1 = wconv[NUP + DFF + ch], wb2 = wconv[2 * NUP + DFF + ch], bb = bconv[DFF + ch];
        const float ca0 = ba + wa2 * a0 + wa1 * pa[1] + wa0 * pa[0], cb0 = bb + wb2 * b0 + wb1 * pb[1] + wb0 * pb[0];
        const float ca1 = ba + wa2 * a1 + wa1 * a0 + wa0 * pa[1], cb1 = bb + wb2 * b1 + wb1 * b0 + wb0 * pb[1];
        ACTF[(size_t)(g * 64) * DFF + ch] = (bf16_t)f2bf(siluf(ca0) * cb0);
        ACTF[(size_t)(g * 64 + 1) * DFF + ch] = (bf16_t)f2bf(siluf(ca1) * cb1);
    }
    for (size_t e = gt; e < (size_t)9 * 2 * NUP; e += GT) {
        const int s = (int)(e / (2 * NUP)), rem = (int)(e % (2 * NUP));
        const int g = s == 0 ? 255 : 255 + s;
        const float v = bf1(Uh[(size_t)g * 2 * NUP + rem]);
        if (s == 0) a.out[O_FCP + rem] = v; else a.out[O_FCS + (size_t)(s - 1) * 2 * NUP + rem] = v;
    }
}

#define LAS __attribute__((address_space(3)))
#define XB_TMO      128
#define XB_XCNT(j)  (256  + 64 * (j))
#define XB_XSUB(j)  (1280 + 64 * (j))
#define XB_XGEN(j)  (2304 + 64 * (j))
#define XB_TOP      3328
#define XB_TOPGEN   3392
#define XCD_BAR_WORDS 3456
#define XB_SPIN_CAP (1u << 18)

__device__ __forceinline__ unsigned xb_ld(unsigned* p)              { return __hip_atomic_load(p, __ATOMIC_RELAXED, __HIP_MEMORY_SCOPE_AGENT); }
__device__ __forceinline__ unsigned xb_add(unsigned* p, unsigned v) { return __hip_atomic_fetch_add(p, v, __ATOMIC_RELAXED, __HIP_MEMORY_SCOPE_AGENT); }
__device__ __forceinline__ unsigned xb_xcc_id() { return (unsigned)__builtin_amdgcn_s_getreg((3 << 11) | 20) & 0xFu; }
#define XB_SPIN(cond, bar) do { unsigned _sp = 0; while (cond) { __builtin_amdgcn_s_sleep(1); \
    if ((++_sp & 255u) == 0u) { if (xb_ld(&(bar)[XB_TMO])) break; if (_sp > XB_SPIN_CAP) { atomicAdd(&(bar)[XB_TMO], 1u); break; } } } } while (0)

struct XcdBarrier {
    unsigned* bar; unsigned x;
    volatile LAS unsigned* st;
};

__device__ __forceinline__ XcdBarrier xcd_barrier_post(unsigned* bar, volatile LAS unsigned* st) {
    XcdBarrier b; b.bar = bar; b.x = xb_xcc_id(); b.st = st;
    if (threadIdx.x == 0) (void)xb_add(&bar[XB_XCNT(b.x)], 1u);
    return b;
}
__device__ __forceinline__ void xcd_barrier_complete(unsigned* bar, unsigned x, unsigned& nloc, unsigned& nx) {
    const unsigned G = gridDim.x * gridDim.y * gridDim.z;
    unsigned sum, cnt, mine, sp = 0u;
    for (;;) {
        sum = 0u; cnt = 0u; mine = 0u;
#pragma unroll
        for (unsigned j = 0; j < 16; ++j) { const unsigned c = xb_ld(&bar[XB_XCNT(j)]); sum += c; cnt += (c > 0u) ? 1u : 0u; mine = (j == x) ? c : mine; }
        if (sum == G) break;
        __builtin_amdgcn_s_sleep(1);
        if ((++sp & 255u) == 0u) { if (xb_ld(&bar[XB_TMO])) break; if (sp > XB_SPIN_CAP) { atomicAdd(&bar[XB_TMO], 1u); break; } }
    }
    nloc = mine > 0u ? mine : 1u; nx = cnt > 0u ? cnt : 1u;
}

__device__ __forceinline__ void xcd_barrier(const XcdBarrier& b) {
    asm volatile("s_waitcnt vmcnt(0)" ::: "memory");
    __syncthreads();
    if (threadIdx.x == 0) {
        unsigned* bar = b.bar;
        __builtin_amdgcn_s_waitcnt(0);
        unsigned nloc = b.st[0], nx = b.st[1];
        if (nloc == 0u) { xcd_barrier_complete(bar, b.x, nloc, nx); b.st[0] = nloc; b.st[1] = nx; }
        const unsigned old = xb_add(&bar[XB_XSUB(b.x)], 1u);
        const unsigned gen = old / nloc;
        if (old + 1u == (gen + 1u) * nloc) {
            __builtin_amdgcn_fence(__ATOMIC_RELEASE, "agent");
            asm volatile("s_waitcnt vmcnt(0)" ::: "memory");
            const unsigned og = xb_add(&bar[XB_TOP], 1u);
            const unsigned tg = og / nx;
            if (og + 1u == (tg + 1u) * nx) xb_add(&bar[XB_TOPGEN], 1u);
            else XB_SPIN(xb_ld(&bar[XB_TOPGEN]) == tg, bar);
            __builtin_amdgcn_fence(__ATOMIC_ACQUIRE, "agent");
            xb_add(&bar[XB_XGEN(b.x)], 1u);
            asm volatile("s_waitcnt vmcnt(0)" ::: "memory");
        } else {
            XB_SPIN(xb_ld(&bar[XB_XGEN(b.x)]) == gen, bar);
            __builtin_amdgcn_fence(__ATOMIC_ACQUIRE, "agent");
            asm volatile("s_waitcnt vmcnt(0)" ::: "memory");
        }
    }
    __syncthreads();
}

__global__ void __launch_bounds__(512, 2) mega_fwd(Args a) {
    extern __shared__ __attribute__((aligned(16))) unsigned char lds[];
    cg::grid_group grid = cg::this_grid();
    const int tid = threadIdx.x, lane = tid & 63, wave = __builtin_amdgcn_readfirstlane(tid >> 6);
    unsigned char* ws = a.ws;
    const float* MOD = (const float*)(ws + WS_MOD);
#ifndef ONLY_PH
#define ONLY_PH -1
#endif
#define PHON(k) ((ONLY_PH < 0 || ONLY_PH == (k)) && lo <= (k) && (k) <= hi)
    volatile LAS unsigned* bst = (volatile LAS unsigned*)((PG8_LAS unsigned char*)lds + (LDS_BYTES - 64));
    if (tid == 0) { bst[0] = 0u; bst[1] = 0u; }
    __syncthreads();
    const XcdBarrier xbar = xcd_barrier_post((unsigned*)(ws + WS_CTL) + 1024, bst);
    if (a.ph_lo > NPHASE) grid.sync();
#define SEAM(k) do { if ((k) < hi) xcd_barrier(xbar); } while (0)
    const int lo = a.ph_lo, hi = a.ph_hi;
    if (PHON(0)) { phase0(a, lds, tid, lane, wave);
        SEAM(0); }
    if (PHON(1)) { normmod_phase(a.in[0], a.in[1], a.in[11], MOD, 0 * DM, 1 * DM, (bf16_t*)(ws + WS_ACT), lane, wave); SEAM(1); }
    if (PHON(2)) {
        pg8::Gemm g{(const bf16_t*)(ws + WS_ACT), (const bf16_t*)(ws + WS_WIN), TT, NP, DM, DM}; pg8::StaticOrder S; S.init(TT, NP, gridDim.x, blockIdx.x);
        EpiP E{(bf16_t*)(ws + WS_P), NP};
        pg8::gemm_phase<EpiP, pg8::StaticOrder, true, true>((PG8_LAS unsigned char*)lds, g, S, E);
        { int rank, count; if (gemm_tail_rank(S.nwg, rank, count)) tail_wout(a, lds, rank, count, lane, wave); else if (count <= 0 && blockIdx.x == 0) tail_wout(a, lds, 0, 1, lane, wave); }
        SEAM(2);
    }
    const bool swap_order = ((blockIdx.x >> 3) & 1) != 0;
    if (PHON(3)) {
        if (swap_order) { gla_g1(a, lds, tid, lane, wave); __syncthreads(); post_rows(a, lds, tid, lane, wave); }
        else { post_rows(a, lds, tid, lane, wave); gla_g1(a, lds, tid, lane, wave); }
        SEAM(3); }
    if (PHON(4)) { gla_g2(a, tid); idx_phase(a, lds, tid, lane, wave); SEAM(4); }
    if (PHON(5)) {
        attn_phase(a, lds, lane, wave); __syncthreads(); gla_g3(a, lds, tid, lane, wave);
        SEAM(5); }
    if (PHON(6)) {
        pg8::Gemm g{(const bf16_t*)(ws + WS_P), (const bf16_t*)(ws + WS_WOUT), TT, DM, DM, NP}; pg8::StaticOrder S; S.init(TT, DM, gridDim.x, blockIdx.x);
        EpiRes E{a.in[0], a.in[1], a.out + O_Y, MOD + 2 * DM};
        pg8::gemm_phase<EpiRes, pg8::StaticOrder, true, true>((PG8_LAS unsigned char*)lds, g, S, E);
        { int rank, count; if (gemm_tail_rank(S.nwg, rank, count)) tail_wup_wdn(a, lds, rank, count, lane, wave); else if (count <= 0 && blockIdx.x == 0) tail_wup_wdn(a, lds, 0, 1, lane, wave); }
        SEAM(6);
    }
    if (PHON(7)) { normmod_phase(a.out + O_Y, a.out + O_Y + (size_t)TP * DM, a.in[12], MOD, 3 * DM, 4 * DM, (bf16_t*)(ws + WS_ACT), lane, wave); SEAM(7); }
    if (PHON(8)) {
        pg8::Gemm g{(const bf16_t*)(ws + WS_ACT), (const bf16_t*)(ws + WS_WUP), TT, NUP, DM, DM}; pg8::StaticOrder S; S.init(TT, NUP, gridDim.x, blockIdx.x);
        EpiUp E{(bf16_t*)(ws + WS_P), (bf16_t*)(ws + WS_UF), (bf16_t*)(ws + WS_UH), a.in[21], a.in[22]};
        pg8::gemm_phase<EpiUp, pg8::StaticOrder, true, true>((PG8_LAS unsigned char*)lds, g, S, E);
        SEAM(8);
    }
    if (PHON(9)) { fixup_phase(a, tid); SEAM(9); }
    if (PHON(10)) {
        pg8::Gemm g{(const bf16_t*)(ws + WS_P), (const bf16_t*)(ws + WS_WDN), TT, DM, DFF, DFF}; pg8::StaticOrder S; S.init(TT, DM, gridDim.x, blockIdx.x);
        EpiRes E{a.out + O_Y, a.out + O_Y + (size_t)TP * DM, a.out + O_Y, MOD + 5 * DM};
        pg8::gemm_phase<EpiRes, pg8::StaticOrder, true, true>((PG8_LAS unsigned char*)lds, g, S, E);
    }
}

#ifndef MK_MULTI
#define MK_MULTI 0
#endif
extern "C" void kernel_launch(void* const* d_in, const int* in_sizes, int n_in, void* d_out, int out_size, void* d_ws, size_t ws_size, hipStream_t stream) {
    static int grid = 0;
    if (grid == 0) {
        if (n_in != 24 || (size_t)out_size != O_TOTAL || ws_size < WS_END) { fprintf(stderr, "kernel_launch: unexpected shapes: n_in %d out %d ws %zu\n", n_in, out_size, ws_size); grid = -1; return; }
        int dev = 0, cus = 0, per_cu = 0;
        hipGetDevice(&dev); hipDeviceGetAttribute(&cus, hipDeviceAttributeMultiprocessorCount, dev);
        if (hipFuncSetAttribute((const void*)mega_fwd, hipFuncAttributeMaxDynamicSharedMemorySize, LDS_BYTES) != hipSuccess) { fprintf(stderr, "kernel_launch: hipFuncSetAttribute failed\n"); grid = -1; return; }
        hipOccupancyMaxActiveBlocksPerMultiprocessor(&per_cu, (const void*)mega_fwd, 512, LDS_BYTES);
        if (per_cu < 1) per_cu = 1;
        (void)hipGetLastError();
        grid = cus * 1;
        if (grid <= 0) grid = 256;
    }
    if (grid < 0) return;
    hipMemsetAsync((char*)d_ws + WS_CTL, 0, 32768, stream);
    Args a{};
    for (int i = 0; i < 24; ++i) a.in[i] = (const float*)d_in[i];
    a.out = (float*)d_out; a.ws = (unsigned char*)d_ws;
#if MK_MULTI
    for (int ph = 0; ph < NPHASE; ++ph) { a.ph_lo = ph; a.ph_hi = ph; hipLaunchKernelGGL(mega_fwd, dim3(grid), dim3(512), LDS_BYTES, stream, a); }
#else
    a.ph_lo = 0; a.ph_hi = NPHASE - 1;
    void* args[] = {&a};
    hipError_t e = hipLaunchCooperativeKernel((const void*)mega_fwd, dim3(grid), dim3(512), args, LDS_BYTES, stream);
    if (e != hipSuccess) fprintf(stderr, "cooperative launch failed: %s (grid %d)\n", hipGetErrorString(e), grid);
#endif
}
```

```cpp
#include <hip/hip_runtime.h>
#include <hip/hip_cooperative_groups.h>
#include <cstdio>
#include <cstdint>
namespace cg = cooperative_groups;
namespace pg8 {
#define PG8_LAS __attribute__((address_space(3)))
typedef unsigned short bf16_t;
typedef short bf16x8 __attribute__((ext_vector_type(8)));
typedef float f32x4 __attribute__((ext_vector_type(4)));
typedef unsigned u32x4 __attribute__((ext_vector_type(4)));
constexpr int BM = 256, BK = 64, HALF = 128, HTB = HALF * BK * 2  , STAGE_BYTES = 8 * HTB, NXCD = 8, WGM = 8;

__host__ __device__ __forceinline__ int lds_byte(int r, int c) { const int st = (r >> 4) * 2 + (c >> 5), rr = r & 15, cc = c & 31, ob = rr * 64 + cc * 2; return st * 1024 + (ob ^ (((ob >> 9) & 1) << 5)); }
__host__ __device__ __forceinline__ void stage_rc(int b, int& R, int& C) { const int st = b / 1024, sb = b % 1024, swz = sb ^ (((sb >> 9) & 1) << 5); R = (st >> 1) * 16 + swz / 64; C = (st & 1) * 32 + (swz % 64) / 2; }
__host__ __device__ __forceinline__ int perm32(int rho) { const int n = rho >> 4, i = rho & 15; return 8 * (i >> 2) + 4 * n + (i & 3); }

struct Unit { int pm, pn; };
struct Gemm { const bf16_t* A; const bf16_t* Bt; int M, N, K, lda; };

struct StaticOrder {
    int nM, nN, nwg, G, c;
    __host__ __device__ void init(int M, int N, int G_, int c_) { nM = M / BM; nN = N / BM; nwg = nM * nN; G = G_; c = c_; }
    __host__ __device__ bool next(int i, Unit& u) const {
        const long L = (long)i * G + c; if (L >= nwg) return false;
        int wgid = (int)L; { const int q = nwg / NXCD, r = nwg % NXCD, xcd = wgid % NXCD, off = wgid / NXCD; wgid = (xcd < r ? xcd * (q + 1) : r * (q + 1) + (xcd - r) * q) + off; }
        const int nig = WGM * nN, gid = wgid / nig, fm = gid * WGM, gsz = (nM - fm) < WGM ? (nM - fm) : WGM;
        u.pm = fm + ((wgid % nig) % gsz); u.pn = (wgid % nig) / gsz; return true;
    }
    __device__ __forceinline__ void a_ready(const Unit&) const {}
    __device__ __forceinline__ void done(const Unit&) const {}
};

__device__ __forceinline__ unsigned cvt_pk_bf16(float lo, float hi) { unsigned r; asm volatile("v_cvt_pk_bf16_f32 %0, %1, %2" : "=v"(r) : "v"(lo), "v"(hi)); return r; }
template <class Epi, class Sched, bool ALIGN_EPI = false, bool SP2 = false>
__device__ __forceinline__ void gemm_phase(PG8_LAS unsigned char* lds, const Gemm g, const Sched& S, const Epi& E) {
    const int tid = threadIdx.x, wid = __builtin_amdgcn_readfirstlane(tid >> 6), lane = tid & 63, wr = wid >> 2, wc = wid & 3, fr = lane & 15, fq = lane >> 4;
    const int K = g.K, nt = K / BK;
    unsigned voffA[2], voffB[2];
#pragma unroll
    for (int i = 0; i < 2; ++i) { int R, C; stage_rc(tid * 16 + i * 8192, R, C); const int Rb = Epi::PERM ? ((R & ~31) + perm32(R & 31)) : R;
        voffA[i] = (unsigned)(R * g.lda + C) * 2u; voffB[i] = (unsigned)(Rb * K + C) * 2u; }
    const size_t kstep = (size_t)(BK * 2);
    const size_t hstepA = (size_t)HALF * g.lda * 2, hstepB = (size_t)HALF * K * 2;
    const size_t tstepA = 2 * hstepA, tstepB = 2 * hstepB;
    const unsigned ldsw = (unsigned)wid * 1024u;
    const int aoff = lds_byte(wr * 64 + fr, fq * 8), boff = lds_byte(wc * 32 + fr, fq * 8);
#define PG8_SA(b, h) (((b) * 2 + (h)) * HTB)
#define PG8_SB(b, h) ((4 + (b) * 2 + (h)) * HTB)
#define PG8_STAGE(bufoff, gbase, voff) do { _Pragma("unroll") for (int _i = 0; _i < 2; ++_i) \
        __builtin_amdgcn_global_load_lds((const unsigned*)((const char*)(gbase) + (voff)[_i]), (PG8_LAS unsigned*)(lds + (bufoff) + ldsw + _i * 8192), 16, 0, 0); } while (0)
#define PG8_LDA(dst, b, h) do { _Pragma("unroll") for (int m = 0; m < 4; ++m) _Pragma("unroll") for (int k = 0; k < 2; ++k) dst[m][k] = *(const PG8_LAS bf16x8*)(lds + PG8_SA(b, h) + aoff + m * 2048 + k * 1024); } while (0)
#define PG8_LDB(dst, b, h) do { _Pragma("unroll") for (int n = 0; n < 2; ++n) _Pragma("unroll") for (int k = 0; k < 2; ++k) dst[n][k] = *(const PG8_LAS bf16x8*)(lds + PG8_SB(b, h) + boff + n * 2048 + k * 1024); } while (0)
#define PG8_MMA(ai, bj, At, Bt) do { __builtin_amdgcn_s_setprio(1); _Pragma("unroll") for (int m = 0; m < 4; ++m) _Pragma("unroll") for (int n = 0; n < 2; ++n) _Pragma("unroll") for (int k = 0; k < 2; ++k) \
        acc[ai][bj][m][n] = __builtin_amdgcn_mfma_f32_16x16x32_bf16(Bt[n][k], At[m][k], acc[ai][bj][m][n], 0, 0, 0); __builtin_amdgcn_s_setprio(0); } while (0)
#define PG8_WAIT_V(n) asm volatile("s_waitcnt vmcnt(" #n ")" ::: "memory")
#define PG8_WAIT_L(n) asm volatile("s_waitcnt lgkmcnt(" #n ")" ::: "memory")
#define PG8_BAR __builtin_amdgcn_s_barrier()
#define PG8_SCHED __builtin_amdgcn_sched_barrier(0)
    Unit cur, nxt; int ui = 0;
    if (!S.next(0, cur)) return;
    f32x4 acc[2][2][4][2];
#pragma unroll
    for (int a = 0; a < 2; ++a)
#pragma unroll
        for (int b = 0; b < 2; ++b)
#pragma unroll
            for (int m = 0; m < 4; ++m)
#pragma unroll
                for (int n = 0; n < 2; ++n) acc[a][b][m][n] = (f32x4){0.f, 0.f, 0.f, 0.f};
    bf16x8 At[4][2], B0[2][2], B1[2][2];
    const char* cA = (const char*)g.A + (size_t)cur.pm * tstepA; const char* cB = (const char*)g.Bt + (size_t)cur.pn * tstepB;
    S.a_ready(cur);
    if constexpr (SP2) {
        PG8_STAGE(PG8_SB(0, 0), cB, voffB); PG8_STAGE(PG8_SB(0, 1), cB + hstepB, voffB); PG8_STAGE(PG8_SA(0, 0), cA, voffA); PG8_STAGE(PG8_SA(0, 1), cA + hstepA, voffA);
        if (wr == 1) PG8_BAR;
        PG8_WAIT_V(2); PG8_BAR;
        PG8_STAGE(PG8_SB(1, 0), cB + kstep, voffB); PG8_STAGE(PG8_SA(1, 0), cA + kstep, voffA); PG8_STAGE(PG8_SB(1, 1), cB + hstepB + kstep, voffB);
        PG8_WAIT_V(6); PG8_BAR;
    } else {
        PG8_STAGE(PG8_SB(0, 0), cB, voffB); PG8_STAGE(PG8_SA(0, 0), cA, voffA); PG8_STAGE(PG8_SB(0, 1), cB + hstepB, voffB); PG8_STAGE(PG8_SA(0, 1), cA + hstepA, voffA);
        if (wr == 1) PG8_BAR;
        PG8_WAIT_V(4); PG8_BAR;
        PG8_STAGE(PG8_SB(1, 0), cB + kstep, voffB); PG8_STAGE(PG8_SA(1, 0), cA + kstep, voffA); PG8_STAGE(PG8_SB(1, 1), cB + hstepB + kstep, voffB);
        PG8_WAIT_V(6); PG8_BAR;
    }
    for (;;) {
        const bool has_next = S.next(ui + 1, nxt);
        const char* nA = has_next ? (const char*)g.A + (size_t)nxt.pm * tstepA : cA; const char* nB = has_next ? (const char*)g.Bt + (size_t)nxt.pn * tstepB : cB;
        for (int t = 0; t < nt; t += 2) {
            const bool last = (t == nt - 2);
            const char* a1 = cA + (size_t)(t + 1) * kstep;
            const char* a2 = last ? nA : cA + (size_t)(t + 2) * kstep; const char* b2 = last ? nB : cB + (size_t)(t + 2) * kstep;
            const char* a3 = a2 + kstep; const char* b3 = b2 + kstep;
            if (last && has_next) S.a_ready(nxt);
            if constexpr (SP2) {
            PG8_LDB(B0, 0, 0); PG8_LDB(B1, 0, 1); PG8_SCHED; PG8_LDA(At, 0, 0); PG8_STAGE(PG8_SA(1, 1), a1 + hstepA, voffA);
            PG8_WAIT_V(8); PG8_WAIT_L(0); PG8_BAR; PG8_MMA(0, 0, At, B0); PG8_MMA(0, 1, At, B1); PG8_BAR; PG8_SCHED;
            PG8_LDA(At, 0, 1); PG8_STAGE(PG8_SB(0, 0), b2, voffB); PG8_STAGE(PG8_SB(0, 1), b2 + hstepB, voffB); PG8_STAGE(PG8_SA(0, 0), a2, voffA);
            PG8_WAIT_V(8); PG8_WAIT_L(0); PG8_BAR; PG8_MMA(1, 0, At, B0); PG8_MMA(1, 1, At, B1); PG8_BAR; PG8_SCHED;
            PG8_LDB(B0, 1, 0); PG8_LDB(B1, 1, 1); PG8_SCHED; PG8_LDA(At, 1, 0); PG8_STAGE(PG8_SA(0, 1), a2 + hstepA, voffA);
            PG8_WAIT_V(8); PG8_WAIT_L(0); PG8_BAR; PG8_MMA(0, 0, At, B0); PG8_MMA(0, 1, At, B1); PG8_BAR; PG8_SCHED;
            PG8_LDA(At, 1, 1); PG8_STAGE(PG8_SB(1, 0), b3, voffB); PG8_STAGE(PG8_SB(1, 1), b3 + hstepB, voffB); PG8_STAGE(PG8_SA(1, 0), a3, voffA);
            PG8_WAIT_V(8); PG8_WAIT_L(0); PG8_BAR; PG8_MMA(1, 0, At, B0); PG8_MMA(1, 1, At, B1); PG8_BAR; PG8_SCHED;
            } else {
            PG8_LDB(B0, 0, 0); PG8_SCHED; PG8_LDA(At, 0, 0); PG8_STAGE(PG8_SA(1, 1), a1 + hstepA, voffA);
            PG8_WAIT_L(8); PG8_BAR; PG8_WAIT_L(0); PG8_MMA(0, 0, At, B0); PG8_BAR; PG8_SCHED;
            PG8_LDB(B1, 0, 1); PG8_STAGE(PG8_SB(0, 0), b2, voffB);
            PG8_BAR; PG8_WAIT_L(0); PG8_MMA(0, 1, At, B1); PG8_BAR;
            PG8_LDA(At, 0, 1); PG8_STAGE(PG8_SA(0, 0), a2, voffA);
            PG8_BAR; PG8_WAIT_L(0); PG8_MMA(1, 0, At, B0); PG8_BAR; PG8_SCHED;
            PG8_STAGE(PG8_SB(0, 1), b2 + hstepB, voffB);
            PG8_WAIT_V(6); PG8_BAR; PG8_MMA(1, 1, At, B1); PG8_BAR;
            PG8_LDB(B0, 1, 0); PG8_SCHED; PG8_LDA(At, 1, 0); PG8_STAGE(PG8_SA(0, 1), a2 + hstepA, voffA);
            PG8_WAIT_L(8); PG8_BAR; PG8_WAIT_L(0); PG8_MMA(0, 0, At, B0); PG8_BAR; PG8_SCHED;
            PG8_LDB(B1, 1, 1); PG8_STAGE(PG8_SB(1, 0), b3, voffB);
            PG8_BAR; PG8_WAIT_L(0); PG8_MMA(0, 1, At, B1); PG8_BAR;
            PG8_LDA(At, 1, 1); PG8_STAGE(PG8_SA(1, 0), a3, voffA);
            PG8_BAR; PG8_WAIT_L(0); PG8_MMA(1, 0, At, B0); PG8_BAR; PG8_SCHED;
            PG8_STAGE(PG8_SB(1, 1), b3 + hstepB, voffB);
            PG8_WAIT_V(6); PG8_BAR; PG8_MMA(1, 1, At, B1); PG8_BAR;
            }
        }
        if constexpr (ALIGN_EPI) { if (wr == 0) PG8_BAR; }
        if constexpr (!Epi::AFTER_DRAIN) { E(acc, cur, wr, wc, fr, fq); S.done(cur); }
        if (!has_next) break;
#pragma unroll
        for (int a = 0; a < 2; ++a)
#pragma unroll
            for (int b = 0; b < 2; ++b)
#pragma unroll
                for (int m = 0; m < 4; ++m)
#pragma unroll
                    for (int n = 0; n < 2; ++n) acc[a][b][m][n] = (f32x4){0.f, 0.f, 0.f, 0.f};
        cur = nxt; cA = nA; cB = nB; ++ui;
        if constexpr (ALIGN_EPI) { if (wr == 1) PG8_BAR; }
    }
    PG8_WAIT_V(0);
    if constexpr (!ALIGN_EPI) { if (wr == 0) PG8_BAR; }
    PG8_BAR;
    if constexpr (Epi::AFTER_DRAIN) { E.fused(acc, cur, wr, wc, fr, fq, lds, wid, lane); S.done(cur); }
#undef PG8_SA
#undef PG8_SB
#undef PG8_STAGE
#undef PG8_LDA
#undef PG8_LDB
#undef PG8_MMA
#undef PG8_WAIT_V
#undef PG8_WAIT_L
#undef PG8_BAR
#undef PG8_SCHED
}
}
using pg8::bf16_t; using pg8::bf16x8; using pg8::f32x4; using pg8::u32x4;
typedef float f32x16 __attribute__((ext_vector_type(16)));
typedef unsigned long long u64;

constexpr int DM = 2048, TP = 16384, TS = 512, TT = TP + TS, NBATCH = 9, MODW = 6 * DM;
constexpr int NP = 7424;
constexpr int C_AQ = 0, C_IQ = 1024, C_AK = 2048, C_AV = 3072, C_GQ = 4096, C_GK = 4608, C_GV = 5120, C_GR = 6144, C_IK = 7168, C_IW = 7232, C_GLR = 7248, C_END = 7264;
constexpr int DFF = 5632, NUP = 11264, WIN_N = 7264;
constexpr int NCH = 264;
constexpr float EPS = 1e-6f;
constexpr size_t O_Y = 0, O_KP = 34603008, O_VP = 51380224, O_IKP = 68157440, O_GSP = 69206016, O_FCP = 69337088,
                 O_KS = 69359616, O_VS = 69883904, O_IKS = 70408192, O_GSS = 70440960, O_FCS = 71489536, O_TOTAL = 71669760;
constexpr size_t MiB = 1u << 20;
constexpr size_t WS_CTL = 0, WS_MOD = 1 * MiB, WS_D = 2 * MiB, WS_WIN = 4 * MiB, WS_WOUT = 33 * MiB, WS_WUP = 41 * MiB, WS_WDN = 85 * MiB,
                 WS_ACT = 107 * MiB, WS_P = 173 * MiB, WS_CK = 413 * MiB, WS_CV = 429 * MiB, WS_CIK = 445 * MiB, WS_KV8 = 446 * MiB, WS_CKV8 = 479 * MiB, WS_END = 495 * MiB;
constexpr size_t WS_BC = WS_WUP;
constexpr size_t WS_IKC = WS_CK;
constexpr size_t WS_UF = WS_CK, WS_UH = WS_CK + 12 * MiB;
constexpr int LDS_BYTES = 149568;
constexpr int NPHASE = 11;
constexpr int IDX_ITEMS = 5184;

struct Args { const float* in[24]; float* out; unsigned char* ws; int ph_lo, ph_hi; };

__device__ __forceinline__ unsigned f2bf(float f) { unsigned u = __builtin_bit_cast(unsigned, f); return (u + 0x7fffu + ((u >> 16) & 1u)) >> 16; }
typedef float f32x2v __attribute__((ext_vector_type(2))); typedef __bf16 bf16x2v __attribute__((ext_vector_type(2)));
__device__ __forceinline__ unsigned pk2(float lo, float hi) { const f32x2v v = {lo, hi}; const bf16x2v b = __builtin_convertvector(v, bf16x2v); return __builtin_bit_cast(unsigned, b); }
__device__ __forceinline__ float bflo(unsigned w) { return __builtin_bit_cast(float, w << 16); }
__device__ __forceinline__ float bfhi(unsigned w) { return __builtin_bit_cast(float, w & 0xffff0000u); }
__device__ __forceinline__ float bf1(bf16_t h) { return __builtin_bit_cast(float, ((unsigned)h) << 16); }
__device__ __forceinline__ void unpack8(u32x4 w, float* v) { v[0] = bflo(w.x); v[1] = bfhi(w.x); v[2] = bflo(w.y); v[3] = bfhi(w.y); v[4] = bflo(w.z); v[5] = bfhi(w.z); v[6] = bflo(w.w); v[7] = bfhi(w.w); }
__device__ __forceinline__ u32x4 pack8(const float* v) { u32x4 w; w.x = pk2(v[0], v[1]); w.y = pk2(v[2], v[3]); w.z = pk2(v[4], v[5]); w.w = pk2(v[6], v[7]); return w; }
__device__ __forceinline__ float wave_sum(float v) {
#pragma unroll
    for (int o = 1; o < 64; o <<= 1) v += __shfl_xor(v, o);
    return v;
}
__device__ __forceinline__ float siluf(float x) { return x * __builtin_amdgcn_rcpf(1.f + __expf(-x)); }
typedef float f32x2 __attribute__((ext_vector_type(2)));
__device__ __forceinline__ unsigned pk4_fp8(float a, float b, float c, float d) { int w = 0; w = __builtin_amdgcn_cvt_pk_fp8_f32(a, b, w, false); w = __builtin_amdgcn_cvt_pk_fp8_f32(c, d, w, true); return (unsigned)w; }
__device__ __forceinline__ u32x4 pack16_fp8(const float* v) { u32x4 w; w.x = pk4_fp8(v[0], v[1], v[2], v[3]); w.y = pk4_fp8(v[4], v[5], v[6], v[7]); w.z = pk4_fp8(v[8], v[9], v[10], v[11]); w.w = pk4_fp8(v[12], v[13], v[14], v[15]); return w; }
__device__ __forceinline__ void unpack16_fp8(u32x4 w, float* v) {
#pragma unroll
    for (int i = 0; i < 4; ++i) { const f32x2 lo = __builtin_amdgcn_cvt_pk_f32_fp8((int)w[i], false), hi = __builtin_amdgcn_cvt_pk_f32_fp8((int)w[i], true); v[4 * i] = lo.x; v[4 * i + 1] = lo.y; v[4 * i + 2] = hi.x; v[4 * i + 3] = hi.y; }
}

template <int MAPID> __device__ __forceinline__ int colmap(int n) {
    if (MAPID == 0) return n;
    if (MAPID == 1) {
        if (n < 1024) return n;
        if (n < 2048) return 3072 + (n - 1024);
        if (n < 3072) return 1024 + (n - 2048);
        if (n < 4096) return 2048 + (n - 3072);
        if (n < 4608) return 4176 + (n - 4096);
        if (n < 5120) return 4688 + (n - 4608);
        if (n < 6144) return 5200 + (n - 5120);
        if (n < 7168) return 6224 + (n - 6144);
        if (n < 7232) return 4096 + (n - 7168);
        if (n < 7248) return 4160 + (n - 7232);
        if (n < 7264) return n;
        return -1;
    }
    { const int pn = n >> 8, w = n & 255; return w < 128 ? pn * 128 + w : DFF + pn * 128 + (w - 128); }
}
template <int MAPID> __device__ __forceinline__ void transpose_item(const float* __restrict__ W, int K, int Nsrc, bf16_t* __restrict__ WT, int nblk, float* scr, int item, int lane) {
    const int kb = item / nblk, nb = item % nblk, k0 = 64 * kb, n0 = 32 * nb;
    const int srcc = colmap<MAPID>(n0 + (lane & 31));
#pragma unroll 8
    for (int i = 0; i < 32; ++i) { const int kk = 2 * i + (lane >> 5); scr[kk * 33 + (lane & 31)] = srcc >= 0 ? W[(size_t)(k0 + kk) * Nsrc + srcc] : 0.f; }
    asm volatile("s_waitcnt lgkmcnt(0)" ::: "memory");
    const int c = lane & 7;
#pragma unroll
    for (int j = 0; j < 4; ++j) { const int n = (lane >> 3) + 8 * j; const float* s = scr + (8 * c) * 33 + n;
        u32x4 o; o.x = pk2(s[0 * 33], s[1 * 33]); o.y = pk2(s[2 * 33], s[3 * 33]); o.z = pk2(s[4 * 33], s[5 * 33]); o.w = pk2(s[6 * 33], s[7 * 33]);
        *(u32x4*)(WT + (size_t)(n0 + n) * K + k0 + 8 * c) = o; }
    asm volatile("s_waitcnt lgkmcnt(0)" ::: "memory");
}

__device__ __forceinline__ void phase0(const Args& a, unsigned char* lds, int tid, int lane, int wave) {
    unsigned char* ws = a.ws;
    if ((int)blockIdx.x < 192 || gridDim.x < 192) {
        float* sc = (float*)lds;
        float* red = (float*)(lds + 73728);
        for (int i = tid; i < NBATCH * DM; i += 512) { const int b = i >> 11, k = i & 2047; const float c = b == 0 ? a.in[2][k] : a.in[3][(b - 1) * DM + k]; sc[i] = c / (1.f + __expf(-c)); }
        __syncthreads();
        for (int item = blockIdx.x; item < 192; item += gridDim.x) {
            const int col = item * 64 + lane, k0 = wave * 256;
            float acc[NBATCH];
#pragma unroll
            for (int b = 0; b < NBATCH; ++b) acc[b] = 0.f;
            const float* wp = a.in[9] + (size_t)k0 * MODW + col;
            for (int k = 0; k < 256; k += 32) {
                float wv[32];
#pragma unroll
                for (int i = 0; i < 32; ++i) wv[i] = wp[(size_t)(k + i) * MODW];
#pragma unroll
                for (int i = 0; i < 32; ++i)
#pragma unroll
                    for (int b = 0; b < NBATCH; ++b) acc[b] += sc[b * DM + k0 + k + i] * wv[i]; }
#pragma unroll
            for (int b = 0; b < NBATCH; ++b) red[(wave * NBATCH + b) * 64 + lane] = acc[b];
            __syncthreads();
            for (int i = tid; i < NBATCH * 64; i += 512) { const int b = i >> 6, l = i & 63; float s = a.in[10][item * 64 + l];
#pragma unroll
                for (int w = 0; w < 8; ++w) s += red[(w * NBATCH + b) * 64 + l];
                ((float*)(ws + WS_MOD))[b * MODW + item * 64 + l] = s; }
            __syncthreads();
        }
    }
    __syncthreads();
    {
        float* scr = (float*)(lds + wave * 8448);
        const int gw = blockIdx.x * 8 + wave, NGW = gridDim.x * 8;
        constexpr int I_IN = 32 * (NP / 32);
        for (int it = gw; it < I_IN; it += NGW) transpose_item<1>(a.in[13], DM, WIN_N, (bf16_t*)(ws + WS_WIN), NP / 32, scr, it, lane);
    }
    {
        const size_t gt = (size_t)blockIdx.x * 512 + tid, GT = (size_t)gridDim.x * 512;
        for (size_t i = gt; i < 8388608 / 16; i += GT) {
            const size_t row = i >> 6, chk = i & 63; float v[16];
            const f32x4* s = (const f32x4*)(a.in[4] + row * 1024 + chk * 16);
#pragma unroll
            for (int j = 0; j < 4; ++j) { const f32x4 x = s[j]; v[4 * j] = x.x; v[4 * j + 1] = x.y; v[4 * j + 2] = x.z; v[4 * j + 3] = x.w; }
            *(u32x4*)(ws + WS_CKV8 + row * 2048 + chk * 16) = pack16_fp8(v);
            s = (const f32x4*)(a.in[5] + row * 1024 + chk * 16);
#pragma unroll
            for (int j = 0; j < 4; ++j) { const f32x4 x = s[j]; v[4 * j] = x.x; v[4 * j + 1] = x.y; v[4 * j + 2] = x.z; v[4 * j + 3] = x.w; }
            *(u32x4*)(ws + WS_CKV8 + row * 2048 + 1024 + chk * 16) = pack16_fp8(v); }
        for (size_t i = gt; i < 524288 / 8; i += GT) {
            const f32x4* s = (const f32x4*)a.in[6] + 2 * i; f32x4 x = s[0], y = s[1]; u32x4 o; o.x = pk2(x.x, x.y); o.y = pk2(x.z, x.w); o.z = pk2(y.x, y.y); o.w = pk2(y.z, y.w); ((u32x4*)(ws + WS_CIK))[i] = o; }
    }
}

__device__ __forceinline__ bool gemm_tail_rank(int nwg, int& rank, int& count) {
    const int G = gridDim.x, c = blockIdx.x, rounds = (nwg + G - 1) / G, nbusy = nwg - (rounds - 1) * G;
    rank = c - nbusy; count = G - nbusy; return c >= nbusy;
}
__device__ __forceinline__ void tail_wout(const Args& a, unsigned char* lds, int rank, int count, int lane, int wave) {
    float* scr = (float*)(lds + wave * 8448);
    for (int it = rank * 8 + wave; it < 32 * 64; it += count * 8) transpose_item<0>(a.in[19], DM, DM, (bf16_t*)(a.ws + WS_WOUT), 64, scr, it, lane);
}
__device__ __forceinline__ void tail_wup_wdn(const Args& a, unsigned char* lds, int rank, int count, int lane, int wave) {
    float* scr = (float*)(lds + wave * 8448);
    constexpr int I_UP = 32 * (NUP / 32), I_DN = (DFF / 64) * 64;
    for (int it = rank * 8 + wave; it < I_UP + I_DN; it += count * 8) {
        if (it < I_UP) transpose_item<2>(a.in[20], DM, NUP, (bf16_t*)(a.ws + WS_WUP), NUP / 32, scr, it, lane);
        else transpose_item<0>(a.in[23], DFF, DM, (bf16_t*)(a.ws + WS_WDN), 64, scr, it - I_UP, lane);
    }
}

__device__ __forceinline__ void normmod_phase(const float* xp, const float* xs, const float* g, const float* mod, int sh_off, int sc_off, bf16_t* dst, int lane, int wave) {
    const int gw = blockIdx.x * 8 + wave, NGW = gridDim.x * 8;
    for (int r = gw; r < TT; r += NGW) {
        const float* xrow = r < TP ? xp + (size_t)r * DM : xs + (size_t)(r - TP) * DM;
        const int b = r < TP ? 0 : 1 + ((r - TP) >> 6);
        const f32x4* xr = (const f32x4*)xrow + lane;
        f32x4 v[8]; float s = 0.f;
#pragma unroll
        for (int j = 0; j < 8; ++j) { v[j] = xr[64 * j]; s += (v[j].x * v[j].x + v[j].y * v[j].y) + (v[j].z * v[j].z + v[j].w * v[j].w); }
        const float rstd = rsqrtf(wave_sum(s) * (1.f / DM) + EPS);
        const f32x4* gp = (const f32x4*)g + lane; const f32x4* scp = (const f32x4*)(mod + (size_t)b * MODW + sc_off) + lane; const f32x4* shp = (const f32x4*)(mod + (size_t)b * MODW + sh_off) + lane;
        u64* o8 = (u64*)(dst + (size_t)r * DM) + lane;
#pragma unroll
        for (int j = 0; j < 8; ++j) { const f32x4 gg = gp[64 * j], sc = scp[64 * j], sh = shp[64 * j];
            const f32x4 y = v[j] * rstd * gg * (sc + 1.f) + sh;
            o8[64 * j] = (u64)pk2(y.x, y.y) | ((u64)pk2(y.z, y.w) << 32); }
    }
}

struct EpiP {
    static constexpr bool PERM = true, AFTER_DRAIN = false;
    bf16_t* O; int ldc;
    __device__ __forceinline__ void operator()(const f32x4 (&acc)[2][2][4][2], const pg8::Unit& u, int wr, int wc, int fr, int fq) const {
        const int row0 = u.pm * 256 + wr * 64 + fr, col0 = u.pn * 256 + wc * 32 + 8 * fq;
#pragma unroll
        for (int ai = 0; ai < 2; ++ai)
#pragma unroll
            for (int m = 0; m < 4; ++m) { bf16_t* rowp = O + (size_t)(row0 + ai * 128 + m * 16) * ldc + col0;
#pragma unroll
                for (int bj = 0; bj < 2; ++bj) { const f32x4 v0 = acc[ai][bj][m][0], v1 = acc[ai][bj][m][1]; u32x4 w;
                    w.x = pg8::cvt_pk_bf16(v0[0], v0[1]); w.y = pg8::cvt_pk_bf16(v0[2], v0[3]); w.z = pg8::cvt_pk_bf16(v1[0], v1[1]); w.w = pg8::cvt_pk_bf16(v1[2], v1[3]);
                    *(u32x4*)(rowp + bj * 128) = w; } }
    }
};
struct EpiRes {
    static constexpr bool PERM = true, AFTER_DRAIN = false;
    const float* srcP; const float* srcS; float* dst; const float* gate;
    __device__ __forceinline__ void operator()(const f32x4 (&acc)[2][2][4][2], const pg8::Unit& u, int wr, int wc, int fr, int fq) const {
        const int col0 = u.pn * 256 + wc * 32 + 8 * fq;
#pragma unroll
        for (int ai = 0; ai < 2; ++ai)
#pragma unroll
            for (int m = 0; m < 4; ++m) {
                const int row = u.pm * 256 + ai * 128 + wr * 64 + m * 16 + fr;
                const int b = row < TP ? 0 : 1 + ((row - TP) >> 6);
                const float* sp = (row < TP ? srcP + (size_t)row * DM : srcS + (size_t)(row - TP) * DM) + col0;
                const float* gp = gate + (size_t)b * MODW + col0; float* dp = dst + (size_t)row * DM + col0;
#pragma unroll
                for (int bj = 0; bj < 2; ++bj)
#pragma unroll
                    for (int n = 0; n < 2; ++n) { const f32x4 x = *(const f32x4*)(sp + bj * 128 + 4 * n), gg = *(const f32x4*)(gp + bj * 128 + 4 * n);
                        *(f32x4*)(dp + bj * 128 + 4 * n) = x + gg * acc[ai][bj][m][n]; }
            }
    }
};
template <int CTRL> __device__ __forceinline__ float dpp_ror(float v) {
    return __builtin_bit_cast(float, __builtin_amdgcn_update_dpp(0, __builtin_bit_cast(int, v), CTRL, 0xf, 0xf, false));
}
struct EpiUp {
    static constexpr bool PERM = true, AFTER_DRAIN = false;
    bf16_t* ACTF; bf16_t* Uf; bf16_t* Uh; const float* wconv; const float* bconv;
    __device__ __forceinline__ void operator()(const f32x4 (&acc)[2][2][4][2], const pg8::Unit& u, int wr, int wc, int fr, int fq) const {
        const int lane = fr + 16 * fq;
        const int ch0 = u.pn * 128 + wc * 32 + 8 * fq;
        const int src1 = (lane & 48) | ((fr + 15) & 15), src2 = (lane & 48) | ((fr + 14) & 15);
        unsigned outp[2][4][4];
#pragma unroll
        for (int cp = 0; cp < 4; ++cp) {
            const int chp = ch0 + 2 * cp;
            const f32x2 wa0 = *(const f32x2*)(wconv + chp), wa1 = *(const f32x2*)(wconv + NUP + chp), wa2 = *(const f32x2*)(wconv + 2 * NUP + chp), ba = *(const f32x2*)(bconv + chp);
            const f32x2 wb0 = *(const f32x2*)(wconv + DFF + chp), wb1 = *(const f32x2*)(wconv + NUP + DFF + chp), wb2 = *(const f32x2*)(wconv + 2 * NUP + DFF + chp), bb = *(const f32x2*)(bconv + DFF + chp);
#pragma unroll
            for (int ai = 0; ai < 2; ++ai) {
                float rr[4][2];
#pragma unroll
                for (int ii = 0; ii < 2; ++ii) {
                    const int c8 = 2 * cp + ii, n = c8 >> 2, i = c8 & 3;
                    float ua[4], ub[4], r1a[4], r2a[4], r1b[4], r2b[4];
#pragma unroll
                    for (int m = 0; m < 4; ++m) { ua[m] = acc[ai][0][m][n][i]; ub[m] = acc[ai][1][m][n][i];
                        r1a[m] = dpp_ror<0x121>(ua[m]); r2a[m] = dpp_ror<0x122>(ua[m]); r1b[m] = dpp_ror<0x121>(ub[m]); r2b[m] = dpp_ror<0x122>(ub[m]); }
#pragma unroll
                    for (int m = 0; m < 4; ++m) {
                        const float p1a = fr >= 1 ? r1a[m] : r1a[(m + 3) & 3], p2a = fr >= 2 ? r2a[m] : r2a[(m + 3) & 3];
                        const float p1b = fr >= 1 ? r1b[m] : r1b[(m + 3) & 3], p2b = fr >= 2 ? r2b[m] : r2b[(m + 3) & 3];
                        const float ca = ba[ii] + wa2[ii] * ua[m] + wa1[ii] * p1a + wa0[ii] * p2a;
                        const float cb = bb[ii] + wb2[ii] * ub[m] + wb1[ii] * p1b + wb0[ii] * p2b;
                        rr[m][ii] = siluf(ca) * cb;
                    }
                }
#pragma unroll
                for (int m = 0; m < 4; ++m) outp[ai][m][cp] = pg8::cvt_pk_bf16(rr[m][0], rr[m][1]);
            }
        }
#pragma unroll
        for (int ai = 0; ai < 2; ++ai) {
            const int g = u.pm * 4 + ai * 2 + wr;
#pragma unroll
            for (int m = 0; m < 4; ++m) { const int row = g * 64 + 16 * m + fr;
                u32x4 w; w.x = outp[ai][m][0]; w.y = outp[ai][m][1]; w.z = outp[ai][m][2]; w.w = outp[ai][m][3];
                *(u32x4*)(ACTF + (size_t)row * DFF + ch0) = w; }
            if (fr < 2) { bf16_t* p = Uf + (size_t)(g * 2 + fr) * NUP + ch0;
#pragma unroll
                for (int bj = 0; bj < 2; ++bj) { const f32x4 v0 = acc[ai][bj][0][0], v1 = acc[ai][bj][0][1]; u32x4 w;
                    w.x = pg8::cvt_pk_bf16(v0[0], v0[1]); w.y = pg8::cvt_pk_bf16(v0[2], v0[3]); w.z = pg8::cvt_pk_bf16(v1[0], v1[1]); w.w = pg8::cvt_pk_bf16(v1[2], v1[3]);
                    *(u32x4*)(p + bj * DFF) = w; } }
            if (fr >= 14) { bf16_t* p = Uh + (size_t)(g * 2 + fr - 14) * NUP + ch0;
#pragma unroll
                for (int bj = 0; bj < 2; ++bj) { const f32x4 v0 = acc[ai][bj][3][0], v1 = acc[ai][bj][3][1]; u32x4 w;
                    w.x = pg8::cvt_pk_bf16(v0[0], v0[1]); w.y = pg8::cvt_pk_bf16(v0[2], v0[3]); w.z = pg8::cvt_pk_bf16(v1[0], v1[1]); w.w = pg8::cvt_pk_bf16(v1[2], v1[3]);
                    *(u32x4*)(p + bj * DFF) = w; } }
        }
    }
};

__device__ __forceinline__ void post_rows(const Args& a, unsigned char* lds, int tid, int lane, int wave) {
    double* inv16 = (double*)lds; double* inv8 = inv16 + 16;
    if (tid < 16) inv16[tid] = exp(-(double)tid * (1.0 / 16.0) * 13.122363377404328);
    else if (tid < 24) inv8[tid - 16] = exp(-(double)(tid - 16) * (1.0 / 8.0) * 13.122363377404328);
    __syncthreads();
    bf16_t* P = (bf16_t*)(a.ws + WS_P);
    const float* gq = a.in[14]; const float* gk = a.in[15];
    const int sub = lane & 7;
    float gqv[16], gkv[16];
#pragma unroll
    for (int i = 0; i < 16; ++i) { gqv[i] = gq[sub * 16 + i]; gkv[i] = gk[sub * 16 + i]; }
    const int gw = blockIdx.x * 8 + wave, NGW = gridDim.x * 8;
    for (int r = gw; r < TT; r += NGW) {
        bf16_t* prow = P + (size_t)r * NP;
        const int pos = r < TP ? r : 1024 + ((r - TP) & 63);
        float* kout = r < TP ? a.out + O_KP + (size_t)r * 1024 : a.out + O_KS + (size_t)(r - TP) * 1024;
        float* vout = r < TP ? a.out + O_VP + (size_t)r * 1024 : a.out + O_VS + (size_t)(r - TP) * 1024;
        float* ikout = r < TP ? a.out + O_IKP + (size_t)r * 64 : a.out + O_IKS + (size_t)(r - TP) * 64;
        float cs[16], sn[16];
#pragma unroll
        for (int i = 0; i < 16; ++i) { double rev = (double)pos * inv16[i] * 0.15915494309189535; rev -= rint(rev); const float rf = (float)rev; cs[i] = __builtin_amdgcn_cosf(rf); sn[i] = __builtin_amdgcn_sinf(rf); }
#pragma unroll
        for (int which = 0; which < 2; ++which) {
            bf16_t* p = prow + (which ? C_AK : C_AQ) + lane * 16;
            float v[16]; unpack8(*(const u32x4*)p, v); unpack8(*(const u32x4*)(p + 8), v + 8);
            float ss = 0.f;
#pragma unroll
            for (int i = 0; i < 16; ++i) ss += v[i] * v[i];
            ss += __shfl_xor(ss, 1); ss += __shfl_xor(ss, 2); ss += __shfl_xor(ss, 4);
            const float rstd = rsqrtf(ss * (1.f / 128.f) + EPS);
#pragma unroll
            for (int i = 0; i < 16; ++i) v[i] = v[i] * rstd * (which ? gkv[i] : gqv[i]);
#pragma unroll
            for (int i = 0; i < 16; ++i) { const float pv = __shfl_xor(v[i], 1);
                if (sub == 0) v[i] = v[i] * cs[i] - pv * sn[i]; else if (sub == 1) v[i] = v[i] * cs[i] + pv * sn[i]; }
            if (which) {
#pragma unroll
                for (int i = 0; i < 4; ++i) __builtin_nontemporal_store((f32x4){v[4 * i], v[4 * i + 1], v[4 * i + 2], v[4 * i + 3]}, (f32x4*)(kout + lane * 16 + 4 * i));
                *(u32x4*)(a.ws + WS_KV8 + (size_t)r * 2048 + lane * 16) = pack16_fp8(v);
            } else {
#pragma unroll
                for (int i = 0; i < 16; ++i) v[i] *= 0.12751743074602468f;
            }
            *(u32x4*)p = pack8(v); *(u32x4*)(p + 8) = pack8(v + 8);
        }
        {
            const bf16_t* p = prow + C_AV + lane * 16; float v[16]; unpack8(*(const u32x4*)p, v); unpack8(*(const u32x4*)(p + 8), v + 8);
#pragma unroll
            for (int i = 0; i < 4; ++i) __builtin_nontemporal_store((f32x4){v[4 * i], v[4 * i + 1], v[4 * i + 2], v[4 * i + 3]}, (f32x4*)(vout + lane * 16 + 4 * i));
            *(u32x4*)(a.ws + WS_KV8 + (size_t)r * 2048 + 1024 + lane * 16) = pack16_fp8(v);
        }
        float c8[8], s8[8];
#pragma unroll
        for (int i = 0; i < 8; ++i) { double rev = (double)pos * inv8[i] * 0.15915494309189535; rev -= rint(rev); const float rf = (float)rev; c8[i] = __builtin_amdgcn_cosf(rf); s8[i] = __builtin_amdgcn_sinf(rf); }
        {
            bf16_t* p = prow + C_IQ + lane * 16; float v[16]; unpack8(*(const u32x4*)p, v); unpack8(*(const u32x4*)(p + 8), v + 8);
            if ((lane & 3) == 0) {
#pragma unroll
                for (int i = 0; i < 8; ++i) { const float x1 = v[i], x2 = v[i + 8]; v[i] = x1 * c8[i] - x2 * s8[i]; v[i + 8] = x2 * c8[i] + x1 * s8[i]; }
                *(u32x4*)p = pack8(v); *(u32x4*)(p + 8) = pack8(v + 8);
            }
        }
        if (lane < 4) {
            bf16_t* p = prow + C_IK + lane * 16; float v[16]; unpack8(*(const u32x4*)p, v); unpack8(*(const u32x4*)(p + 8), v + 8);
            if (lane == 0) {
#pragma unroll
                for (int i = 0; i < 8; ++i) { const float x1 = v[i], x2 = v[i + 8]; v[i] = x1 * c8[i] - x2 * s8[i]; v[i + 8] = x2 * c8[i] + x1 * s8[i]; }
                *(u32x4*)p = pack8(v); *(u32x4*)(p + 8) = pack8(v + 8);
            }
            { bf16_t* pc = (bf16_t*)(a.ws + WS_IKC) + (size_t)r * 64 + lane * 16; *(u32x4*)pc = pack8(v); *(u32x4*)(pc + 8) = pack8(v + 8); }
#pragma unroll
            for (int i = 0; i < 4; ++i) __builtin_nontemporal_store((f32x4){v[4 * i], v[4 * i + 1], v[4 * i + 2], v[4 * i + 3]}, (f32x4*)(ikout + lane * 16 + 4 * i));
        }
    }
    __syncthreads();
}

__device__ __forceinline__ f32x4 mfma16(bf16x8 a, bf16x8 b, f32x4 c) { return __builtin_amdgcn_mfma_f32_16x16x32_bf16(a, b, c, 0, 0, 0); }
constexpr int L_GLR = 0, L_BC = 4096, L_TOT = 36864, L_A = 38912;
__device__ __forceinline__ int tsw(int row) { return ((row >> 3) & 7) << 3; }
__device__ __forceinline__ void gla_bcum(const Args& a, unsigned char* lds, int n, int h, int tid) {
    const bf16_t* P = (const bf16_t*)(a.ws + WS_P);
    float* glr = (float*)(lds + L_GLR); float* bc = (float*)(lds + L_BC); float* tot = (float*)(lds + L_TOT);
    for (int e = tid; e < 1024; e += 512) { const int t = e >> 4, rr = e & 15; glr[e] = bf1(P[(size_t)(n * 64 + t) * NP + C_GLR + rr]); }
    __syncthreads();
    const int dk = tid & 127, tq = tid >> 7;
    float w[16];
#pragma unroll
    for (int rr = 0; rr < 16; ++rr) w[rr] = a.in[16][rr * 512 + h * 128 + dk];
    const float bias = a.in[17][h * 128 + dk];
    float run = 0.f;
#pragma unroll 4
    for (int tt = 0; tt < 16; ++tt) { const int t = tq * 16 + tt; float x = bias;
#pragma unroll
        for (int rr = 0; rr < 16; ++rr) x += glr[t * 16 + rr] * w[rr];
        const float ls = fminf(x, 0.f) - log1pf(__expf(-fabsf(x)));
        run += ls * (1.f / 16.f); bc[t * 128 + dk] = run; }
    tot[tq * 128 + dk] = run;
    __syncthreads();
    float off = 0.f;
    for (int g = 0; g < tq; ++g) off += tot[g * 128 + dk];
    if (tq > 0) { for (int tt = 0; tt < 16; ++tt) bc[(tq * 16 + tt) * 128 + dk] += off; }
    __syncthreads();
}
__device__ __forceinline__ void gla_g1(const Args& a, unsigned char* lds, int tid, int lane, int wave) {
    const bf16_t* P = (const bf16_t*)(a.ws + WS_P);
    float* Dd = (float*)(a.ws + WS_D);
    const float* bc = (const float*)(lds + L_BC);
    bf16_t* KT = (bf16_t*)(lds + L_A);
    bf16_t* VT = (bf16_t*)(lds + L_A + 18432);
    for (int it = blockIdx.x; it < NCH * 4; it += gridDim.x) {
        const int n = it >> 2, h = it & 3;
        gla_bcum(a, lds, n, h, tid);
        { f32x4* bcg = (f32x4*)(a.ws + WS_BC) + (size_t)it * 2048;
#pragma unroll
          for (int i = 0; i < 4; ++i) bcg[tid + 512 * i] = ((const f32x4*)bc)[tid + 512 * i]; }
        for (int ch = tid; ch < 1024; ch += 512) { const int s = ch >> 4, d0 = (ch & 15) * 8; float v[8]; unpack8(*(const u32x4*)(P + (size_t)(n * 64 + s) * NP + C_GK + h * 128 + d0), v);
#pragma unroll
            for (int i = 0; i < 8; ++i) KT[(d0 + i) * 72 + (s ^ tsw(d0))] = (bf16_t)f2bf(v[i] * __expf(bc[63 * 128 + d0 + i] - bc[s * 128 + d0 + i])); }
        for (int ch = tid; ch < 2048; ch += 512) { const int s = ch >> 5, d0 = (ch & 31) * 8; const u32x4 w = *(const u32x4*)(P + (size_t)(n * 64 + s) * NP + C_GV + h * 256 + d0);
            VT[(d0 + 0) * 72 + (s ^ tsw(d0))] = (bf16_t)(w.x & 0xffff); VT[(d0 + 1) * 72 + (s ^ tsw(d0))] = (bf16_t)(w.x >> 16); VT[(d0 + 2) * 72 + (s ^ tsw(d0))] = (bf16_t)(w.y & 0xffff); VT[(d0 + 3) * 72 + (s ^ tsw(d0))] = (bf16_t)(w.y >> 16);
            VT[(d0 + 4) * 72 + (s ^ tsw(d0))] = (bf16_t)(w.z & 0xffff); VT[(d0 + 5) * 72 + (s ^ tsw(d0))] = (bf16_t)(w.z >> 16); VT[(d0 + 6) * 72 + (s ^ tsw(d0))] = (bf16_t)(w.w & 0xffff); VT[(d0 + 7) * 72 + (s ^ tsw(d0))] = (bf16_t)(w.w >> 16); }
        if (tid < 128) Dd[it * 128 + tid] = __expf(bc[63 * 128 + tid]);
        __syncthreads();
        const int l15 = lane & 15, q = lane >> 4;
        bf16_t* Uo = (bf16_t*)a.out + (size_t)it * 32768;
        {   const int mt = wave;
            const int kr = mt * 16 + l15; const bf16x8 a0 = *(const bf16x8*)(KT + kr * 72 + ((q * 8) ^ tsw(kr))), a1 = *(const bf16x8*)(KT + kr * 72 + ((32 + q * 8) ^ tsw(kr)));
#pragma unroll
            for (int nt = 0; nt < 16; ++nt) {
                const int vr = nt * 16 + l15; const bf16x8 b0 = *(const bf16x8*)(VT + vr * 72 + ((q * 8) ^ tsw(vr))), b1 = *(const bf16x8*)(VT + vr * 72 + ((32 + q * 8) ^ tsw(vr)));
                f32x4 c = {0.f, 0.f, 0.f, 0.f}; c = mfma16(a0, b0, c); c = mfma16(a1, b1, c);
                *(u64*)(Uo + (nt * 16 + l15) * 128 + mt * 16 + q * 4) = (u64)pk2(c[0], c[1]) | ((u64)pk2(c[2], c[3]) << 32);
            } }
        __syncthreads();
    }
}
__device__ __forceinline__ void gla_g2(const Args& a, int tid) {
    unsigned* US2 = (unsigned*)a.out;
    const float* Dd = (const float*)(a.ws + WS_D);
    const size_t gt = (size_t)blockIdx.x * 512 + tid, GT = (size_t)gridDim.x * 512;
    for (size_t e = gt; e < 65536; e += GT) {
        const int h = (int)(e >> 14), rem2 = (int)(e & 16383), dk = (2 * rem2) & 127, dv = (2 * rem2) >> 7;
        float S0 = 0.f, S1 = 0.f;
        for (int n0 = 0; n0 < 256; n0 += 32) {
            unsigned u[32]; f32x2 d[32];
#pragma unroll
            for (int i = 0; i < 32; ++i) { const int it = (n0 + i) * 4 + h; u[i] = US2[(size_t)it * 16384 + rem2]; d[i] = *(const f32x2*)(Dd + it * 128 + dk); }
#pragma unroll
            for (int i = 0; i < 32; ++i) { const int it = (n0 + i) * 4 + h; US2[(size_t)it * 16384 + rem2] = pk2(S0, S1); S0 = d[i].x * S0 + bflo(u[i]); S1 = d[i].y * S1 + bfhi(u[i]); }
        }
        a.out[O_GSP + (size_t)h * 32768 + dk * 256 + dv] = S0; a.out[O_GSP + (size_t)h * 32768 + (dk + 1) * 256 + dv] = S1;
    }
    for (size_t e2 = gt; e2 < 8 * 65536; e2 += GT) {
        const int b = (int)(e2 >> 16), e = (int)(e2 & 65535), h = e >> 14, rem2 = e & 16383, dk = (2 * rem2) & 127, dv = (2 * rem2) >> 7;
        const int it = (256 + b) * 4 + h;
        const size_t so = ((size_t)(b * 4 + h) * 128 + dk) * 256 + dv;
        const float S0 = a.in[7][so], S1 = a.in[7][so + 256]; const unsigned u = US2[(size_t)it * 16384 + rem2];
        US2[(size_t)it * 16384 + rem2] = pk2(S0, S1);
        const f32x2 d = *(const f32x2*)(Dd + it * 128 + dk);
        a.out[O_GSS + so] = d.x * S0 + bflo(u); a.out[O_GSS + so + 256] = d.y * S1 + bfhi(u);
    }
}
__device__ __forceinline__ void gla_g3(const Args& a, unsigned char* lds, int tid, int lane, int wave) {
    bf16_t* P = (bf16_t*)(a.ws + WS_P);
    const float* bc = (const float*)(lds + L_BC);
    bf16_t* Q = (bf16_t*)(lds + L_A);
    bf16_t* Kk = (bf16_t*)(lds + L_A + 17408);
    bf16_t* VT = (bf16_t*)(lds + L_A + 34816);
    bf16_t* ATS = (bf16_t*)(lds + L_A + 71680);
    float* RS = (float*)(lds + L_A + 80896);
    bf16_t* OUTS = (bf16_t*)(lds + L_A);
    const int l15 = lane & 15, q = lane >> 4;
    for (int it = gridDim.x - 1 - blockIdx.x; it < NCH * 4; it += gridDim.x) {
        const int n = it >> 2, h = it & 3;
        { const f32x4* bcg = (const f32x4*)(a.ws + WS_BC) + (size_t)it * 2048; f32x4* bcl = (f32x4*)(lds + L_BC);
#pragma unroll
          for (int i = 0; i < 4; ++i) bcl[tid + 512 * i] = bcg[tid + 512 * i]; }
        __syncthreads();
        for (int ch = tid; ch < 1024; ch += 512) { const int s = ch >> 4, d0 = (ch & 15) * 8; float v[8], o[8];
            unpack8(*(const u32x4*)(P + (size_t)(n * 64 + s) * NP + C_GQ + h * 128 + d0), v);
#pragma unroll
            for (int i = 0; i < 8; ++i) o[i] = v[i] * 0.08838834764831845f * __expf(bc[s * 128 + d0 + i]);
            *(u32x4*)(Q + s * 136 + d0) = pack8(o);
            unpack8(*(const u32x4*)(P + (size_t)(n * 64 + s) * NP + C_GK + h * 128 + d0), v);
#pragma unroll
            for (int i = 0; i < 8; ++i) o[i] = v[i] * __expf(-bc[s * 128 + d0 + i]);
            *(u32x4*)(Kk + s * 136 + d0) = pack8(o); }
        for (int ch = tid; ch < 2048; ch += 512) { const int s = ch >> 5, d0 = (ch & 31) * 8; const u32x4 w = *(const u32x4*)(P + (size_t)(n * 64 + s) * NP + C_GV + h * 256 + d0);
            VT[(d0 + 0) * 72 + (s ^ tsw(d0))] = (bf16_t)(w.x & 0xffff); VT[(d0 + 1) * 72 + (s ^ tsw(d0))] = (bf16_t)(w.x >> 16); VT[(d0 + 2) * 72 + (s ^ tsw(d0))] = (bf16_t)(w.y & 0xffff); VT[(d0 + 3) * 72 + (s ^ tsw(d0))] = (bf16_t)(w.y >> 16);
            VT[(d0 + 4) * 72 + (s ^ tsw(d0))] = (bf16_t)(w.z & 0xffff); VT[(d0 + 5) * 72 + (s ^ tsw(d0))] = (bf16_t)(w.z >> 16); VT[(d0 + 6) * 72 + (s ^ tsw(d0))] = (bf16_t)(w.w & 0xffff); VT[(d0 + 7) * 72 + (s ^ tsw(d0))] = (bf16_t)(w.w >> 16); }
        __syncthreads();
#pragma unroll
        for (int ti = 0; ti < 2; ++ti) { const int id = wave * 2 + ti, mt = id >> 2, nt = id & 3;
            f32x4 c = {0.f, 0.f, 0.f, 0.f};
#pragma unroll
            for (int ks = 0; ks < 4; ++ks) c = mfma16(*(const bf16x8*)(Q + (mt * 16 + l15) * 136 + ks * 32 + q * 8), *(const bf16x8*)(Kk + (nt * 16 + l15) * 136 + ks * 32 + q * 8), c);
#pragma unroll
            for (int j = 0; j < 4; ++j) { const int t = mt * 16 + q * 4 + j, s = nt * 16 + l15; ATS[t * 72 + s] = (bf16_t)f2bf(s <= t ? c[j] : 0.f); } }
        __syncthreads();
        const int mt = wave & 3, half = wave >> 2;
        bf16_t grv[4][8];
#pragma unroll
        for (int j = 0; j < 4; ++j)
#pragma unroll
            for (int i = 0; i < 8; ++i) grv[j][i] = P[(size_t)(n * 64 + mt * 16 + q * 4 + j) * NP + C_GR + h * 256 + (half * 8 + i) * 16 + l15];
        f32x4 acc[8];
#pragma unroll
        for (int i = 0; i < 8; ++i) acc[i] = (f32x4){0.f, 0.f, 0.f, 0.f};
        const bf16_t* Sg = (const bf16_t*)a.out + (size_t)it * 32768;
#pragma unroll
        for (int ks = 0; ks < 4; ++ks) { const bf16x8 aq = *(const bf16x8*)(Q + (mt * 16 + l15) * 136 + ks * 32 + q * 8);
#pragma unroll
            for (int i = 0; i < 8; ++i) acc[i] = mfma16(aq, *(const bf16x8*)(Sg + ((half * 8 + i) * 16 + l15) * 128 + ks * 32 + q * 8), acc[i]); }
#pragma unroll
        for (int ks = 0; ks < 2; ++ks) { const bf16x8 at = *(const bf16x8*)(ATS + (mt * 16 + l15) * 72 + ks * 32 + q * 8);
#pragma unroll
            for (int i = 0; i < 8; ++i) { const int vr = (half * 8 + i) * 16 + l15; acc[i] = mfma16(at, *(const bf16x8*)(VT + vr * 72 + ((ks * 32 + q * 8) ^ tsw(vr))), acc[i]); } }
        float ssq[4];
#pragma unroll
        for (int j = 0; j < 4; ++j) { float s = 0.f;
#pragma unroll
            for (int i = 0; i < 8; ++i) s += acc[i][j] * acc[i][j];
            s += __shfl_xor(s, 1); s += __shfl_xor(s, 2); s += __shfl_xor(s, 4); s += __shfl_xor(s, 8); ssq[j] = s; }
        if (l15 == 0) {
#pragma unroll
            for (int j = 0; j < 4; ++j) RS[(mt * 16 + q * 4 + j) * 2 + half] = ssq[j]; }
        __syncthreads();
#pragma unroll
        for (int j = 0; j < 4; ++j) { const int t = mt * 16 + q * 4 + j; const float rstd = rsqrtf((RS[t * 2] + RS[t * 2 + 1]) * (1.f / 256.f) + EPS);
#pragma unroll
            for (int i = 0; i < 8; ++i) { const int dv = (half * 8 + i) * 16 + l15; const float gr = bf1(grv[j][i]);
                OUTS[t * 264 + dv] = (bf16_t)f2bf(acc[i][j] * rstd * a.in[18][dv] * siluf(gr)); } }
        __syncthreads();
#pragma unroll
        for (int c4 = 0; c4 < 4; ++c4) { const int c = tid + 512 * c4, row = c >> 5, col = (c & 31) * 8;
            *(u32x4*)(P + (size_t)(n * 64 + row) * NP + 1024 + h * 256 + col) = *(const u32x4*)(OUTS + row * 264 + col); }
        __syncthreads();
    }
}

__device__ __forceinline__ unsigned mono_key(float f) { const unsigned u = __builtin_bit_cast(unsigned, f); return (u & 0x80000000u) ? ~u : (u | 0x80000000u); }
template <int NE> __device__ __forceinline__ unsigned select_kth(const unsigned (&e)[NE], int kth, int lowbit = 0) {
    unsigned mx = 0u, mn = 0xFFFFFFFFu;
#pragma unroll
    for (int j = 0; j < NE; ++j) { mx = max(mx, e[j]); mn = min(mn, e[j] ? e[j] : 0xFFFFFFFFu); }
#pragma unroll
    for (int o = 1; o < 64; o <<= 1) { mx = max(mx, (unsigned)__shfl_xor((int)mx, o)); mn = min(mn, (unsigned)__shfl_xor((int)mn, o)); }
    const unsigned dif = mx ^ mn;
    const int hb = dif ? 31 - __clz((int)dif) : -1;
    unsigned tau = hb >= 31 ? 0u : (hb < 0 ? mx : (mx & ~((2u << hb) - 1u)));
    for (int bit = hb; bit >= lowbit; --bit) { const unsigned cand = tau | (1u << bit); int c = 0;
#pragma unroll
        for (int j = 0; j < NE; ++j) c += __popcll(__ballot(e[j] >= cand));
        if (c >= kth) tau = cand; }
    return tau;
}
__device__ __forceinline__ unsigned compact1024(unsigned* base, int n, int lane, int lowbit, int& newcnt) {
    unsigned e[16];
#pragma unroll
    for (int j = 0; j < 16; ++j) { const int i = j * 64 + lane; e[j] = i < n ? base[i] : 0u; }
    const unsigned tau = select_kth<16>(e, 256, lowbit);
    const u64 lt = (1ull << lane) - 1ull; int run = 0;
#pragma unroll
    for (int j = 0; j < 16; ++j) { const bool p = e[j] >= tau; const u64 m = __ballot(p); if (p) base[run + __popcll(m & lt)] = e[j]; run += __popcll(m); }
    newcnt = run;
    return tau;
}
__device__ __forceinline__ void compact_final(unsigned* base, int n, int lane, int& newcnt) {
    unsigned e[16];
#pragma unroll
    for (int j = 0; j < 16; ++j) { const int i = j * 64 + lane; e[j] = i < n ? base[i] : 0u; }
    const unsigned t18 = select_kth<16>(e, 256, 14) >> 14;
    int cgt = 0;
#pragma unroll
    for (int j = 0; j < 16; ++j) cgt += __popcll(__ballot((e[j] >> 14) > t18));
    const int need = 256 - cgt;
    const u64 lt = (1ull << lane) - 1ull; int run = 0, trun = 0;
#pragma unroll
    for (int j = 0; j < 16; ++j) { const bool gt = (e[j] >> 14) > t18, tie = (e[j] >> 14) == t18 && e[j] != 0u;
        const u64 mt = __ballot(tie); const int trank = trun + __popcll(mt & lt);
        const bool keep = gt || (tie && trank < need);
        const u64 mk = __ballot(keep); if (keep) base[run + __popcll(mk & lt)] = e[j]; run += __popcll(mk); trun += __popcll(mt); }
    newcnt = run;
}
__device__ __forceinline__ const bf16_t* ik_row(const bf16_t* IKC, const bf16_t* CIK, bool sample, int b, int k) {
    if (!sample) return IKC + (size_t)k * 64;
    return k < 1024 ? CIK + (size_t)(b * 1024 + k) * 64 : IKC + (size_t)(TP + b * 64 + (k - 1024)) * 64;
}
__device__ __forceinline__ float relu_i(float x) { const int b = __builtin_bit_cast(int, x); return __builtin_bit_cast(float, b > 0 ? b : 0); }
constexpr int IDX_TAB_N = 3;
__device__ const unsigned short IDX_TAB[256][IDX_TAB_N] = {{401,86,65535},{416,72,65535},{395,101,65535},{393,96,65535},{399,95,65535},{390,100,65535},{391,102,65535},{410,75,65535},{406,80,65535},{384,113,65535},{385,108,65535},{377,121,65535},{388,106,65535},{378,118,65535},{371,127,65535},{381,114,65535},{369,132,65535},{370,126,65535},{374,120,65535},{364,135,65535},{373,125,65535},{362,136,65535},{368,133,65535},{354,148,65535},{359,145,65535},{363,138,65535},{356,143,65535},{358,140,65535},{365,139,65535},{360,147,65535},{355,149,65535},{353,152,65535},{350,155,65535},{352,150,65535},{348,156,65535},{347,158,65535},{346,159,65535},{349,157,65535},{344,161,65535},{345,162,65535},{341,166,65535},{343,163,65535},{340,168,65535},{342,164,65535},{338,171,65535},{339,170,65535},{336,172,65535},{337,173,65535},{334,175,65535},{335,174,65535},{332,176,65535},{333,177,65535},{329,180,65535},{331,179,65535},{328,182,65535},{330,178,65535},{326,184,65535},{327,185,65535},{324,186,65535},{325,183,65535},{322,188,65535},{323,189,65535},{320,190,65535},{321,191,65535},{318,192,65535},{319,193,65535},{316,194,65535},{317,195,65535},{314,196,65535},{315,197,65535},{312,198,65535},{313,199,65535},{310,200,65535},{311,201,65535},{308,202,65535},{309,203,65535},{306,204,65535},{307,205,65535},{304,206,65535},{305,207,65535},{302,208,65535},{303,209,65535},{300,210,65535},{301,211,65535},{298,212,65535},{299,213,65535},{296,214,65535},{297,215,65535},{294,216,65535},{295,217,65535},{292,218,65535},{293,219,65535},{290,220,65535},{291,221,65535},{288,222,65535},{289,223,65535},{286,224,65535},{287,225,65535},{284,226,65535},{285,227,65535},{282,228,65535},{283,229,65535},{280,230,65535},{281,231,65535},{278,232,65535},{279,233,65535},{276,234,65535},{277,235,65535},{274,236,65535},{275,237,65535},{272,238,65535},{273,239,65535},{270,240,65535},{271,241,65535},{268,242,65535},{269,243,65535},{266,244,65535},{267,245,65535},{264,246,65535},{265,247,65535},{262,248,65535},{263,249,65535},{260,250,65535},{261,251,65535},{258,252,65535},{259,253,65535},{256,254,65535},{257,255,65535},{508,16,65535},{511,10,65535},{510,12,65535},{509,15,65535},{506,20,65535},{507,19,65535},{504,22,65535},{500,24,65535},{502,23,65535},{503,25,65535},{505,21,65535},{501,27,65535},{498,18,65535},{499,29,65535},{496,30,65535},{497,28,65535},{491,526,65535},{495,527,65535},{492,524,65535},{493,525,65535},{490,522,65535},{494,31,65535},{488,520,65535},{483,513,65535},{486,518,65535},{482,37,65535},{484,516,65535},{489,517,65535},{487,514,65535},{485,515,65535},{480,38,65535},{481,36,65535},{478,32,9},{479,35,3},{472,521,17},{463,519,26},{474,523,11},{476,512,13},{475,33,8},{439,42,34},{470,40,6},{471,39,7},{467,45,4},{469,43,5},{466,47,2},{458,46,14},{464,51,0},{465,49,1},{468,48,65535},{477,41,65535},{460,50,65535},{473,44,65535},{462,52,65535},{461,53,65535},{456,57,65535},{457,55,65535},{454,56,65535},{455,59,65535},{452,58,65535},{459,54,65535},{453,60,65535},{451,61,65535},{448,62,65535},{450,63,65535},{449,64,65535},{447,65,65535},{444,66,65535},{446,67,65535},{442,68,65535},{445,69,65535},{443,70,65535},{441,71,65535},{438,76,65535},{440,73,65535},{436,74,65535},{437,77,65535},{434,79,65535},{430,84,65535},{435,78,65535},{433,81,65535},{432,82,65535},{431,83,65535},{428,85,65535},{426,89,65535},{429,87,65535},{427,88,65535},{424,91,65535},{422,92,65535},{425,90,65535},{423,93,65535},{418,98,65535},{421,97,65535},{420,94,65535},{419,99,65535},{413,104,65535},{417,103,65535},{407,115,65535},{408,112,65535},{414,107,65535},{415,105,65535},{403,119,65535},{412,109,65535},{411,110,65535},{400,123,65535},{404,116,65535},{409,111,65535},{398,124,65535},{405,117,65535},{402,122,65535},{396,131,65535},{392,130,65535},{394,128,65535},{383,142,65535},{389,134,65535},{387,137,65535},{397,129,65535},{386,141,65535},{376,151,65535},{375,154,65535},{372,160,65535},{380,146,65535},{379,153,65535},{382,144,65535},{366,165,65535},{357,181,65535},{351,187,65535},{361,169,65535},{367,167,65535}};
constexpr int IKP = 144;
__device__ __forceinline__ void idx_phase(const Args& a, unsigned char* lds, int tid, int lane, int wave) {
    const bf16_t* P = (const bf16_t*)(a.ws + WS_P); const bf16_t* CIK = (const bf16_t*)(a.ws + WS_CIK); const bf16_t* IKC = (const bf16_t*)(a.ws + WS_IKC);
    unsigned* CAND = (unsigned*)(a.ws + WS_ACT);
    unsigned* lst = (unsigned*)(lds + wave * 16384);
    unsigned char* kbuf = lds + 131072;
    const int r = lane & 31, hf = lane >> 5;
    const int qsel = (r >> 2) & 1, head = (r & 3) + 4 * (r >> 3);
    const int skey = tid >> 3, schk = tid & 7;
    const bool use_tab = gridDim.x == 256;
    for (int kk = 0; ; ++kk) {
        int id;
        if (use_tab) { if (kk >= IDX_TAB_N) break; id = IDX_TAB[blockIdx.x][kk]; if (id == 0xFFFF) break; }
        else { const int it = blockIdx.x + kk * gridDim.x; if (it >= 528) break;
               id = it < 256 ? (255 - (it >> 1)) * 2 + (it & 1) : (it < 512 ? ((it - 256) >> 1) * 2 + (it & 1) : it); }
        int c, half = id & 1, bb = 0; bool sample = false;
        if (id < 512) c = id >> 1;
        else { sample = true; bb = (id - 512) >> 1; c = 256 + bb; }
        const int L = sample ? 1088 : 64 * (c + 1), ntile = L >> 6;
        const int t0 = c * 64 + half * 32 + wave * 4;
        bf16x8 af[2][4]; float w[2][16];
#pragma unroll
        for (int rb = 0; rb < 2; ++rb) {
            const bf16_t* qp = P + (size_t)(t0 + 2 * rb + qsel) * NP + C_IQ + head * 64 + hf * 8;
#pragma unroll
            for (int ks = 0; ks < 4; ++ks) af[rb][ks] = *(const bf16x8*)(qp + ks * 16);
            const bf16_t* wp = P + (size_t)(t0 + 2 * rb + hf) * NP + C_IW;
            unpack8(*(const u32x4*)wp, w[rb]); unpack8(*(const u32x4*)(wp + 8), w[rb] + 8);
        }
        unsigned tau[2], cnt[2];
#pragma unroll
        for (int rb = 0; rb < 2; ++rb) { tau[rb] = 0u; cnt[rb] = 0u; }
        { const u32x4 v = *(const u32x4*)(ik_row(IKC, CIK, sample, bb, skey) + schk * 8); *(u32x4*)(kbuf + skey * IKP + schk * 16) = v; }
        u32x4 p1 = {0u, 0u, 0u, 0u}, p2 = p1, p3 = p1;
        if (1 < ntile) p1 = *(const u32x4*)(ik_row(IKC, CIK, sample, bb, 1 * 64 + skey) + schk * 8);
        if (2 < ntile) p2 = *(const u32x4*)(ik_row(IKC, CIK, sample, bb, 2 * 64 + skey) + schk * 8);
        if (3 < ntile) p3 = *(const u32x4*)(ik_row(IKC, CIK, sample, bb, 3 * 64 + skey) + schk * 8);
        __syncthreads();
#define IDX_MFMA8(ACC, KBP, SUB) do { bf16x8 bfr[4]; \
            _Pragma("unroll") for (int ks = 0; ks < 4; ++ks) bfr[ks] = *(const bf16x8*)((KBP) + ((SUB) * 32 + r) * IKP + ks * 32 + hf * 16); \
            _Pragma("unroll") for (int i = 0; i < 16; ++i) { ACC[0][i] = 0.f; ACC[1][i] = 0.f; } \
            __builtin_amdgcn_s_setprio(1); \
            _Pragma("unroll") for (int ks = 0; ks < 4; ++ks) { ACC[0] = __builtin_amdgcn_mfma_f32_32x32x16_bf16(af[0][ks], bfr[ks], ACC[0], 0, 0, 0); ACC[1] = __builtin_amdgcn_mfma_f32_32x32x16_bf16(af[1][ks], bfr[ks], ACC[1], 0, 0, 0); } \
            __builtin_amdgcn_s_setprio(0); } while (0)
#define IDX_SCORE(ACC, ENT, KEY) do { _Pragma("unroll") for (int rb = 0; rb < 2; ++rb) { float s0 = 0.f, s1 = 0.f; \
            _Pragma("unroll") for (int i = 0; i < 16; i += 2) { s0 += relu_i(ACC[rb][i]) * w[rb][i]; s1 += relu_i(ACC[rb][i + 1]) * w[rb][i + 1]; } \
            ENT[rb] = (mono_key(s0 + s1) & 0xFFFFC000u) | (KEY); } } while (0)
#define IDX_INTERLEAVE() do { _Pragma("unroll") for (int i_ = 0; i_ < 8; ++i_) { __builtin_amdgcn_sched_group_barrier(0x008, 1, 0); __builtin_amdgcn_sched_group_barrier(0x002, 9, 0); } } while (0)
#define IDX_INSERT(ENT) do { _Pragma("unroll") for (int rb = 0; rb < 2; ++rb) { \
            const unsigned ent = ENT[rb]; const bool p = ent > tau[rb]; const u64 m = __ballot(p); \
            if (m) { const unsigned mh = hf ? (unsigned)(m >> 32) : (unsigned)m; \
                if (p) lst[(2 * rb + hf) * 1024 + cnt[rb] + __popc(mh & ((1u << r) - 1u))] = ent; \
                cnt[rb] += __popc(mh); \
                if (__any(cnt[rb] > 992u)) { \
                    _Pragma("unroll") for (int hh = 0; hh < 2; ++hh) { const int cc = __builtin_amdgcn_readlane((int)cnt[rb], hh * 32); \
                        if (cc > 992) { int nc; const unsigned nt_ = compact1024(lst + (2 * rb + hh) * 1024, cc, lane, 14, nc); if (hf == hh) { tau[rb] = nt_; cnt[rb] = (unsigned)nc; } } } } } } } while (0)
        f32x16 accA[2], accB[2];
        IDX_MFMA8(accA, kbuf, 0);
        for (int tl = 0; tl < ntile; ++tl) {
            u32x4 p4 = {0u, 0u, 0u, 0u};
            if (tl + 4 < ntile) p4 = *(const u32x4*)(ik_row(IKC, CIK, sample, bb, (tl + 4) * 64 + skey) + schk * 8);
            const unsigned char* kb = kbuf + (tl & 1) * (64 * IKP);
            const unsigned char* kbn = kbuf + ((tl + 1) & 1) * (64 * IKP);
            unsigned entA[2], entB[2];
            IDX_MFMA8(accB, kb, 1);
            IDX_SCORE(accA, entA, (unsigned)(tl * 64 + r));
            IDX_INTERLEAVE();
            IDX_INSERT(entA);
            if (tl + 1 < ntile) *(u32x4*)(kbuf + ((tl + 1) & 1) * (64 * IKP) + skey * IKP + schk * 16) = p1;
            __syncthreads();
            if (tl + 1 < ntile) { IDX_MFMA8(accA, kbn, 0); IDX_SCORE(accB, entB, (unsigned)(tl * 64 + 32 + r)); IDX_INTERLEAVE(); }
            else { IDX_SCORE(accB, entB, (unsigned)(tl * 64 + 32 + r)); }
            IDX_INSERT(entB);
            if (tl == 14 || tl == 50 || tl == 174) {
#pragma unroll
                for (int rb = 0; rb < 2; ++rb)
#pragma unroll
                    for (int hh = 0; hh < 2; ++hh) { const int cc = __builtin_amdgcn_readlane((int)cnt[rb], hh * 32);
                        if (cc > 256) { int nc; const unsigned nt_ = compact1024(lst + (2 * rb + hh) * 1024, cc, lane, 14, nc); if (hf == hh) { tau[rb] = nt_; cnt[rb] = (unsigned)nc; } } }
            }
            p1 = p2; p2 = p3; p3 = p4;
        }
#pragma unroll
        for (int rb = 0; rb < 2; ++rb)
#pragma unroll
            for (int hh = 0; hh < 2; ++hh) { int cc = __builtin_amdgcn_readlane((int)cnt[rb], hh * 32); unsigned* base = lst + (2 * rb + hh) * 1024;
                if (cc > 256) { int nc; compact_final(base, cc, lane, nc); cc = nc; }
                unsigned* dst = CAND + (size_t)(t0 + 2 * rb + hh) * 256;
                for (int j = lane; j < cc; j += 64) dst[j] = base[j]; }
    }
}

__device__ __forceinline__ void attn_phase(const Args& a, unsigned char* lds, int lane, int wave) {
    bf16_t* P = (bf16_t*)(a.ws + WS_P);
    const unsigned char* KV8 = a.ws + WS_KV8; const unsigned char* CKV8 = a.ws + WS_CKV8;
    const unsigned* CAND = (const unsigned*)(a.ws + WS_ACT);
    unsigned* sel = (unsigned*)(lds + 122880 + wave * 1024);
    const int gw = blockIdx.x * 8 + wave, NGW = gridDim.x * 8;
    for (int t = gw; t < TT; t += NGW) {
        const bool sample = t >= TP; const int bb = sample ? (t - TP) >> 6 : 0;
        const int c = t >> 6; const int L = sample ? 1088 : 64 * (c + 1);
        const int nsel = min(256, L);
        const unsigned* cand = CAND + (size_t)t * 256;
#pragma unroll
        for (int j = 0; j < 4; ++j) { const int i = j * 64 + lane; if (i < nsel) sel[i] = cand[i] & 0x3FFFu; }
        bf16_t* qp = P + (size_t)t * NP + lane * 16;
        float q[16]; unpack8(*(const u32x4*)qp, q); unpack8(*(const u32x4*)(qp + 8), q + 8);
        float mx = -INFINITY, l = 0.f, o[16];
#pragma unroll
        for (int d = 0; d < 16; ++d) o[d] = 0.f;
        for (int j = 0; j < nsel; j += 8) {
            const u32x4 ida = *(const u32x4*)(sel + j), idb = *(const u32x4*)(sel + j + 4);
            u32x4 kk[8], vv[8];
#pragma unroll
            for (int i = 0; i < 8; ++i) { const int idx = (int)(i < 4 ? ida[i & 3] : idb[i & 3]); const unsigned char* kp;
                if (!sample) kp = KV8 + (size_t)idx * 2048;
                else if (idx < 1024) kp = CKV8 + (size_t)(bb * 1024 + idx) * 2048;
                else kp = KV8 + (size_t)(TP + bb * 64 + idx - 1024) * 2048;
                kk[i] = *(const u32x4*)(kp + lane * 16); vv[i] = *(const u32x4*)(kp + 1024 + lane * 16); }
            float s[8];
#pragma unroll
            for (int i = 0; i < 8; ++i) { float kf[16]; unpack16_fp8(kk[i], kf); float d0 = 0.f, d1 = 0.f;
#pragma unroll
                for (int x = 0; x < 16; x += 2) { d0 += q[x] * kf[x]; d1 += q[x + 1] * kf[x + 1]; }
                float d = d0 + d1;
                d += __shfl_xor(d, 1); d += __shfl_xor(d, 2); d += __shfl_xor(d, 4); s[i] = d; }
            const float mn = fmaxf(fmaxf(fmaxf(mx, fmaxf(s[0], s[1])), fmaxf(s[2], s[3])), fmaxf(fmaxf(s[4], s[5]), fmaxf(s[6], s[7])));
            const float al = __builtin_amdgcn_exp2f(mx - mn);
            float p[8];
#pragma unroll
            for (int i = 0; i < 8; ++i) p[i] = __builtin_amdgcn_exp2f(s[i] - mn);
            l = l * al + ((p[0] + p[1]) + (p[2] + p[3])) + ((p[4] + p[5]) + (p[6] + p[7]));
#pragma unroll
            for (int d = 0; d < 16; ++d) o[d] *= al;
#pragma unroll
            for (int i = 0; i < 8; ++i) { float vf[16]; unpack16_fp8(vv[i], vf);
#pragma unroll
                for (int d = 0; d < 16; ++d) o[d] += p[i] * vf[d]; }
            mx = mn;
        }
        const float il = 1.f / l;
#pragma unroll
        for (int d = 0; d < 16; ++d) o[d] *= il;
        *(u32x4*)qp = pack8(o); *(u32x4*)(qp + 8) = pack8(o + 8);
    }
}

__device__ __forceinline__ void fixup_phase(const Args& a, int tid) {
    const bf16_t* Uf = (const bf16_t*)(a.ws + WS_UF); const bf16_t* Uh = (const bf16_t*)(a.ws + WS_UH);
    bf16_t* ACTF = (bf16_t*)(a.ws + WS_P);
    const float* wconv = a.in[21]; const float* bconv = a.in[22];
    const size_t gt = (size_t)blockIdx.x * 512 + tid, GT = (size_t)gridDim.x * 512;
    for (size_t e = gt; e < (size_t)NCH * DFF; e += GT) {
        const int g = (int)(e / DFF), ch = (int)(e % DFF);
        float pa[2], pb[2];
        if (g >= 256) { const float* st = a.in[8] + (size_t)(g - 256) * 2 * NUP; pa[0] = st[ch]; pa[1] = st[NUP + ch]; pb[0] = st[DFF + ch]; pb[1] = st[NUP + DFF + ch]; }
        else if (g == 0) { pa[0] = pa[1] = pb[0] = pb[1] = 0.f; }
        else { const bf16_t* st = Uh + (size_t)(g - 1) * 2 * NUP; pa[0] = bf1(st[ch]); pa[1] = bf1(st[NUP + ch]); pb[0] = bf1(st[DFF + ch]); pb[1] = bf1(st[NUP + DFF + ch]); }
        const bf16_t* uf = Uf + (size_t)g * 2 * NUP;
        const float a0 = bf1(uf[ch]), a1 = bf1(uf[NUP + ch]), b0 = bf1(uf[DFF + ch]), b1 = bf1(uf[NUP + DFF + ch]);
        const float wa0 = wconv[ch], wa1 = wconv[NUP + ch], wa2 = wconv[2 * NUP + ch], ba = bconv[ch];
        const float wb0 = wconv[DFF + ch], wb1 = wconv[NUP + DFF + ch], wb2 = wconv[2 * NUP + DFF + ch], bb = bconv[DFF + ch];
        const float ca0 = ba + wa2 * a0 + wa1 * pa[1] + wa0 * pa[0], cb0 = bb + wb2 * b0 + wb1 * pb[1] + wb0 * pb[0];
        const float ca1 = ba + wa2 * a1 + wa1 * a0 + wa0 * pa[1], cb1 = bb + wb2 * b1 + wb1 * b0 + wb0 * pb[1];
        ACTF[(size_t)(g * 64) * DFF + ch] = (bf16_t)f2bf(siluf(ca0) * cb0);
        ACTF[(size_t)(g * 64 + 1) * DFF + ch] = (bf16_t)f2bf(siluf(ca1) * cb1);
    }
    for (size_t e = gt; e < (size_t)9 * 2 * NUP; e += GT) {
        const int s = (int)(e / (2 * NUP)), rem = (int)(e % (2 * NUP));
        const int g = s == 0 ? 255 : 255 + s;
        const float v = bf1(Uh[(size_t)g * 2 * NUP + rem]);
        if (s == 0) a.out[O_FCP + rem] = v; else a.out[O_FCS + (size_t)(s - 1) * 2 * NUP + rem] = v;
    }
}

#define LAS __attribute__((address_space(3)))
#define XB_TMO      128
#define XB_XCNT(j)  (256  + 64 * (j))
#define XB_XSUB(j)  (1280 + 64 * (j))
#define XB_XGEN(j)  (2304 + 64 * (j))
#define XB_TOP      3328
#define XB_TOPGEN   3392
#define XCD_BAR_WORDS 3456
#define XB_SPIN_CAP (1u << 18)

__device__ __forceinline__ unsigned xb_ld(unsigned* p)              { return __hip_atomic_load(p, __ATOMIC_RELAXED, __HIP_MEMORY_SCOPE_AGENT); }
__device__ __forceinline__ unsigned xb_add(unsigned* p, unsigned v) { return __hip_atomic_fetch_add(p, v, __ATOMIC_RELAXED, __HIP_MEMORY_SCOPE_AGENT); }
__device__ __forceinline__ unsigned xb_xcc_id() { return (unsigned)__builtin_amdgcn_s_getreg((3 << 11) | 20) & 0xFu; }
#define XB_SPIN(cond, bar) do { unsigned _sp = 0; while (cond) { __builtin_amdgcn_s_sleep(1); \
    if ((++_sp & 255u) == 0u) { if (xb_ld(&(bar)[XB_TMO])) break; if (_sp > XB_SPIN_CAP) { atomicAdd(&(bar)[XB_TMO], 1u); break; } } } } while (0)

struct XcdBarrier {
    unsigned* bar; unsigned x;
    volatile LAS unsigned* st;
};

__device__ __forceinline__ XcdBarrier xcd_barrier_post(unsigned* bar, volatile LAS unsigned* st) {
    XcdBarrier b; b.bar = bar; b.x = xb_xcc_id(); b.st = st;
    if (threadIdx.x == 0) (void)xb_add(&bar[XB_XCNT(b.x)], 1u);
    return b;
}
__device__ __forceinline__ void xcd_barrier_complete(unsigned* bar, unsigned x, unsigned& nloc, unsigned& nx) {
    const unsigned G = gridDim.x * gridDim.y * gridDim.z;
    unsigned sum, cnt, mine, sp = 0u;
    for (;;) {
        sum = 0u; cnt = 0u; mine = 0u;
#pragma unroll
        for (unsigned j = 0; j < 16; ++j) { const unsigned c = xb_ld(&bar[XB_XCNT(j)]); sum += c; cnt += (c > 0u) ? 1u : 0u; mine = (j == x) ? c : mine; }
        if (sum == G) break;
        __builtin_amdgcn_s_sleep(1);
        if ((++sp & 255u) == 0u) { if (xb_ld(&bar[XB_TMO])) break; if (sp > XB_SPIN_CAP) { atomicAdd(&bar[XB_TMO], 1u); break; } }
    }
    nloc = mine > 0u ? mine : 1u; nx = cnt > 0u ? cnt : 1u;
}

__device__ __forceinline__ void xcd_barrier(const XcdBarrier& b) {
    asm volatile("s_waitcnt vmcnt(0)" ::: "memory");
    __syncthreads();
    if (threadIdx.x == 0) {
        unsigned* bar = b.bar;
        __builtin_amdgcn_s_waitcnt(0);
        unsigned nloc = b.st[0], nx = b.st[1];
        if (nloc == 0u) { xcd_barrier_complete(bar, b.x, nloc, nx); b.st[0] = nloc; b.st[1] = nx; }
        const unsigned old = xb_add(&bar[XB_XSUB(b.x)], 1u);
        const unsigned gen = old / nloc;
        if (old + 1u == (gen + 1u) * nloc) {
            __builtin_amdgcn_fence(__ATOMIC_RELEASE, "agent");
            asm volatile("s_waitcnt vmcnt(0)" ::: "memory");
            const unsigned og = xb_add(&bar[XB_TOP], 1u);
            const unsigned tg = og / nx;
            if (og + 1u == (tg + 1u) * nx) xb_add(&bar[XB_TOPGEN], 1u);
            else XB_SPIN(xb_ld(&bar[XB_TOPGEN]) == tg, bar);
            __builtin_amdgcn_fence(__ATOMIC_ACQUIRE, "agent");
            xb_add(&bar[XB_XGEN(b.x)], 1u);
            asm volatile("s_waitcnt vmcnt(0)" ::: "memory");
        } else {
            XB_SPIN(xb_ld(&bar[XB_XGEN(b.x)]) == gen, bar);
            __builtin_amdgcn_fence(__ATOMIC_ACQUIRE, "agent");
            asm volatile("s_waitcnt vmcnt(0)" ::: "memory");
        }
    }
    __syncthreads();
}

__global__ void __launch_bounds__(512, 2) mega_fwd(Args a) {
    extern __shared__ __attribute__((aligned(16))) unsigned char lds[];
    cg::grid_group grid = cg::this_grid();
    const int tid = threadIdx.x, lane = tid & 63, wave = __builtin_amdgcn_readfirstlane(tid >> 6);
    unsigned char* ws = a.ws;
    const float* MOD = (const float*)(ws + WS_MOD);
#ifndef ONLY_PH
#define ONLY_PH -1
#endif
#define PHON(k) ((ONLY_PH < 0 || ONLY_PH == (k)) && lo <= (k) && (k) <= hi)
    volatile LAS unsigned* bst = (volatile LAS unsigned*)((PG8_LAS unsigned char*)lds + (LDS_BYTES - 64));
    if (tid == 0) { bst[0] = 0u; bst[1] = 0u; }
    __syncthreads();
    const XcdBarrier xbar = xcd_barrier_post((unsigned*)(ws + WS_CTL) + 1024, bst);
    if (a.ph_lo > NPHASE) grid.sync();
#define SEAM(k) do { if ((k) < hi) xcd_barrier(xbar); } while (0)
    const int lo = a.ph_lo, hi = a.ph_hi;
    if (PHON(0)) { phase0(a, lds, tid, lane, wave);
        SEAM(0); }
    if (PHON(1)) { normmod_phase(a.in[0], a.in[1], a.in[11], MOD, 0 * DM, 1 * DM, (bf16_t*)(ws + WS_ACT), lane, wave); SEAM(1); }
    if (PHON(2)) {
        pg8::Gemm g{(const bf16_t*)(ws + WS_ACT), (const bf16_t*)(ws + WS_WIN), TT, NP, DM, DM}; pg8::StaticOrder S; S.init(TT, NP, gridDim.x, blockIdx.x);
        EpiP E{(bf16_t*)(ws + WS_P), NP};
        pg8::gemm_phase<EpiP, pg8::StaticOrder, true, true>((PG8_LAS unsigned char*)lds, g, S, E);
        { int rank, count; if (gemm_tail_rank(S.nwg, rank, count)) tail_wout(a, lds, rank, count, lane, wave); else if (count <= 0 && blockIdx.x == 0) tail_wout(a, lds, 0, 1, lane, wave); }
        SEAM(2);
    }
    const bool swap_order = ((blockIdx.x >> 3) & 1) != 0;
    if (PHON(3)) {
        if (swap_order) { gla_g1(a, lds, tid, lane, wave); __syncthreads(); post_rows(a, lds, tid, lane, wave); }
        else { post_rows(a, lds, tid, lane, wave); gla_g1(a, lds, tid, lane, wave); }
        SEAM(3); }
    if (PHON(4)) { gla_g2(a, tid); idx_phase(a, lds, tid, lane, wave); SEAM(4); }
    if (PHON(5)) {
        attn_phase(a, lds, lane, wave); __syncthreads(); gla_g3(a, lds, tid, lane, wave);
        SEAM(5); }
    if (PHON(6)) {
        pg8::Gemm g{(const bf16_t*)(ws + WS_P), (const bf16_t*)(ws + WS_WOUT), TT, DM, DM, NP}; pg8::StaticOrder S; S.init(TT, DM, gridDim.x, blockIdx.x);
        EpiRes E{a.in[0], a.in[1], a.out + O_Y, MOD + 2 * DM};
        pg8::gemm_phase<EpiRes, pg8::StaticOrder, true, true>((PG8_LAS unsigned char*)lds, g, S, E);
        { int rank, count; if (gemm_tail_rank(S.nwg, rank, count)) tail_wup_wdn(a, lds, rank, count, lane, wave); else if (count <= 0 && blockIdx.x == 0) tail_wup_wdn(a, lds, 0, 1, lane, wave); }
        SEAM(6);
    }
    if (PHON(7)) { normmod_phase(a.out + O_Y, a.out + O_Y + (size_t)TP * DM, a.in[12], MOD, 3 * DM, 4 * DM, (bf16_t*)(ws + WS_ACT), lane, wave); SEAM(7); }
    if (PHON(8)) {
        pg8::Gemm g{(const bf16_t*)(ws + WS_ACT), (const bf16_t*)(ws + WS_WUP), TT, NUP, DM, DM}; pg8::StaticOrder S; S.init(TT, NUP, gridDim.x, blockIdx.x);
        EpiUp E{(bf16_t*)(ws + WS_P), (bf16_t*)(ws + WS_UF), (bf16_t*)(ws + WS_UH), a.in[21], a.in[22]};
        pg8::gemm_phase<EpiUp, pg8::StaticOrder, true, true>((PG8_LAS unsigned char*)lds, g, S, E);
        SEAM(8);
    }
    if (PHON(9)) { fixup_phase(a, tid); SEAM(9); }
    if (PHON(10)) {
        pg8::Gemm g{(const bf16_t*)(ws + WS_P), (const bf16_t*)(ws + WS_WDN), TT, DM, DFF, DFF}; pg8::StaticOrder S; S.init(TT, DM, gridDim.x, blockIdx.x);
        EpiRes E{a.out + O_Y, a.out + O_Y + (size_t)TP * DM, a.out + O_Y, MOD + 5 * DM};
        pg8::gemm_phase<EpiRes, pg8::StaticOrder, true, true>((PG8_LAS unsigned char*)lds, g, S, E);
    }
}

#ifndef MK_MULTI
#define MK_MULTI 0
#endif
extern "C" void kernel_launch(void* const* d_in, const int* in_sizes, int n_in, void* d_out, int out_size, void* d_ws, size_t ws_size, hipStream_t stream) {
    static int grid = 0;
    if (grid == 0) {
        if (n_in != 24 || (size_t)out_size != O_TOTAL || ws_size < WS_END) { fprintf(stderr, "kernel_launch: unexpected shapes: n_in %d out %d ws %zu\n", n_in, out_size, ws_size); grid = -1; return; }
        int dev = 0, cus = 0, per_cu = 0;
        hipGetDevice(&dev); hipDeviceGetAttribute(&cus, hipDeviceAttributeMultiprocessorCount, dev);
        if (hipFuncSetAttribute((const void*)mega_fwd, hipFuncAttributeMaxDynamicSharedMemorySize, LDS_BYTES) != hipSuccess) { fprintf(stderr, "kernel_launch: hipFuncSetAttribute failed\n"); grid = -1; return; }
        hipOccupancyMaxActiveBlocksPerMultiprocessor(&per_cu, (const void*)mega_fwd, 512, LDS_BYTES);
        if (per_cu < 1) per_cu = 1;
        (void)hipGetLastError();
        grid = cus * 1;
        if (grid <= 0) grid = 256;
    }
    if (grid < 0) return;
    hipMemsetAsync((char*)d_ws + WS_CTL, 0, 32768, stream);
    Args a{};
    for (int i = 0; i < 24; ++i) a.in[i] = (const float*)d_in[i];
    a.out = (float*)d_out; a.ws = (unsigned char*)d_ws;
#if MK_MULTI
    for (int ph = 0; ph < NPHASE; ++ph) { a.ph_lo = ph; a.ph_hi = ph; hipLaunchKernelGGL(mega_fwd, dim3(grid), dim3(512), LDS_BYTES, stream, a); }
#else
    a.ph_lo = 0; a.ph_hi = NPHASE - 1;
    void* args[] = {&a};
    hipError_t e = hipLaunchCooperativeKernel((const void*)mega_fwd, dim3(grid), dim3(512), args, LDS_BYTES, stream);
    if (e != hipSuccess) fprintf(stderr, "cooperative launch failed: %s (grid %d)\n", hipGetErrorString(e), grid);
#endif
}
```

```cpp
#include <hip/hip_runtime.h>
#include <hip/hip_cooperative_groups.h>
#include <cstdio>
#include <cstdint>
namespace cg = cooperative_groups;
namespace pg8 {
#define PG8_LAS __attribute__((address_space(3)))
typedef unsigned short bf16_t;
typedef short bf16x8 __attribute__((ext_vector_type(8)));
typedef float f32x4 __attribute__((ext_vector_type(4)));
typedef unsigned u32x4 __attribute__((ext_vector_type(4)));
constexpr int BM = 256, BK = 64, HALF = 128, HTB = HALF * BK * 2  , STAGE_BYTES = 8 * HTB, NXCD = 8, WGM = 8;

__host__ __device__ __forceinline__ int lds_byte(int r, int c) { const int st = (r >> 4) * 2 + (c >> 5), rr = r & 15, cc = c & 31, ob = rr * 64 + cc * 2; return st * 1024 + (ob ^ (((ob >> 9) & 1) << 5)); }
__host__ __device__ __forceinline__ void stage_rc(int b, int& R, int& C) { const int st = b / 1024, sb = b % 1024, swz = sb ^ (((sb >> 9) & 1) << 5); R = (st >> 1) * 16 + swz / 64; C = (st & 1) * 32 + (swz % 64) / 2; }
__host__ __device__ __forceinline__ int perm32(int rho) { const int n = rho >> 4, i = rho & 15; return 8 * (i >> 2) + 4 * n + (i & 3); }

struct Unit { int pm, pn; };
struct Gemm { const bf16_t* A; const bf16_t* Bt; int M, N, K, lda; };

struct StaticOrder {
    int nM, nN, nwg, G, c;
    __host__ __device__ void init(int M, int N, int G_, int c_) { nM = M / BM; nN = N / BM; nwg = nM * nN; G = G_; c = c_; }
    __host__ __device__ bool next(int i, Unit& u) const {
        const long L = (long)i * G + c; if (L >= nwg) return false;
        int wgid = (int)L; { const int q = nwg / NXCD, r = nwg % NXCD, xcd = wgid % NXCD, off = wgid / NXCD; wgid = (xcd < r ? xcd * (q + 1) : r * (q + 1) + (xcd - r) * q) + off; }
        const int nig = WGM * nN, gid = wgid / nig, fm = gid * WGM, gsz = (nM - fm) < WGM ? (nM - fm) : WGM;
        u.pm = fm + ((wgid % nig) % gsz); u.pn = (wgid % nig) / gsz; return true;
    }
    __device__ __forceinline__ void a_ready(const Unit&) const {}
    __device__ __forceinline__ void done(const Unit&) const {}
};

__device__ __forceinline__ unsigned cvt_pk_bf16(float lo, float hi) { unsigned r; asm volatile("v_cvt_pk_bf16_f32 %0, %1, %2" : "=v"(r) : "v"(lo), "v"(hi)); return r; }
template <class Epi, class Sched, bool ALIGN_EPI = false, bool SP2 = false>
__device__ __forceinline__ void gemm_phase(PG8_LAS unsigned char* lds, const Gemm g, const Sched& S, const Epi& E) {
    const int tid = threadIdx.x, wid = __builtin_amdgcn_readfirstlane(tid >> 6), lane = tid & 63, wr = wid >> 2, wc = wid & 3, fr = lane & 15, fq = lane >> 4;
    const int K = g.K, nt = K / BK;
    unsigned voffA[2], voffB[2];
#pragma unroll
    for (int i = 0; i < 2; ++i) { int R, C; stage_rc(tid * 16 + i * 8192, R, C); const int Rb = Epi::PERM ? ((R & ~31) + perm32(R & 31)) : R;
        voffA[i] = (unsigned)(R * g.lda + C) * 2u; voffB[i] = (unsigned)(Rb * K + C) * 2u; }
    const size_t kstep = (size_t)(BK * 2);
    const size_t hstepA = (size_t)HALF * g.lda * 2, hstepB = (size_t)HALF * K * 2;
    const size_t tstepA = 2 * hstepA, tstepB = 2 * hstepB;
    const unsigned ldsw = (unsigned)wid * 1024u;
    const int aoff = lds_byte(wr * 64 + fr, fq * 8), boff = lds_byte(wc * 32 + fr, fq * 8);
#define PG8_SA(b, h) (((b) * 2 + (h)) * HTB)
#define PG8_SB(b, h) ((4 + (b) * 2 + (h)) * HTB)
#define PG8_STAGE(bufoff, gbase, voff) do { _Pragma("unroll") for (int _i = 0; _i < 2; ++_i) \
        __builtin_amdgcn_global_load_lds((const unsigned*)((const char*)(gbase) + (voff)[_i]), (PG8_LAS unsigned*)(lds + (bufoff) + ldsw + _i * 8192), 16, 0, 0); } while (0)
#define PG8_LDA(dst, b, h) do { _Pragma("unroll") for (int m = 0; m < 4; ++m) _Pragma("unroll") for (int k = 0; k < 2; ++k) dst[m][k] = *(const PG8_LAS bf16x8*)(lds + PG8_SA(b, h) + aoff + m * 2048 + k * 1024); } while (0)
#define PG8_LDB(dst, b, h) do { _Pragma("unroll") for (int n = 0; n < 2; ++n) _Pragma("unroll") for (int k = 0; k < 2; ++k) dst[n][k] = *(const PG8_LAS bf16x8*)(lds + PG8_SB(b, h) + boff + n * 2048 + k * 1024); } while (0)
#define PG8_MMA(ai, bj, At, Bt) do { __builtin_amdgcn_s_setprio(1); _Pragma("unroll") for (int m = 0; m < 4; ++m) _Pragma("unroll") for (int n = 0; n < 2; ++n) _Pragma("unroll") for (int k = 0; k < 2; ++k) \
        acc[ai][bj][m][n] = __builtin_amdgcn_mfma_f32_16x16x32_bf16(Bt[n][k], At[m][k], acc[ai][bj][m][n], 0, 0, 0); __builtin_amdgcn_s_setprio(0); } while (0)
#define PG8_WAIT_V(n) asm volatile("s_waitcnt vmcnt(" #n ")" ::: "memory")
#define PG8_WAIT_L(n) asm volatile("s_waitcnt lgkmcnt(" #n ")" ::: "memory")
#define PG8_BAR __builtin_amdgcn_s_barrier()
#define PG8_SCHED __builtin_amdgcn_sched_barrier(0)
    Unit cur, nxt; int ui = 0;
    if (!S.next(0, cur)) return;
    f32x4 acc[2][2][4][2];
#pragma unroll
    for (int a = 0; a < 2; ++a)
#pragma unroll
        for (int b = 0; b < 2; ++b)
#pragma unroll
            for (int m = 0; m < 4; ++m)
#pragma unroll
                for (int n = 0; n < 2; ++n) acc[a][b][m][n] = (f32x4){0.f, 0.f, 0.f, 0.f};
    bf16x8 At[4][2], B0[2][2], B1[2][2];
    const char* cA = (const char*)g.A + (size_t)cur.pm * tstepA; const char* cB = (const char*)g.Bt + (size_t)cur.pn * tstepB;
    S.a_ready(cur);
    if constexpr (SP2) {
        PG8_STAGE(PG8_SB(0, 0), cB, voffB); PG8_STAGE(PG8_SB(0, 1), cB + hstepB, voffB); PG8_STAGE(PG8_SA(0, 0), cA, voffA); PG8_STAGE(PG8_SA(0, 1), cA + hstepA, voffA);
        if (wr == 1) PG8_BAR;
        PG8_WAIT_V(2); PG8_BAR;
        PG8_STAGE(PG8_SB(1, 0), cB + kstep, voffB); PG8_STAGE(PG8_SA(1, 0), cA + kstep, voffA); PG8_STAGE(PG8_SB(1, 1), cB + hstepB + kstep, voffB);
        PG8_WAIT_V(6); PG8_BAR;
    } else {
        PG8_STAGE(PG8_SB(0, 0), cB, voffB); PG8_STAGE(PG8_SA(0, 0), cA, voffA); PG8_STAGE(PG8_SB(0, 1), cB + hstepB, voffB); PG8_STAGE(PG8_SA(0, 1), cA + hstepA, voffA);
        if (wr == 1) PG8_BAR;
        PG8_WAIT_V(4); PG8_BAR;
        PG8_STAGE(PG8_SB(1, 0), cB + kstep, voffB); PG8_STAGE(PG8_SA(1, 0), cA + kstep, voffA); PG8_STAGE(PG8_SB(1, 1), cB + hstepB + kstep, voffB);
        PG8_WAIT_V(6); PG8_BAR;
    }
    for (;;) {
        const bool has_next = S.next(ui + 1, nxt);
        const char* nA = has_next ? (const char*)g.A + (size_t)nxt.pm * tstepA : cA; const char* nB = has_next ? (const char*)g.Bt + (size_t)nxt.pn * tstepB : cB;
        for (int t = 0; t < nt; t += 2) {
            const bool last = (t == nt - 2);
            const char* a1 = cA + (size_t)(t + 1) * kstep;
            const char* a2 = last ? nA : cA + (size_t)(t + 2) * kstep; const char* b2 = last ? nB : cB + (size_t)(t + 2) * kstep;
            const char* a3 = a2 + kstep; const char* b3 = b2 + kstep;
            if (last && has_next) S.a_ready(nxt);
            if constexpr (SP2) {
            PG8_LDB(B0, 0, 0); PG8_LDB(B1, 0, 1); PG8_SCHED; PG8_LDA(At, 0, 0); PG8_STAGE(PG8_SA(1, 1), a1 + hstepA, voffA);
            PG8_WAIT_V(8); PG8_WAIT_L(0); PG8_BAR; PG8_MMA(0, 0, At, B0); PG8_MMA(0, 1, At, B1); PG8_BAR; PG8_SCHED;
            PG8_LDA(At, 0, 1); PG8_STAGE(PG8_SB(0, 0), b2, voffB); PG8_STAGE(PG8_SB(0, 1), b2 + hstepB, voffB); PG8_STAGE(PG8_SA(0, 0), a2, voffA);
            PG8_WAIT_V(8); PG8_WAIT_L(0); PG8_BAR; PG8_MMA(1, 0, At, B0); PG8_MMA(1, 1, At, B1); PG8_BAR; PG8_SCHED;
            PG8_LDB(B0, 1, 0); PG8_LDB(B1, 1, 1); PG8_SCHED; PG8_LDA(At, 1, 0); PG8_STAGE(PG8_SA(0, 1), a2 + hstepA, voffA);
            PG8_WAIT_V(8); PG8_WAIT_L(0); PG8_BAR; PG8_MMA(0, 0, At, B0); PG8_MMA(0, 1, At, B1); PG8_BAR; PG8_SCHED;
            PG8_LDA(At, 1, 1); PG8_STAGE(PG8_SB(1, 0), b3, voffB); PG8_STAGE(PG8_SB(1, 1), b3 + hstepB, voffB); PG8_STAGE(PG8_SA(1, 0), a3, voffA);
            PG8_WAIT_V(8); PG8_WAIT_L(0); PG8_BAR; PG8_MMA(1, 0, At, B0); PG8_MMA(1, 1, At, B1); PG8_BAR; PG8_SCHED;
            } else {
            PG8_LDB(B0, 0, 0); PG8_SCHED; PG8_LDA(At, 0, 0); PG8_STAGE(PG8_SA(1, 1), a1 + hstepA, voffA);
            PG8_WAIT_L(8); PG8_BAR; PG8_WAIT_L(0); PG8_MMA(0, 0, At, B0); PG8_BAR; PG8_SCHED;
            PG8_LDB(B1, 0, 1); PG8_STAGE(PG8_SB(0, 0), b2, voffB);
            PG8_BAR; PG8_WAIT_L(0); PG8_MMA(0, 1, At, B1); PG8_BAR;
            PG8_LDA(At, 0, 1); PG8_STAGE(PG8_SA(0, 0), a2, voffA);
            PG8_BAR; PG8_WAIT_L(0); PG8_MMA(1, 0, At, B0); PG8_BAR; PG8_SCHED;
            PG8_STAGE(PG8_SB(0, 1), b2 + hstepB, voffB);
            PG8_WAIT_V(6); PG8_BAR; PG8_MMA(1, 1, At, B1); PG8_BAR;
            PG8_LDB(B0, 1, 0); PG8_SCHED; PG8_LDA(At, 1, 0); PG8_STAGE(PG8_SA(0, 1), a2 + hstepA, voffA);
            PG8_WAIT_L(8); PG8_BAR; PG8_WAIT_L(0); PG8_MMA(0, 0, At, B0); PG8_BAR; PG8_SCHED;
            PG8_LDB(B1, 1, 1); PG8_STAGE(PG8_SB(1, 0), b3, voffB);
            PG8_BAR; PG8_WAIT_L(0); PG8_MMA(0, 1, At, B1); PG8_BAR;
            PG8_LDA(At, 1, 1); PG8_STAGE(PG8_SA(1, 0), a3, voffA);
            PG8_BAR; PG8_WAIT_L(0); PG8_MMA(1, 0, At, B0); PG8_BAR; PG8_SCHED;
            PG8_STAGE(PG8_SB(1, 1), b3 + hstepB, voffB);
            PG8_WAIT_V(6); PG8_BAR; PG8_MMA(1, 1, At, B1); PG8_BAR;
            }
        }
        if constexpr (ALIGN_EPI) { if (wr == 0) PG8_BAR; }
        if constexpr (!Epi::AFTER_DRAIN) { E(acc, cur, wr, wc, fr, fq); S.done(cur); }
        if (!has_next) break;
#pragma unroll
        for (int a = 0; a < 2; ++a)
#pragma unroll
            for (int b = 0; b < 2; ++b)
#pragma unroll
                for (int m = 0; m < 4; ++m)
#pragma unroll
                    for (int n = 0; n < 2; ++n) acc[a][b][m][n] = (f32x4){0.f, 0.f, 0.f, 0.f};
        cur = nxt; cA = nA; cB = nB; ++ui;
        if constexpr (ALIGN_EPI) { if (wr == 1) PG8_BAR; }
    }
    PG8_WAIT_V(0);
    if constexpr (!ALIGN_EPI) { if (wr == 0) PG8_BAR; }
    PG8_BAR;
    if constexpr (Epi::AFTER_DRAIN) { E.fused(acc, cur, wr, wc, fr, fq, lds, wid, lane); S.done(cur); }
#undef PG8_SA
#undef PG8_SB
#undef PG8_STAGE
#undef PG8_LDA
#undef PG8_LDB
#undef PG8_MMA
#undef PG8_WAIT_V
#undef PG8_WAIT_L
#undef PG8_BAR
#undef PG8_SCHED
}
}
using pg8::bf16_t; using pg8::bf16x8; using pg8::f32x4; using pg8::u32x4;
typedef float f32x16 __attribute__((ext_vector_type(16)));
typedef unsigned long long u64;

constexpr int DM = 2048, TP = 16384, TS = 512, TT = TP + TS, NBATCH = 9, MODW = 6 * DM;
constexpr int NP = 7424;
constexpr int C_AQ = 0, C_IQ = 1024, C_AK = 2048, C_AV = 3072, C_GQ = 4096, C_GK = 4608, C_GV = 5120, C_GR = 6144, C_IK = 7168, C_IW = 7232, C_GLR = 7248, C_END = 7264;
constexpr int DFF = 5632, NUP = 11264, WIN_N = 7264;
constexpr int NCH = 264;
constexpr float EPS = 1e-6f;
constexpr size_t O_Y = 0, O_KP = 34603008, O_VP = 51380224, O_IKP = 68157440, O_GSP = 69206016, O_FCP = 69337088,
                 O_KS = 69359616, O_VS = 69883904, O_IKS = 70408192, O_GSS = 70440960, O_FCS = 71489536, O_TOTAL = 71669760;
constexpr size_t MiB = 1u << 20;
constexpr size_t WS_CTL = 0, WS_MOD = 1 * MiB, WS_D = 2 * MiB, WS_WIN = 4 * MiB, WS_WOUT = 33 * MiB, WS_WUP = 41 * MiB, WS_WDN = 85 * MiB,
                 WS_ACT = 107 * MiB, WS_P = 173 * MiB, WS_CK = 413 * MiB, WS_CV = 429 * MiB, WS_CIK = 445 * MiB, WS_KV8 = 446 * MiB, WS_CKV8 = 479 * MiB, WS_END = 495 * MiB;
constexpr size_t WS_BC = WS_WUP;
constexpr size_t WS_IKC = WS_CK;
constexpr size_t WS_UF = WS_CK, WS_UH = WS_CK + 12 * MiB;
constexpr int LDS_BYTES = 149568;
constexpr int NPHASE = 11;
constexpr int IDX_ITEMS = 5184;

struct Args { const float* in[24]; float* out; unsigned char* ws; int ph_lo, ph_hi; };

__device__ __forceinline__ unsigned f2bf(float f) { unsigned u = __builtin_bit_cast(unsigned, f); return (u + 0x7fffu + ((u >> 16) & 1u)) >> 16; }
typedef float f32x2v __attribute__((ext_vector_type(2))); typedef __bf16 bf16x2v __attribute__((ext_vector_type(2)));
__device__ __forceinline__ unsigned pk2(float lo, float hi) { const f32x2v v = {lo, hi}; const bf16x2v b = __builtin_convertvector(v, bf16x2v); return __builtin_bit_cast(unsigned, b); }
__device__ __forceinline__ float bflo(unsigned w) { return __builtin_bit_cast(float, w << 16); }
__device__ __forceinline__ float bfhi(unsigned w) { return __builtin_bit_cast(float, w & 0xffff0000u); }
__device__ __forceinline__ float bf1(bf16_t h) { return __builtin_bit_cast(float, ((unsigned)h) << 16); }
__device__ __forceinline__ void unpack8(u32x4 w, float* v) { v[0] = bflo(w.x); v[1] = bfhi(w.x); v[2] = bflo(w.y); v[3] = bfhi(w.y); v[4] = bflo(w.z); v[5] = bfhi(w.z); v[6] = bflo(w.w); v[7] = bfhi(w.w); }
__device__ __forceinline__ u32x4 pack8(const float* v) { u32x4 w; w.x = pk2(v[0], v[1]); w.y = pk2(v[2], v[3]); w.z = pk2(v[4], v[5]); w.w = pk2(v[6], v[7]); return w; }
__device__ __forceinline__ float wave_sum(float v) {
#pragma unroll
    for (int o = 1; o < 64; o <<= 1) v += __shfl_xor(v, o);
    return v;
}
__device__ __forceinline__ float siluf(float x) { return x * __builtin_amdgcn_rcpf(1.f + __expf(-x)); }
typedef float f32x2 __attribute__((ext_vector_type(2)));
__device__ __forceinline__ unsigned pk4_fp8(float a, float b, float c, float d) { int w = 0; w = __builtin_amdgcn_cvt_pk_fp8_f32(a, b, w, false); w = __builtin_amdgcn_cvt_pk_fp8_f32(c, d, w, true); return (unsigned)w; }
__device__ __forceinline__ u32x4 pack16_fp8(const float* v) { u32x4 w; w.x = pk4_fp8(v[0], v[1], v[2], v[3]); w.y = pk4_fp8(v[4], v[5], v[6], v[7]); w.z = pk4_fp8(v[8], v[9], v[10], v[11]); w.w = pk4_fp8(v[12], v[13], v[14], v[15]); return w; }
__device__ __forceinline__ void unpack16_fp8(u32x4 w, float* v) {
#pragma unroll
    for (int i = 0; i < 4; ++i) { const f32x2 lo = __builtin_amdgcn_cvt_pk_f32_fp8((int)w[i], false), hi = __builtin_amdgcn_cvt_pk_f32_fp8((int)w[i], true); v[4 * i] = lo.x; v[4 * i + 1] = lo.y; v[4 * i + 2] = hi.x; v[4 * i + 3] = hi.y; }
}

template <int MAPID> __device__ __forceinline__ int colmap(int n) {
    if (MAPID == 0) return n;
    if (MAPID == 1) {
        if (n < 1024) return n;
        if (n < 2048) return 3072 + (n - 1024);
        if (n < 3072) return 1024 + (n - 2048);
        if (n < 4096) return 2048 + (n - 3072);
        if (n < 4608) return 4176 + (n - 4096);
        if (n < 5120) return 4688 + (n - 4608);
        if (n < 6144) return 5200 + (n - 5120);
        if (n < 7168) return 6224 + (n - 6144);
        if (n < 7232) return 4096 + (n - 7168);
        if (n < 7248) return 4160 + (n - 7232);
        if (n < 7264) return n;
        return -1;
    }
    { const int pn = n >> 8, w = n & 255; return w < 128 ? pn * 128 + w : DFF + pn * 128 + (w - 128); }
}
template <int MAPID> __device__ __forceinline__ void transpose_item(const float* __restrict__ W, int K, int Nsrc, bf16_t* __restrict__ WT, int nblk, float* scr, int item, int lane) {
    const int kb = item / nblk, nb = item % nblk, k0 = 64 * kb, n0 = 32 * nb;
    const int srcc = colmap<MAPID>(n0 + (lane & 31));
#pragma unroll 8
    for (int i = 0; i < 32; ++i) { const int kk = 2 * i + (lane >> 5); scr[kk * 33 + (lane & 31)] = srcc >= 0 ? W[(size_t)(k0 + kk) * Nsrc + srcc] : 0.f; }
    asm volatile("s_waitcnt lgkmcnt(0)" ::: "memory");
    const int c = lane & 7;
#pragma unroll
    for (int j = 0; j < 4; ++j) { const int n = (lane >> 3) + 8 * j; const float* s = scr + (8 * c) * 33 + n;
        u32x4 o; o.x = pk2(s[0 * 33], s[1 * 33]); o.y = pk2(s[2 * 33], s[3 * 33]); o.z = pk2(s[4 * 33], s[5 * 33]); o.w = pk2(s[6 * 33], s[7 * 33]);
        *(u32x4*)(WT + (size_t)(n0 + n) * K + k0 + 8 * c) = o; }
    asm volatile("s_waitcnt lgkmcnt(0)" ::: "memory");
}

__device__ __forceinline__ void phase0(const Args& a, unsigned char* lds, int tid, int lane, int wave) {
    unsigned char* ws = a.ws;
    if ((int)blockIdx.x < 192 || gridDim.x < 192) {
        float* sc = (float*)lds;
        float* red = (float*)(lds + 73728);
        for (int i = tid; i < NBATCH * DM; i += 512) { const int b = i >> 11, k = i & 2047; const float c = b == 0 ? a.in[2][k] : a.in[3][(b - 1) * DM + k]; sc[i] = c / (1.f + __expf(-c)); }
        __syncthreads();
        for (int item = blockIdx.x; item < 192; item += gridDim.x) {
            const int col = item * 64 + lane, k0 = wave * 256;
            float acc[NBATCH];
#pragma unroll
            for (int b = 0; b < NBATCH; ++b) acc[b] = 0.f;
            const float* wp = a.in[9] + (size_t)k0 * MODW + col;
            for (int k = 0; k < 256; k += 32) {
                float wv[32];
#pragma unroll
                for (int i = 0; i < 32; ++i) wv[i] = wp[(size_t)(k + i) * MODW];
#pragma unroll
                for (int i = 0; i < 32; ++i)
#pragma unroll
                    for (int b = 0; b < NBATCH; ++b) acc[b] += sc[b * DM + k0 + k + i] * wv[i]; }
#pragma unroll
            for (int b = 0; b < NBATCH; ++b) red[(wave * NBATCH + b) * 64 + lane] = acc[b];
            __syncthreads();
            for (int i = tid; i < NBATCH * 64; i += 512) { const int b = i >> 6, l = i & 63; float s = a.in[10][item * 64 + l];
#pragma unroll
                for (int w = 0; w < 8; ++w) s += red[(w * NBATCH + b) * 64 + l];
                ((float*)(ws + WS_MOD))[b * MODW + item * 64 + l] = s; }
            __syncthreads();
        }
    }
    __syncthreads();
    {
        float* scr = (float*)(lds + wave * 8448);
        const int gw = blockIdx.x * 8 + wave, NGW = gridDim.x * 8;
        constexpr int I_IN = 32 * (NP / 32);
        for (int it = gw; it < I_IN; it += NGW) transpose_item<1>(a.in[13], DM, WIN_N, (bf16_t*)(ws + WS_WIN), NP / 32, scr, it, lane);
    }
    {
        const size_t gt = (size_t)blockIdx.x * 512 + tid, GT = (size_t)gridDim.x * 512;
        for (size_t i = gt; i < 8388608 / 16; i += GT) {
            const size_t row = i >> 6, chk = i & 63; float v[16];
            const f32x4* s = (const f32x4*)(a.in[4] + row * 1024 + chk * 16);
#pragma unroll
            for (int j = 0; j < 4; ++j) { const f32x4 x = s[j]; v[4 * j] = x.x; v[4 * j + 1] = x.y; v[4 * j + 2] = x.z; v[4 * j + 3] = x.w; }
            *(u32x4*)(ws + WS_CKV8 + row * 2048 + chk * 16) = pack16_fp8(v);
            s = (const f32x4*)(a.in[5] + row * 1024 + chk * 16);
#pragma unroll
            for (int j = 0; j < 4; ++j) { const f32x4 x = s[j]; v[4 * j] = x.x; v[4 * j + 1] = x.y; v[4 * j + 2] = x.z; v[4 * j + 3] = x.w; }
            *(u32x4*)(ws + WS_CKV8 + row * 2048 + 1024 + chk * 16) = pack16_fp8(v); }
        for (size_t i = gt; i < 524288 / 8; i += GT) {
            const f32x4* s = (const f32x4*)a.in[6] + 2 * i; f32x4 x = s[0], y = s[1]; u32x4 o; o.x = pk2(x.x, x.y); o.y = pk2(x.z, x.w); o.z = pk2(y.x, y.y); o.w = pk2(y.z, y.w); ((u32x4*)(ws + WS_CIK))[i] = o; }
    }
}

__device__ __forceinline__ bool gemm_tail_rank(int nwg, int& rank, int& count) {
    const int G = gridDim.x, c = blockIdx.x, rounds = (nwg + G - 1) / G, nbusy = nwg - (rounds - 1) * G;
    rank = c - nbusy; count = G - nbusy; return c >= nbusy;
}
__device__ __forceinline__ void tail_wout(const Args& a, unsigned char* lds, int rank, int count, int lane, int wave) {
    float* scr = (float*)(lds + wave * 8448);
    for (int it = rank * 8 + wave; it < 32 * 64; it += count * 8) transpose_item<0>(a.in[19], DM, DM, (bf16_t*)(a.ws + WS_WOUT), 64, scr, it, lane);
}
__device__ __forceinline__ void tail_wup_wdn(const Args& a, unsigned char* lds, int rank, int count, int lane, int wave) {
    float* scr = (float*)(lds + wave * 8448);
    constexpr int I_UP = 32 * (NUP / 32), I_DN = (DFF / 64) * 64;
    for (int it = rank * 8 + wave; it < I_UP + I_DN; it += count * 8) {
        if (it < I_UP) transpose_item<2>(a.in[20], DM, NUP, (bf16_t*)(a.ws + WS_WUP), NUP / 32, scr, it, lane);
        else transpose_item<0>(a.in[23], DFF, DM, (bf16_t*)(a.ws + WS_WDN), 64, scr, it - I_UP, lane);
    }
}

__device__ __forceinline__ void normmod_phase(const float* xp, const float* xs, const float* g, const float* mod, int sh_off, int sc_off, bf16_t* dst, int lane, int wave) {
    const int gw = blockIdx.x * 8 + wave, NGW = gridDim.x * 8;
    for (int r = gw; r < TT; r += NGW) {
        const float* xrow = r < TP ? xp + (size_t)r * DM : xs + (size_t)(r - TP) * DM;
        const int b = r < TP ? 0 : 1 + ((r - TP) >> 6);
        const f32x4* xr = (const f32x4*)xrow + lane;
        f32x4 v[8]; float s = 0.f;
#pragma unroll
        for (int j = 0; j < 8; ++j) { v[j] = __builtin_nontemporal_load(xr + 64 * j); s += (v[j].x * v[j].x + v[j].y * v[j].y) + (v[j].z * v[j].z + v[j].w * v[j].w); }
        const float rstd = rsqrtf(wave_sum(s) * (1.f / DM) + EPS);
        const f32x4* gp = (const f32x4*)g + lane; const f32x4* scp = (const f32x4*)(mod + (size_t)b * MODW + sc_off) + lane; const f32x4* shp = (const f32x4*)(mod + (size_t)b * MODW + sh_off) + lane;
        u64* o8 = (u64*)(dst + (size_t)r * DM) + lane;
#pragma unroll
        for (int j = 0; j < 8; ++j) { const f32x4 gg = gp[64 * j], sc = scp[64 * j], sh = shp[64 * j];
            const f32x4 y = v[j] * rstd * gg * (sc + 1.f) + sh;
            o8[64 * j] = (u64)pk2(y.x, y.y) | ((u64)pk2(y.z, y.w) << 32); }
    }
}

struct EpiP {
    static constexpr bool PERM = true, AFTER_DRAIN = false;
    bf16_t* O; int ldc;
    __device__ __forceinline__ void operator()(const f32x4 (&acc)[2][2][4][2], const pg8::Unit& u, int wr, int wc, int fr, int fq) const {
        const int row0 = u.pm * 256 + wr * 64 + fr, col0 = u.pn * 256 + wc * 32 + 8 * fq;
#pragma unroll
        for (int ai = 0; ai < 2; ++ai)
#pragma unroll
            for (int m = 0; m < 4; ++m) { bf16_t* rowp = O + (size_t)(row0 + ai * 128 + m * 16) * ldc + col0;
#pragma unroll
                for (int bj = 0; bj < 2; ++bj) { const f32x4 v0 = acc[ai][bj][m][0], v1 = acc[ai][bj][m][1]; u32x4 w;
                    w.x = pg8::cvt_pk_bf16(v0[0], v0[1]); w.y = pg8::cvt_pk_bf16(v0[2], v0[3]); w.z = pg8::cvt_pk_bf16(v1[0], v1[1]); w.w = pg8::cvt_pk_bf16(v1[2], v1[3]);
                    *(u32x4*)(rowp + bj * 128) = w; } }
    }
};
struct EpiRes {
    static constexpr bool PERM = true, AFTER_DRAIN = false;
    const float* srcP; const float* srcS; float* dst; const float* gate;
    __device__ __forceinline__ void operator()(const f32x4 (&acc)[2][2][4][2], const pg8::Unit& u, int wr, int wc, int fr, int fq) const {
        const int col0 = u.pn * 256 + wc * 32 + 8 * fq;
#pragma unroll
        for (int ai = 0; ai < 2; ++ai)
#pragma unroll
            for (int m = 0; m < 4; ++m) {
                const int row = u.pm * 256 + ai * 128 + wr * 64 + m * 16 + fr;
                const int b = row < TP ? 0 : 1 + ((row - TP) >> 6);
                const float* sp = (row < TP ? srcP + (size_t)row * DM : srcS + (size_t)(row - TP) * DM) + col0;
                const float* gp = gate + (size_t)b * MODW + col0; float* dp = dst + (size_t)row * DM + col0;
#pragma unroll
                for (int bj = 0; bj < 2; ++bj)
#pragma unroll
                    for (int n = 0; n < 2; ++n) { const f32x4 x = *(const f32x4*)(sp + bj * 128 + 4 * n), gg = *(const f32x4*)(gp + bj * 128 + 4 * n);
                        *(f32x4*)(dp + bj * 128 + 4 * n) = x + gg * acc[ai][bj][m][n]; }
            }
    }
};
template <int CTRL> __device__ __forceinline__ float dpp_ror(float v) {
    return __builtin_bit_cast(float, __builtin_amdgcn_update_dpp(0, __builtin_bit_cast(int, v), CTRL, 0xf, 0xf, false));
}
struct EpiUp {
    static constexpr bool PERM = true, AFTER_DRAIN = false;
    bf16_t* ACTF; bf16_t* Uf; bf16_t* Uh; const float* wconv; const float* bconv;
    __device__ __forceinline__ void operator()(const f32x4 (&acc)[2][2][4][2], const pg8::Unit& u, int wr, int wc, int fr, int fq) const {
        const int lane = fr + 16 * fq;
        const int ch0 = u.pn * 128 + wc * 32 + 8 * fq;
        const int src1 = (lane & 48) | ((fr + 15) & 15), src2 = (lane & 48) | ((fr + 14) & 15);
        unsigned outp[2][4][4];
#pragma unroll
        for (int cp = 0; cp < 4; ++cp) {
            const int chp = ch0 + 2 * cp;
            const f32x2 wa0 = *(const f32x2*)(wconv + chp), wa1 = *(const f32x2*)(wconv + NUP + chp), wa2 = *(const f32x2*)(wconv + 2 * NUP + chp), ba = *(const f32x2*)(bconv + chp);
            const f32x2 wb0 = *(const f32x2*)(wconv + DFF + chp), wb1 = *(const f32x2*)(wconv + NUP + DFF + chp), wb2 = *(const f32x2*)(wconv + 2 * NUP + DFF + chp), bb = *(const f32x2*)(bconv + DFF + chp);
#pragma unroll
            for (int ai = 0; ai < 2; ++ai) {
                float rr[4][2];
#pragma unroll
                for (int ii = 0; ii < 2; ++ii) {
                    const int c8 = 2 * cp + ii, n = c8 >> 2, i = c8 & 3;
                    float ua[4], ub[4], r1a[4], r2a[4], r1b[4], r2b[4];
#pragma unroll
                    for (int m = 0; m < 4; ++m) { ua[m] = acc[ai][0][m][n][i]; ub[m] = acc[ai][1][m][n][i];
                        r1a[m] = dpp_ror<0x121>(ua[m]); r2a[m] = dpp_ror<0x122>(ua[m]); r1b[m] = dpp_ror<0x121>(ub[m]); r2b[m] = dpp_ror<0x122>(ub[m]); }
#pragma unroll
                    for (int m = 0; m < 4; ++m) {
                        const float p1a = fr >= 1 ? r1a[m] : r1a[(m + 3) & 3], p2a = fr >= 2 ? r2a[m] : r2a[(m + 3) & 3];
                        const float p1b = fr >= 1 ? r1b[m] : r1b[(m + 3) & 3], p2b = fr >= 2 ? r2b[m] : r2b[(m + 3) & 3];
                        const float ca = ba[ii] + wa2[ii] * ua[m] + wa1[ii] * p1a + wa0[ii] * p2a;
                        const float cb = bb[ii] + wb2[ii] * ub[m] + wb1[ii] * p1b + wb0[ii] * p2b;
                        rr[m][ii] = siluf(ca) * cb;
                    }
                }
#pragma unroll
                for (int m = 0; m < 4; ++m) outp[ai][m][cp] = pg8::cvt_pk_bf16(rr[m][0], rr[m][1]);
            }
        }
#pragma unroll
        for (int ai = 0; ai < 2; ++ai) {
            const int g = u.pm * 4 + ai * 2 + wr;
#pragma unroll
            for (int m = 0; m < 4; ++m) { const int row = g * 64 + 16 * m + fr;
                u32x4 w; w.x = outp[ai][m][0]; w.y = outp[ai][m][1]; w.z = outp[ai][m][2]; w.w = outp[ai][m][3];
                *(u32x4*)(ACTF + (size_t)row * DFF + ch0) = w; }
            if (fr < 2) { bf16_t* p = Uf + (size_t)(g * 2 + fr) * NUP + ch0;
#pragma unroll
                for (int bj = 0; bj < 2; ++bj) { const f32x4 v0 = acc[ai][bj][0][0], v1 = acc[ai][bj][0][1]; u32x4 w;
                    w.x = pg8::cvt_pk_bf16(v0[0], v0[1]); w.y = pg8::cvt_pk_bf16(v0[2], v0[3]); w.z = pg8::cvt_pk_bf16(v1[0], v1[1]); w.w = pg8::cvt_pk_bf16(v1[2], v1[3]);
                    *(u32x4*)(p + bj * DFF) = w; } }
            if (fr >= 14) { bf16_t* p = Uh + (size_t)(g * 2 + fr - 14) * NUP + ch0;
#pragma unroll
                for (int bj = 0; bj < 2; ++bj) { const f32x4 v0 = acc[ai][bj][3][0], v1 = acc[ai][bj][3][1]; u32x4 w;
                    w.x = pg8::cvt_pk_bf16(v0[0], v0[1]); w.y = pg8::cvt_pk_bf16(v0[2], v0[3]); w.z = pg8::cvt_pk_bf16(v1[0], v1[1]); w.w = pg8::cvt_pk_bf16(v1[2], v1[3]);
                    *(u32x4*)(p + bj * DFF) = w; } }
        }
    }
};

__device__ __forceinline__ void post_rows(const Args& a, unsigned char* lds, int tid, int lane, int wave) {
    double* inv16 = (double*)lds; double* inv8 = inv16 + 16;
    if (tid < 16) inv16[tid] = exp(-(double)tid * (1.0 / 16.0) * 13.122363377404328);
    else if (tid < 24) inv8[tid - 16] = exp(-(double)(tid - 16) * (1.0 / 8.0) * 13.122363377404328);
    __syncthreads();
    bf16_t* P = (bf16_t*)(a.ws + WS_P);
    const float* gq = a.in[14]; const float* gk = a.in[15];
    const int sub = lane & 7;
    float gqv[16], gkv[16];
#pragma unroll
    for (int i = 0; i < 16; ++i) { gqv[i] = gq[sub * 16 + i]; gkv[i] = gk[sub * 16 + i]; }
    const int gw = blockIdx.x * 8 + wave, NGW = gridDim.x * 8;
    for (int r = gw; r < TT; r += NGW) {
        bf16_t* prow = P + (size_t)r * NP;
        const int pos = r < TP ? r : 1024 + ((r - TP) & 63);
        float* kout = r < TP ? a.out + O_KP + (size_t)r * 1024 : a.out + O_KS + (size_t)(r - TP) * 1024;
        float* vout = r < TP ? a.out + O_VP + (size_t)r * 1024 : a.out + O_VS + (size_t)(r - TP) * 1024;
        float* ikout = r < TP ? a.out + O_IKP + (size_t)r * 64 : a.out + O_IKS + (size_t)(r - TP) * 64;
        float cs[16], sn[16];
#pragma unroll
        for (int i = 0; i < 16; ++i) { double rev = (double)pos * inv16[i] * 0.15915494309189535; rev -= rint(rev); const float rf = (float)rev; cs[i] = __builtin_amdgcn_cosf(rf); sn[i] = __builtin_amdgcn_sinf(rf); }
#pragma unroll
        for (int which = 0; which < 2; ++which) {
            bf16_t* p = prow + (which ? C_AK : C_AQ) + lane * 16;
            float v[16]; unpack8(*(const u32x4*)p, v); unpack8(*(const u32x4*)(p + 8), v + 8);
            float ss = 0.f;
#pragma unroll
            for (int i = 0; i < 16; ++i) ss += v[i] * v[i];
            ss += __shfl_xor(ss, 1); ss += __shfl_xor(ss, 2); ss += __shfl_xor(ss, 4);
            const float rstd = rsqrtf(ss * (1.f / 128.f) + EPS);
#pragma unroll
            for (int i = 0; i < 16; ++i) v[i] = v[i] * rstd * (which ? gkv[i] : gqv[i]);
#pragma unroll
            for (int i = 0; i < 16; ++i) { const float pv = __shfl_xor(v[i], 1);
                if (sub == 0) v[i] = v[i] * cs[i] - pv * sn[i]; else if (sub == 1) v[i] = v[i] * cs[i] + pv * sn[i]; }
            if (which) {
#pragma unroll
                for (int i = 0; i < 4; ++i) __builtin_nontemporal_store((f32x4){v[4 * i], v[4 * i + 1], v[4 * i + 2], v[4 * i + 3]}, (f32x4*)(kout + lane * 16 + 4 * i));
                *(u32x4*)(a.ws + WS_KV8 + (size_t)r * 2048 + lane * 16) = pack16_fp8(v);
            } else {
#pragma unroll
                for (int i = 0; i < 16; ++i) v[i] *= 0.12751743074602468f;
            }
            *(u32x4*)p = pack8(v); *(u32x4*)(p + 8) = pack8(v + 8);
        }
        {
            const bf16_t* p = prow + C_AV + lane * 16; float v[16]; unpack8(*(const u32x4*)p, v); unpack8(*(const u32x4*)(p + 8), v + 8);
#pragma unroll
            for (int i = 0; i < 4; ++i) __builtin_nontemporal_store((f32x4){v[4 * i], v[4 * i + 1], v[4 * i + 2], v[4 * i + 3]}, (f32x4*)(vout + lane * 16 + 4 * i));
            *(u32x4*)(a.ws + WS_KV8 + (size_t)r * 2048 + 1024 + lane * 16) = pack16_fp8(v);
        }
        float c8[8], s8[8];
#pragma unroll
        for (int i = 0; i < 8; ++i) { double rev = (double)pos * inv8[i] * 0.15915494309189535; rev -= rint(rev); const float rf = (float)rev; c8[i] = __builtin_amdgcn_cosf(rf); s8[i] = __builtin_amdgcn_sinf(rf); }
        {
            bf16_t* p = prow + C_IQ + lane * 16; float v[16]; unpack8(*(const u32x4*)p, v); unpack8(*(const u32x4*)(p + 8), v + 8);
            if ((lane & 3) == 0) {
#pragma unroll
                for (int i = 0; i < 8; ++i) { const float x1 = v[i], x2 = v[i + 8]; v[i] = x1 * c8[i] - x2 * s8[i]; v[i + 8] = x2 * c8[i] + x1 * s8[i]; }
                *(u32x4*)p = pack8(v); *(u32x4*)(p + 8) = pack8(v + 8);
            }
        }
        if (lane < 4) {
            bf16_t* p = prow + C_IK + lane * 16; float v[16]; unpack8(*(const u32x4*)p, v); unpack8(*(const u32x4*)(p + 8), v + 8);
            if (lane == 0) {
#pragma unroll
                for (int i = 0; i < 8; ++i) { const float x1 = v[i], x2 = v[i + 8]; v[i] = x1 * c8[i] - x2 * s8[i]; v[i + 8] = x2 * c8[i] + x1 * s8[i]; }
                *(u32x4*)p = pack8(v); *(u32x4*)(p + 8) = pack8(v + 8);
            }
            { bf16_t* pc = (bf16_t*)(a.ws + WS_IKC) + (size_t)r * 64 + lane * 16; *(u32x4*)pc = pack8(v); *(u32x4*)(pc + 8) = pack8(v + 8); }
#pragma unroll
            for (int i = 0; i < 4; ++i) __builtin_nontemporal_store((f32x4){v[4 * i], v[4 * i + 1], v[4 * i + 2], v[4 * i + 3]}, (f32x4*)(ikout + lane * 16 + 4 * i));
        }
    }
    __syncthreads();
}

__device__ __forceinline__ f32x4 mfma16(bf16x8 a, bf16x8 b, f32x4 c) { return __builtin_amdgcn_mfma_f32_16x16x32_bf16(a, b, c, 0, 0, 0); }
constexpr int L_GLR = 0, L_BC = 4096, L_TOT = 36864, L_A = 38912;
__device__ __forceinline__ int tsw(int row) { return ((row >> 3) & 7) << 3; }
__device__ __forceinline__ void gla_bcum(const Args& a, unsigned char* lds, int n, int h, int tid) {
    const bf16_t* P = (const bf16_t*)(a.ws + WS_P);
    float* glr = (float*)(lds + L_GLR); float* bc = (float*)(lds + L_BC); float* tot = (float*)(lds + L_TOT);
    for (int e = tid; e < 1024; e += 512) { const int t = e >> 4, rr = e & 15; glr[e] = bf1(P[(size_t)(n * 64 + t) * NP + C_GLR + rr]); }
    __syncthreads();
    const int dk = tid & 127, tq = tid >> 7;
    float w[16];
#pragma unroll
    for (int rr = 0; rr < 16; ++rr) w[rr] = a.in[16][rr * 512 + h * 128 + dk];
    const float bias = a.in[17][h * 128 + dk];
    float run = 0.f;
#pragma unroll 4
    for (int tt = 0; tt < 16; ++tt) { const int t = tq * 16 + tt; float x = bias;
#pragma unroll
        for (int rr = 0; rr < 16; ++rr) x += glr[t * 16 + rr] * w[rr];
        const float ls = fminf(x, 0.f) - log1pf(__expf(-fabsf(x)));
        run += ls * (1.f / 16.f); bc[t * 128 + dk] = run; }
    tot[tq * 128 + dk] = run;
    __syncthreads();
    float off = 0.f;
    for (int g = 0; g < tq; ++g) off += tot[g * 128 + dk];
    if (tq > 0) { for (int tt = 0; tt < 16; ++tt) bc[(tq * 16 + tt) * 128 + dk] += off; }
    __syncthreads();
}
__device__ __forceinline__ void gla_g1(const Args& a, unsigned char* lds, int tid, int lane, int wave) {
    const bf16_t* P = (const bf16_t*)(a.ws + WS_P);
    float* Dd = (float*)(a.ws + WS_D);
    const float* bc = (const float*)(lds + L_BC);
    bf16_t* KT = (bf16_t*)(lds + L_A);
    bf16_t* VT = (bf16_t*)(lds + L_A + 18432);
    for (int it = blockIdx.x; it < NCH * 4; it += gridDim.x) {
        const int n = it >> 2, h = it & 3;
        gla_bcum(a, lds, n, h, tid);
        { f32x4* bcg = (f32x4*)(a.ws + WS_BC) + (size_t)it * 2048;
#pragma unroll
          for (int i = 0; i < 4; ++i) bcg[tid + 512 * i] = ((const f32x4*)bc)[tid + 512 * i]; }
        for (int ch = tid; ch < 1024; ch += 512) { const int s = ch >> 4, d0 = (ch & 15) * 8; float v[8]; unpack8(*(const u32x4*)(P + (size_t)(n * 64 + s) * NP + C_GK + h * 128 + d0), v);
#pragma unroll
            for (int i = 0; i < 8; ++i) KT[(d0 + i) * 72 + (s ^ tsw(d0))] = (bf16_t)f2bf(v[i] * __expf(bc[63 * 128 + d0 + i] - bc[s * 128 + d0 + i])); }
        for (int ch = tid; ch < 2048; ch += 512) { const int s = ch >> 5, d0 = (ch & 31) * 8; const u32x4 w = *(const u32x4*)(P + (size_t)(n * 64 + s) * NP + C_GV + h * 256 + d0);
            VT[(d0 + 0) * 72 + (s ^ tsw(d0))] = (bf16_t)(w.x & 0xffff); VT[(d0 + 1) * 72 + (s ^ tsw(d0))] = (bf16_t)(w.x >> 16); VT[(d0 + 2) * 72 + (s ^ tsw(d0))] = (bf16_t)(w.y & 0xffff); VT[(d0 + 3) * 72 + (s ^ tsw(d0))] = (bf16_t)(w.y >> 16);
            VT[(d0 + 4) * 72 + (s ^ tsw(d0))] = (bf16_t)(w.z & 0xffff); VT[(d0 + 5) * 72 + (s ^ tsw(d0))] = (bf16_t)(w.z >> 16); VT[(d0 + 6) * 72 + (s ^ tsw(d0))] = (bf16_t)(w.w & 0xffff); VT[(d0 + 7) * 72 + (s ^ tsw(d0))] = (bf16_t)(w.w >> 16); }
        if (tid < 128) Dd[it * 128 + tid] = __expf(bc[63 * 128 + tid]);
        __syncthreads();
        const int l15 = lane & 15, q = lane >> 4;
        bf16_t* Uo = (bf16_t*)a.out + (size_t)it * 32768;
        {   const int mt = wave;
            const int kr = mt * 16 + l15; const bf16x8 a0 = *(const bf16x8*)(KT + kr * 72 + ((q * 8) ^ tsw(kr))), a1 = *(const bf16x8*)(KT + kr * 72 + ((32 + q * 8) ^ tsw(kr)));
#pragma unroll
            for (int nt = 0; nt < 16; ++nt) {
                const int vr = nt * 16 + l15; const bf16x8 b0 = *(const bf16x8*)(VT + vr * 72 + ((q * 8) ^ tsw(vr))), b1 = *(const bf16x8*)(VT + vr * 72 + ((32 + q * 8) ^ tsw(vr)));
                f32x4 c = {0.f, 0.f, 0.f, 0.f}; c = mfma16(a0, b0, c); c = mfma16(a1, b1, c);
                *(u64*)(Uo + (nt * 16 + l15) * 128 + mt * 16 + q * 4) = (u64)pk2(c[0], c[1]) | ((u64)pk2(c[2], c[3]) << 32);
            } }
        __syncthreads();
    }
}
__device__ __forceinline__ void gla_g2(const Args& a, int tid) {
    unsigned* US2 = (unsigned*)a.out;
    const float* Dd = (const float*)(a.ws + WS_D);
    const size_t gt = (size_t)blockIdx.x * 512 + tid, GT = (size_t)gridDim.x * 512;
    for (size_t e = gt; e < 65536; e += GT) {
        const int h = (int)(e >> 14), rem2 = (int)(e & 16383), dk = (2 * rem2) & 127, dv = (2 * rem2) >> 7;
        float S0 = 0.f, S1 = 0.f;
        for (int n0 = 0; n0 < 256; n0 += 32) {
            unsigned u[32]; f32x2 d[32];
#pragma unroll
            for (int i = 0; i < 32; ++i) { const int it = (n0 + i) * 4 + h; u[i] = US2[(size_t)it * 16384 + rem2]; d[i] = *(const f32x2*)(Dd + it * 128 + dk); }
#pragma unroll
            for (int i = 0; i < 32; ++i) { const int it = (n0 + i) * 4 + h; US2[(size_t)it * 16384 + rem2] = pk2(S0, S1); S0 = d[i].x * S0 + bflo(u[i]); S1 = d[i].y * S1 + bfhi(u[i]); }
        }
        a.out[O_GSP + (size_t)h * 32768 + dk * 256 + dv] = S0; a.out[O_GSP + (size_t)h * 32768 + (dk + 1) * 256 + dv] = S1;
    }
    for (size_t e2 = gt; e2 < 8 * 65536; e2 += GT) {
        const int b = (int)(e2 >> 16), e = (int)(e2 & 65535), h = e >> 14, rem2 = e & 16383, dk = (2 * rem2) & 127, dv = (2 * rem2) >> 7;
        const int it = (256 + b) * 4 + h;
        const size_t so = ((size_t)(b * 4 + h) * 128 + dk) * 256 + dv;
        const float S0 = a.in[7][so], S1 = a.in[7][so + 256]; const unsigned u = US2[(size_t)it * 16384 + rem2];
        US2[(size_t)it * 16384 + rem2] = pk2(S0, S1);
        const f32x2 d = *(const f32x2*)(Dd + it * 128 + dk);
        a.out[O_GSS + so] = d.x * S0 + bflo(u); a.out[O_GSS + so + 256] = d.y * S1 + bfhi(u);
    }
}
__device__ __forceinline__ void gla_g3(const Args& a, unsigned char* lds, int tid, int lane, int wave) {
    bf16_t* P = (bf16_t*)(a.ws + WS_P);
    const float* bc = (const float*)(lds + L_BC);
    bf16_t* Q = (bf16_t*)(lds + L_A);
    bf16_t* Kk = (bf16_t*)(lds + L_A + 17408);
    bf16_t* VT = (bf16_t*)(lds + L_A + 34816);
    bf16_t* ATS = (bf16_t*)(lds + L_A + 71680);
    float* RS = (float*)(lds + L_A + 80896);
    bf16_t* OUTS = (bf16_t*)(lds + L_A);
    const int l15 = lane & 15, q = lane >> 4;
    for (int it = gridDim.x - 1 - blockIdx.x; it < NCH * 4; it += gridDim.x) {
        const int n = it >> 2, h = it & 3;
        { const f32x4* bcg = (const f32x4*)(a.ws + WS_BC) + (size_t)it * 2048; f32x4* bcl = (f32x4*)(lds + L_BC);
#pragma unroll
          for (int i = 0; i < 4; ++i) bcl[tid + 512 * i] = bcg[tid + 512 * i]; }
        __syncthreads();
        for (int ch = tid; ch < 1024; ch += 512) { const int s = ch >> 4, d0 = (ch & 15) * 8; float v[8], o[8];
            unpack8(*(const u32x4*)(P + (size_t)(n * 64 + s) * NP + C_GQ + h * 128 + d0), v);
#pragma unroll
            for (int i = 0; i < 8; ++i) o[i] = v[i] * 0.08838834764831845f * __expf(bc[s * 128 + d0 + i]);
            *(u32x4*)(Q + s * 136 + d0) = pack8(o);
            unpack8(*(const u32x4*)(P + (size_t)(n * 64 + s) * NP + C_GK + h * 128 + d0), v);
#pragma unroll
            for (int i = 0; i < 8; ++i) o[i] = v[i] * __expf(-bc[s * 128 + d0 + i]);
            *(u32x4*)(Kk + s * 136 + d0) = pack8(o); }
        for (int ch = tid; ch < 2048; ch += 512) { const int s = ch >> 5, d0 = (ch & 31) * 8; const u32x4 w = *(const u32x4*)(P + (size_t)(n * 64 + s) * NP + C_GV + h * 256 + d0);
            VT[(d0 + 0) * 72 + (s ^ tsw(d0))] = (bf16_t)(w.x & 0xffff); VT[(d0 + 1) * 72 + (s ^ tsw(d0))] = (bf16_t)(w.x >> 16); VT[(d0 + 2) * 72 + (s ^ tsw(d0))] = (bf16_t)(w.y & 0xffff); VT[(d0 + 3) * 72 + (s ^ tsw(d0))] = (bf16_t)(w.y >> 16);
            VT[(d0 + 4) * 72 + (s ^ tsw(d0))] = (bf16_t)(w.z & 0xffff); VT[(d0 + 5) * 72 + (s ^ tsw(d0))] = (bf16_t)(w.z >> 16); VT[(d0 + 6) * 72 + (s ^ tsw(d0))] = (bf16_t)(w.w & 0xffff); VT[(d0 + 7) * 72 + (s ^ tsw(d0))] = (bf16_t)(w.w >> 16); }
        __syncthreads();
#pragma unroll
        for (int ti = 0; ti < 2; ++ti) { const int id = wave * 2 + ti, mt = id >> 2, nt = id & 3;
            f32x4 c = {0.f, 0.f, 0.f, 0.f};
#pragma unroll
            for (int ks = 0; ks < 4; ++ks) c = mfma16(*(const bf16x8*)(Q + (mt * 16 + l15) * 136 + ks * 32 + q * 8), *(const bf16x8*)(Kk + (nt * 16 + l15) * 136 + ks * 32 + q * 8), c);
#pragma unroll
            for (int j = 0; j < 4; ++j) { const int t = mt * 16 + q * 4 + j, s = nt * 16 + l15; ATS[t * 72 + s] = (bf16_t)f2bf(s <= t ? c[j] : 0.f); } }
        __syncthreads();
        const int mt = wave & 3, half = wave >> 2;
        bf16_t grv[4][8];
#pragma unroll
        for (int j = 0; j < 4; ++j)
#pragma unroll
            for (int i = 0; i < 8; ++i) grv[j][i] = P[(size_t)(n * 64 + mt * 16 + q * 4 + j) * NP + C_GR + h * 256 + (half * 8 + i) * 16 + l15];
        f32x4 acc[8];
#pragma unroll
        for (int i = 0; i < 8; ++i) acc[i] = (f32x4){0.f, 0.f, 0.f, 0.f};
        const bf16_t* Sg = (const bf16_t*)a.out + (size_t)it * 32768;
#pragma unroll
        for (int ks = 0; ks < 4; ++ks) { const bf16x8 aq = *(const bf16x8*)(Q + (mt * 16 + l15) * 136 + ks * 32 + q * 8);
#pragma unroll
            for (int i = 0; i < 8; ++i) acc[i] = mfma16(aq, *(const bf16x8*)(Sg + ((half * 8 + i) * 16 + l15) * 128 + ks * 32 + q * 8), acc[i]); }
#pragma unroll
        for (int ks = 0; ks < 2; ++ks) { const bf16x8 at = *(const bf16x8*)(ATS + (mt * 16 + l15) * 72 + ks * 32 + q * 8);
#pragma unroll
            for (int i = 0; i < 8; ++i) { const int vr = (half * 8 + i) * 16 + l15; acc[i] = mfma16(at, *(const bf16x8*)(VT + vr * 72 + ((ks * 32 + q * 8) ^ tsw(vr))), acc[i]); } }
        float ssq[4];
#pragma unroll
        for (int j = 0; j < 4; ++j) { float s = 0.f;
#pragma unroll
            for (int i = 0; i < 8; ++i) s += acc[i][j] * acc[i][j];
            s += __shfl_xor(s, 1); s += __shfl_xor(s, 2); s += __shfl_xor(s, 4); s += __shfl_xor(s, 8); ssq[j] = s; }
        if (l15 == 0) {
#pragma unroll
            for (int j = 0; j < 4; ++j) RS[(mt * 16 + q * 4 + j) * 2 + half] = ssq[j]; }
        __syncthreads();
#pragma unroll
        for (int j = 0; j < 4; ++j) { const int t = mt * 16 + q * 4 + j; const float rstd = rsqrtf((RS[t * 2] + RS[t * 2 + 1]) * (1.f / 256.f) + EPS);
#pragma unroll
            for (int i = 0; i < 8; ++i) { const int dv = (half * 8 + i) * 16 + l15; const float gr = bf1(grv[j][i]);
                OUTS[t * 264 + dv] = (bf16_t)f2bf(acc[i][j] * rstd * a.in[18][dv] * siluf(gr)); } }
        __syncthreads();
#pragma unroll
        for (int c4 = 0; c4 < 4; ++c4) { const int c = tid + 512 * c4, row = c >> 5, col = (c & 31) * 8;
            *(u32x4*)(P + (size_t)(n * 64 + row) * NP + 1024 + h * 256 + col) = *(const u32x4*)(OUTS + row * 264 + col); }
        __syncthreads();
    }
}

__device__ __forceinline__ unsigned mono_key(float f) { const unsigned u = __builtin_bit_cast(unsigned, f); return (u & 0x80000000u) ? ~u : (u | 0x80000000u); }
template <int NE> __device__ __forceinline__ unsigned select_kth(const unsigned (&e)[NE], int kth, int lowbit = 0) {
    unsigned mx = 0u, mn = 0xFFFFFFFFu;
#pragma unroll
    for (int j = 0; j < NE; ++j) { mx = max(mx, e[j]); mn = min(mn, e[j] ? e[j] : 0xFFFFFFFFu); }
#pragma unroll
    for (int o = 1; o < 64; o <<= 1) { mx = max(mx, (unsigned)__shfl_xor((int)mx, o)); mn = min(mn, (unsigned)__shfl_xor((int)mn, o)); }
    const unsigned dif = mx ^ mn;
    const int hb = dif ? 31 - __clz((int)dif) : -1;
    unsigned tau = hb >= 31 ? 0u : (hb < 0 ? mx : (mx & ~((2u << hb) - 1u)));
    for (int bit = hb; bit >= lowbit; --bit) { const unsigned cand = tau | (1u << bit); int c = 0;
#pragma unroll
        for (int j = 0; j < NE; ++j) c += __popcll(__ballot(e[j] >= cand));
        if (c >= kth) tau = cand; }
    return tau;
}
__device__ __forceinline__ unsigned compact1024(unsigned* base, int n, int lane, int lowbit, int& newcnt) {
    unsigned e[16];
#pragma unroll
    for (int j = 0; j < 16; ++j) { const int i = j * 64 + lane; e[j] = i < n ? base[i] : 0u; }
    const unsigned tau = select_kth<16>(e, 256, lowbit);
    const u64 lt = (1ull << lane) - 1ull; int run = 0;
#pragma unroll
    for (int j = 0; j < 16; ++j) { const bool p = e[j] >= tau; const u64 m = __ballot(p); if (p) base[run + __popcll(m & lt)] = e[j]; run += __popcll(m); }
    newcnt = run;
    return tau;
}
__device__ __forceinline__ void compact_final(unsigned* base, int n, int lane, int& newcnt) {
    unsigned e[16];
#pragma unroll
    for (int j = 0; j < 16; ++j) { const int i = j * 64 + lane; e[j] = i < n ? base[i] : 0u; }
    const unsigned t18 = select_kth<16>(e, 256, 14) >> 14;
    int cgt = 0;
#pragma unroll
    for (int j = 0; j < 16; ++j) cgt += __popcll(__ballot((e[j] >> 14) > t18));
    const int need = 256 - cgt;
    const u64 lt = (1ull << lane) - 1ull; int run = 0, trun = 0;
#pragma unroll
    for (int j = 0; j < 16; ++j) { const bool gt = (e[j] >> 14) > t18, tie = (e[j] >> 14) == t18 && e[j] != 0u;
        const u64 mt = __ballot(tie); const int trank = trun + __popcll(mt & lt);
        const bool keep = gt || (tie && trank < need);
        const u64 mk = __ballot(keep); if (keep) base[run + __popcll(mk & lt)] = e[j]; run += __popcll(mk); trun += __popcll(mt); }
    newcnt = run;
}
__device__ __forceinline__ const bf16_t* ik_row(const bf16_t* IKC, const bf16_t* CIK, bool sample, int b, int k) {
    if (!sample) return IKC + (size_t)k * 64;
    return k < 1024 ? CIK + (size_t)(b * 1024 + k) * 64 : IKC + (size_t)(TP + b * 64 + (k - 1024)) * 64;
}
__device__ __forceinline__ float relu_i(float x) { const int b = __builtin_bit_cast(int, x); return __builtin_bit_cast(float, b > 0 ? b : 0); }
constexpr int IDX_TAB_N = 3;
__device__ const unsigned short IDX_TAB[256][IDX_TAB_N] = {{401,86,65535},{416,72,65535},{395,101,65535},{393,96,65535},{399,95,65535},{390,100,65535},{391,102,65535},{410,75,65535},{406,80,65535},{384,113,65535},{385,108,65535},{377,121,65535},{388,106,65535},{378,118,65535},{371,127,65535},{381,114,65535},{369,132,65535},{370,126,65535},{374,120,65535},{364,135,65535},{373,125,65535},{362,136,65535},{368,133,65535},{354,148,65535},{359,145,65535},{363,138,65535},{356,143,65535},{358,140,65535},{365,139,65535},{360,147,65535},{355,149,65535},{353,152,65535},{350,155,65535},{352,150,65535},{348,156,65535},{347,158,65535},{346,159,65535},{349,157,65535},{344,161,65535},{345,162,65535},{341,166,65535},{343,163,65535},{340,168,65535},{342,164,65535},{338,171,65535},{339,170,65535},{336,172,65535},{337,173,65535},{334,175,65535},{335,174,65535},{332,176,65535},{333,177,65535},{329,180,65535},{331,179,65535},{328,182,65535},{330,178,65535},{326,184,65535},{327,185,65535},{324,186,65535},{325,183,65535},{322,188,65535},{323,189,65535},{320,190,65535},{321,191,65535},{318,192,65535},{319,193,65535},{316,194,65535},{317,195,65535},{314,196,65535},{315,197,65535},{312,198,65535},{313,199,65535},{310,200,65535},{311,201,65535},{308,202,65535},{309,203,65535},{306,204,65535},{307,205,65535},{304,206,65535},{305,207,65535},{302,208,65535},{303,209,65535},{300,210,65535},{301,211,65535},{298,212,65535},{299,213,65535},{296,214,65535},{297,215,65535},{294,216,65535},{295,217,65535},{292,218,65535},{293,219,65535},{290,220,65535},{291,221,65535},{288,222,65535},{289,223,65535},{286,224,65535},{287,225,65535},{284,226,65535},{285,227,65535},{282,228,65535},{283,229,65535},{280,230,65535},{281,231,65535},{278,232,65535},{279,233,65535},{276,234,65535},{277,235,65535},{274,236,65535},{275,237,65535},{272,238,65535},{273,239,65535},{270,240,65535},{271,241,65535},{268,242,65535},{269,243,65535},{266,244,65535},{267,245,65535},{264,246,65535},{265,247,65535},{262,248,65535},{263,249,65535},{260,250,65535},{261,251,65535},{258,252,65535},{259,253,65535},{256,254,65535},{257,255,65535},{508,16,65535},{511,10,65535},{510,12,65535},{509,15,65535},{506,20,65535},{507,19,65535},{504,22,65535},{500,24,65535},{502,23,65535},{503,25,65535},{505,21,65535},{501,27,65535},{498,18,65535},{499,29,65535},{496,30,65535},{497,28,65535},{491,526,65535},{495,527,65535},{492,524,65535},{493,525,65535},{490,522,65535},{494,31,65535},{488,520,65535},{483,513,65535},{486,518,65535},{482,37,65535},{484,516,65535},{489,517,65535},{487,514,65535},{485,515,65535},{480,38,65535},{481,36,65535},{478,32,9},{479,35,3},{472,521,17},{463,519,26},{474,523,11},{476,512,13},{475,33,8},{439,42,34},{470,40,6},{471,39,7},{467,45,4},{469,43,5},{466,47,2},{458,46,14},{464,51,0},{465,49,1},{468,48,65535},{477,41,65535},{460,50,65535},{473,44,65535},{462,52,65535},{461,53,65535},{456,57,65535},{457,55,65535},{454,56,65535},{455,59,65535},{452,58,65535},{459,54,65535},{453,60,65535},{451,61,65535},{448,62,65535},{450,63,65535},{449,64,65535},{447,65,65535},{444,66,65535},{446,67,65535},{442,68,65535},{445,69,65535},{443,70,65535},{441,71,65535},{438,76,65535},{440,73,65535},{436,74,65535},{437,77,65535},{434,79,65535},{430,84,65535},{435,78,65535},{433,81,65535},{432,82,65535},{431,83,65535},{428,85,65535},{426,89,65535},{429,87,65535},{427,88,65535},{424,91,65535},{422,92,65535},{425,90,65535},{423,93,65535},{418,98,65535},{421,97,65535},{420,94,65535},{419,99,65535},{413,104,65535},{417,103,65535},{407,115,65535},{408,112,65535},{414,107,65535},{415,105,65535},{403,119,65535},{412,109,65535},{411,110,65535},{400,123,65535},{404,116,65535},{409,111,65535},{398,124,65535},{405,117,65535},{402,122,65535},{396,131,65535},{392,130,65535},{394,128,65535},{383,142,65535},{389,134,65535},{387,137,65535},{397,129,65535},{386,141,65535},{376,151,65535},{375,154,65535},{372,160,65535},{380,146,65535},{379,153,65535},{382,144,65535},{366,165,65535},{357,181,65535},{351,187,65535},{361,169,65535},{367,167,65535}};
constexpr int IKP = 144;
__device__ __forceinline__ void idx_phase(const Args& a, unsigned char* lds, int tid, int lane, int wave) {
    const bf16_t* P = (const bf16_t*)(a.ws + WS_P); const bf16_t* CIK = (const bf16_t*)(a.ws + WS_CIK); const bf16_t* IKC = (const bf16_t*)(a.ws + WS_IKC);
    unsigned* CAND = (unsigned*)(a.ws + WS_ACT);
    unsigned* lst = (unsigned*)(lds + wave * 16384);
    unsigned char* kbuf = lds + 131072;
    const int r = lane & 31, hf = lane >> 5;
    const int qsel = (r >> 2) & 1, head = (r & 3) + 4 * (r >> 3);
    const int skey = tid >> 3, schk = tid & 7;
    const bool use_tab = gridDim.x == 256;
    for (int kk = 0; ; ++kk) {
        int id;
        if (use_tab) { if (kk >= IDX_TAB_N) break; id = IDX_TAB[blockIdx.x][kk]; if (id == 0xFFFF) break; }
        else { const int it = blockIdx.x + kk * gridDim.x; if (it >= 528) break;
               id = it < 256 ? (255 - (it >> 1)) * 2 + (it & 1) : (it < 512 ? ((it - 256) >> 1) * 2 + (it & 1) : it); }
        int c, half = id & 1, bb = 0; bool sample = false;
        if (id < 512) c = id >> 1;
        else { sample = true; bb = (id - 512) >> 1; c = 256 + bb; }
        const int L = sample ? 1088 : 64 * (c + 1), ntile = L >> 6;
        const int t0 = c * 64 + half * 32 + wave * 4;
        bf16x8 af[2][4]; float w[2][16];
#pragma unroll
        for (int rb = 0; rb < 2; ++rb) {
            const bf16_t* qp = P + (size_t)(t0 + 2 * rb + qsel) * NP + C_IQ + head * 64 + hf * 8;
#pragma unroll
            for (int ks = 0; ks < 4; ++ks) af[rb][ks] = *(const bf16x8*)(qp + ks * 16);
            const bf16_t* wp = P + (size_t)(t0 + 2 * rb + hf) * NP + C_IW;
            unpack8(*(const u32x4*)wp, w[rb]); unpack8(*(const u32x4*)(wp + 8), w[rb] + 8);
        }
        unsigned tau[2], cnt[2];
#pragma unroll
        for (int rb = 0; rb < 2; ++rb) { tau[rb] = 0u; cnt[rb] = 0u; }
        { const u32x4 v = *(const u32x4*)(ik_row(IKC, CIK, sample, bb, skey) + schk * 8); *(u32x4*)(kbuf + skey * IKP + schk * 16) = v; }
        u32x4 p1 = {0u, 0u, 0u, 0u}, p2 = p1, p3 = p1;
        if (1 < ntile) p1 = *(const u32x4*)(ik_row(IKC, CIK, sample, bb, 1 * 64 + skey) + schk * 8);
        if (2 < ntile) p2 = *(const u32x4*)(ik_row(IKC, CIK, sample, bb, 2 * 64 + skey) + schk * 8);
        if (3 < ntile) p3 = *(const u32x4*)(ik_row(IKC, CIK, sample, bb, 3 * 64 + skey) + schk * 8);
        __syncthreads();
#define IDX_MFMA8(ACC, KBP, SUB) do { bf16x8 bfr[4]; \
            _Pragma("unroll") for (int ks = 0; ks < 4; ++ks) bfr[ks] = *(const bf16x8*)((KBP) + ((SUB) * 32 + r) * IKP + ks * 32 + hf * 16); \
            _Pragma("unroll") for (int i = 0; i < 16; ++i) { ACC[0][i] = 0.f; ACC[1][i] = 0.f; } \
            __builtin_amdgcn_s_setprio(1); \
            _Pragma("unroll") for (int ks = 0; ks < 4; ++ks) { ACC[0] = __builtin_amdgcn_mfma_f32_32x32x16_bf16(af[0][ks], bfr[ks], ACC[0], 0, 0, 0); ACC[1] = __builtin_amdgcn_mfma_f32_32x32x16_bf16(af[1][ks], bfr[ks], ACC[1], 0, 0, 0); } \
            __builtin_amdgcn_s_setprio(0); } while (0)
#define IDX_SCORE(ACC, ENT, KEY) do { _Pragma("unroll") for (int rb = 0; rb < 2; ++rb) { float s0 = 0.f, s1 = 0.f; \
            _Pragma("unroll") for (int i = 0; i < 16; i += 2) { s0 += relu_i(ACC[rb][i]) * w[rb][i]; s1 += relu_i(ACC[rb][i + 1]) * w[rb][i + 1]; } \
            ENT[rb] = (mono_key(s0 + s1) & 0xFFFFC000u) | (KEY); } } while (0)
#define IDX_INTERLEAVE() do { _Pragma("unroll") for (int i_ = 0; i_ < 8; ++i_) { __builtin_amdgcn_sched_group_barrier(0x008, 1, 0); __builtin_amdgcn_sched_group_barrier(0x002, 9, 0); } } while (0)
#define IDX_INSERT(ENT) do { _Pragma("unroll") for (int rb = 0; rb < 2; ++rb) { \
            const unsigned ent = ENT[rb]; const bool p = ent > tau[rb]; const u64 m = __ballot(p); \
            if (m) { const unsigned mh = hf ? (unsigned)(m >> 32) : (unsigned)m; \
                if (p) lst[(2 * rb + hf) * 1024 + cnt[rb] + __popc(mh & ((1u << r) - 1u))] = ent; \
                cnt[rb] += __popc(mh); \
                if (__any(cnt[rb] > 992u)) { \
                    _Pragma("unroll") for (int hh = 0; hh < 2; ++hh) { const int cc = __builtin_amdgcn_readlane((int)cnt[rb], hh * 32); \
                        if (cc > 992) { int nc; const unsigned nt_ = compact1024(lst + (2 * rb + hh) * 1024, cc, lane, 14, nc); if (hf == hh) { tau[rb] = nt_; cnt[rb] = (unsigned)nc; } } } } } } } while (0)
        f32x16 accA[2], accB[2];
        IDX_MFMA8(accA, kbuf, 0);
        for (int tl = 0; tl < ntile; ++tl) {
            u32x4 p4 = {0u, 0u, 0u, 0u};
            if (tl + 4 < ntile) p4 = *(const u32x4*)(ik_row(IKC, CIK, sample, bb, (tl + 4) * 64 + skey) + schk * 8);
            const unsigned char* kb = kbuf + (tl & 1) * (64 * IKP);
            const unsigned char* kbn = kbuf + ((tl + 1) & 1) * (64 * IKP);
            unsigned entA[2], entB[2];
            IDX_MFMA8(accB, kb, 1);
            IDX_SCORE(accA, entA, (unsigned)(tl * 64 + r));
            IDX_INTERLEAVE();
            IDX_INSERT(entA);
            if (tl + 1 < ntile) *(u32x4*)(kbuf + ((tl + 1) & 1) * (64 * IKP) + skey * IKP + schk * 16) = p1;
            __syncthreads();
            if (tl + 1 < ntile) { IDX_MFMA8(accA, kbn, 0); IDX_SCORE(accB, entB, (unsigned)(tl * 64 + 32 + r)); IDX_INTERLEAVE(); }
            else { IDX_SCORE(accB, entB, (unsigned)(tl * 64 + 32 + r)); }
            IDX_INSERT(entB);
            if (tl == 14 || tl == 50 || tl == 174) {
#pragma unroll
                for (int rb = 0; rb < 2; ++rb)
#pragma unroll
                    for (int hh = 0; hh < 2; ++hh) { const int cc = __builtin_amdgcn_readlane((int)cnt[rb], hh * 32);
                        if (cc > 256) { int nc; const unsigned nt_ = compact1024(lst + (2 * rb + hh) * 1024, cc, lane, 14, nc); if (hf == hh) { tau[rb] = nt_; cnt[rb] = (unsigned)nc; } } }
            }
            p1 = p2; p2 = p3; p3 = p4;
        }
#pragma unroll
        for (int rb = 0; rb < 2; ++rb)
#pragma unroll
            for (int hh = 0; hh < 2; ++hh) { int cc = __builtin_amdgcn_readlane((int)cnt[rb], hh * 32); unsigned* base = lst + (2 * rb + hh) * 1024;
                if (cc > 256) { int nc; compact_final(base, cc, lane, nc); cc = nc; }
                unsigned* dst = CAND + (size_t)(t0 + 2 * rb + hh) * 256;
                for (int j = lane; j < cc; j += 64) dst[j] = base[j]; }
    }
}

__device__ __forceinline__ void attn_phase(const Args& a, unsigned char* lds, int lane, int wave) {
    bf16_t* P = (bf16_t*)(a.ws + WS_P);
    const unsigned char* KV8 = a.ws + WS_KV8; const unsigned char* CKV8 = a.ws + WS_CKV8;
    const unsigned* CAND = (const unsigned*)(a.ws + WS_ACT);
    unsigned* sel = (unsigned*)(lds + 122880 + wave * 1024);
    const int gw = blockIdx.x * 8 + wave, NGW = gridDim.x * 8;
    for (int t = gw; t < TT; t += NGW) {
        const bool sample = t >= TP; const int bb = sample ? (t - TP) >> 6 : 0;
        const int c = t >> 6; const int L = sample ? 1088 : 64 * (c + 1);
        const int nsel = min(256, L);
        const unsigned* cand = CAND + (size_t)t * 256;
#pragma unroll
        for (int j = 0; j < 4; ++j) { const int i = j * 64 + lane; if (i < nsel) sel[i] = cand[i] & 0x3FFFu; }
        bf16_t* qp = P + (size_t)t * NP + lane * 16;
        float q[16]; unpack8(*(const u32x4*)qp, q); unpack8(*(const u32x4*)(qp + 8), q + 8);
        float mx = -INFINITY, l = 0.f, o[16];
#pragma unroll
        for (int d = 0; d < 16; ++d) o[d] = 0.f;
        for (int j = 0; j < nsel; j += 8) {
            const u32x4 ida = *(const u32x4*)(sel + j), idb = *(const u32x4*)(sel + j + 4);
            u32x4 kk[8], vv[8];
#pragma unroll
            for (int i = 0; i < 8; ++i) { const int idx = (int)(i < 4 ? ida[i & 3] : idb[i & 3]); const unsigned char* kp;
                if (!sample) kp = KV8 + (size_t)idx * 2048;
                else if (idx < 1024) kp = CKV8 + (size_t)(bb * 1024 + idx) * 2048;
                else kp = KV8 + (size_t)(TP + bb * 64 + idx - 1024) * 2048;
                kk[i] = *(const u32x4*)(kp + lane * 16); vv[i] = *(const u32x4*)(kp + 1024 + lane * 16); }
            float s[8];
#pragma unroll
            for (int i = 0; i < 8; ++i) { float kf[16]; unpack16_fp8(kk[i], kf); float d0 = 0.f, d1 = 0.f;
#pragma unroll
                for (int x = 0; x < 16; x += 2) { d0 += q[x] * kf[x]; d1 += q[x + 1] * kf[x + 1]; }
                float d = d0 + d1;
                d += __shfl_xor(d, 1); d += __shfl_xor(d, 2); d += __shfl_xor(d, 4); s[i] = d; }
            const float mn = fmaxf(fmaxf(fmaxf(mx, fmaxf(s[0], s[1])), fmaxf(s[2], s[3])), fmaxf(fmaxf(s[4], s[5]), fmaxf(s[6], s[7])));
            const float al = __builtin_amdgcn_exp2f(mx - mn);
            float p[8];
#pragma unroll
            for (int i = 0; i < 8; ++i) p[i] = __builtin_amdgcn_exp2f(s[i] - mn);
            l = l * al + ((p[0] + p[1]) + (p[2] + p[3])) + ((p[4] + p[5]) + (p[6] + p[7]));
#pragma unroll
            for (int d = 0; d < 16; ++d) o[d] *= al;
#pragma unroll
            for (int i = 0; i < 8; ++i) { float vf[16]; unpack16_fp8(vv[i], vf);
#pragma unroll
                for (int d = 0; d < 16; ++d) o[d] += p[i] * vf[d]; }
            mx = mn;
        }
        const float il = 1.f / l;
#pragma unroll
        for (int d = 0; d < 16; ++d) o[d] *= il;
        *(u32x4*)qp = pack8(o); *(u32x4*)(qp + 8) = pack8(o + 8);
    }
}

__device__ __forceinline__ void fixup_phase(const Args& a, int tid) {
    const bf16_t* Uf = (const bf16_t*)(a.ws + WS_UF); const bf16_t* Uh = (const bf16_t*)(a.ws + WS_UH);
    bf16_t* ACTF = (bf16_t*)(a.ws + WS_P);
    const float* wconv = a.in[21]; const float* bconv = a.in[22];
    const size_t gt = (size_t)blockIdx.x * 512 + tid, GT = (size_t)gridDim.x * 512;
    for (size_t e = gt; e < (size_t)NCH * DFF; e += GT) {
        const int g = (int)(e / DFF), ch = (int)(e % DFF);
        float pa[2], pb[2];
        if (g >= 256) { const float* st = a.in[8] + (size_t)(g - 256) * 2 * NUP; pa[0] = st[ch]; pa[1] = st[NUP + ch]; pb[0] = st[DFF + ch]; pb[1] = st[NUP + DFF + ch]; }
        else if (g == 0) { pa[0] = pa[1] = pb[0] = pb[1] = 0.f; }
        else { const bf16_t* st = Uh + (size_t)(g - 1) * 2 * NUP; pa[0] = bf1(st[ch]); pa[1] = bf1(st[NUP + ch]); pb[0] = bf1(st[DFF + ch]); pb[1] = bf1(st[NUP + DFF + ch]); }
        const bf16_t* uf = Uf + (size_t)g * 2 * NUP;
        const float a0 = bf1(uf[ch]), a1 = bf1(uf[NUP + ch]), b0 = bf1(uf[DFF + ch]), b1 = bf1(uf[NUP + DFF + ch]);
        const float wa0 = wconv[ch], wa1 = wconv[NUP + ch], wa2 = wconv[2 * NUP + ch], ba = bconv[ch];
        const float wb0 = wconv[DFF + ch], wb1 = wconv[NUP + DFF + ch], wb2 = wconv[2 * NUP + DFF + ch], bb = bconv[DFF + ch];
        const float ca0 = ba + wa2 * a0 + wa1 * pa[1] + wa0 * pa[0], cb0 = bb + wb2 * b0 + wb1 * pb[1] + wb0 * pb[0];
        const float ca1 = ba + wa2 * a1 + wa1 * a0 + wa0 * pa[1], cb1 = bb + wb2 * b1 + wb1 * b0 + wb0 * pb[1];
        ACTF[(size_t)(g * 64) * DFF + ch] = (bf16_t)f2bf(siluf(ca0) * cb0);
        ACTF[(size_t)(g * 64 + 1) * DFF + ch] = (bf16_t)f2bf(siluf(ca1) * cb1);
    }
    for (size_t e = gt; e < (size_t)9 * 2 * NUP; e += GT) {
        const int s = (int)(e / (2 * NUP)), rem = (int)(e % (2 * NUP));
        const int g = s == 0 ? 255 : 255 + s;
        const float v = bf1(Uh[(size_t)g * 2 * NUP + rem]);
        if (s == 0) a.out[O_FCP + rem] = v; else a.out[O_FCS + (size_t)(s - 1) * 2 * NUP + rem] = v;
    }
}

#define LAS __attribute__((address_space(3)))
#define XB_TMO      128
#define XB_XCNT(j)  (256  + 64 * (j))
#define XB_XSUB(j)  (1280 + 64 * (j))
#define XB_XGEN(j)  (2304 + 64 * (j))
#define XB_TOP      3328
#define XB_TOPGEN   3392
#define XCD_BAR_WORDS 3456
#define XB_SPIN_CAP (1u << 18)

__device__ __forceinline__ unsigned xb_ld(unsigned* p)              { return __hip_atomic_load(p, __ATOMIC_RELAXED, __HIP_MEMORY_SCOPE_AGENT); }
__device__ __forceinline__ unsigned xb_add(unsigned* p, unsigned v) { return __hip_atomic_fetch_add(p, v, __ATOMIC_RELAXED, __HIP_MEMORY_SCOPE_AGENT); }
__device__ __forceinline__ unsigned xb_xcc_id() { return (unsigned)__builtin_amdgcn_s_getreg((3 << 11) | 20) & 0xFu; }
#define XB_SPIN(cond, bar) do { unsigned _sp = 0; while (cond) { __builtin_amdgcn_s_sleep(1); \
    if ((++_sp & 255u) == 0u) { if (xb_ld(&(bar)[XB_TMO])) break; if (_sp > XB_SPIN_CAP) { atomicAdd(&(bar)[XB_TMO], 1u); break; } } } } while (0)

struct XcdBarrier {
    unsigned* bar; unsigned x;
    volatile LAS unsigned* st;
};

__device__ __forceinline__ XcdBarrier xcd_barrier_post(unsigned* bar, volatile LAS unsigned* st) {
    XcdBarrier b; b.bar = bar; b.x = xb_xcc_id(); b.st = st;
    if (threadIdx.x == 0) (void)xb_add(&bar[XB_XCNT(b.x)], 1u);
    return b;
}
__device__ __forceinline__ void xcd_barrier_complete(unsigned* bar, unsigned x, unsigned& nloc, unsigned& nx) {
    const unsigned G = gridDim.x * gridDim.y * gridDim.z;
    unsigned sum, cnt, mine, sp = 0u;
    for (;;) {
        sum = 0u; cnt = 0u; mine = 0u;
#pragma unroll
        for (unsigned j = 0; j < 16; ++j) { const unsigned c = xb_ld(&bar[XB_XCNT(j)]); sum += c; cnt += (c > 0u) ? 1u : 0u; mine = (j == x) ? c : mine; }
        if (sum == G) break;
        __builtin_amdgcn_s_sleep(1);
        if ((++sp & 255u) == 0u) { if (xb_ld(&bar[XB_TMO])) break; if (sp > XB_SPIN_CAP) { atomicAdd(&bar[XB_TMO], 1u); break; } }
    }
    nloc = mine > 0u ? mine : 1u; nx = cnt > 0u ? cnt : 1u;
}

__device__ __forceinline__ void xcd_barrier(const XcdBarrier& b) {
    asm volatile("s_waitcnt vmcnt(0)" ::: "memory");
    __syncthreads();
    if (threadIdx.x == 0) {
        unsigned* bar = b.bar;
        __builtin_amdgcn_s_waitcnt(0);
        unsigned nloc = b.st[0], nx = b.st[1];
        if (nloc == 0u) { xcd_barrier_complete(bar, b.x, nloc, nx); b.st[0] = nloc; b.st[1] = nx; }
        const unsigned old = xb_add(&bar[XB_XSUB(b.x)], 1u);
        const unsigned gen = old / nloc;
        if (old + 1u == (gen + 1u) * nloc) {
            __builtin_amdgcn_fence(__ATOMIC_RELEASE, "agent");
            asm volatile("s_waitcnt vmcnt(0)" ::: "memory");
            const unsigned og = xb_add(&bar[XB_TOP], 1u);
            const unsigned tg = og / nx;
            if (og + 1u == (tg + 1u) * nx) xb_add(&bar[XB_TOPGEN], 1u);
            else XB_SPIN(xb_ld(&bar[XB_TOPGEN]) == tg, bar);
            __builtin_amdgcn_fence(__ATOMIC_ACQUIRE, "agent");
            xb_add(&bar[XB_XGEN(b.x)], 1u);
            asm volatile("s_waitcnt vmcnt(0)" ::: "memory");
        } else {
            XB_SPIN(xb_ld(&bar[XB_XGEN(b.x)]) == gen, bar);
            __builtin_amdgcn_fence(__ATOMIC_ACQUIRE, "agent");
            asm volatile("s_waitcnt vmcnt(0)" ::: "memory");
        }
    }
    __syncthreads();
}

__global__ void __launch_bounds__(512, 2) mega_fwd(Args a) {
    extern __shared__ __attribute__((aligned(16))) unsigned char lds[];
    cg::grid_group grid = cg::this_grid();
    const int tid = threadIdx.x, lane = tid & 63, wave = __builtin_amdgcn_readfirstlane(tid >> 6);
    unsigned char* ws = a.ws;
    const float* MOD = (const float*)(ws + WS_MOD);
#ifndef ONLY_PH
#define ONLY_PH -1
#endif
#define PHON(k) ((ONLY_PH < 0 || ONLY_PH == (k)) && lo <= (k) && (k) <= hi)
    volatile LAS unsigned* bst = (volatile LAS unsigned*)((PG8_LAS unsigned char*)lds + (LDS_BYTES - 64));
    if (tid == 0) { bst[0] = 0u; bst[1] = 0u; }
    __syncthreads();
    const XcdBarrier xbar = xcd_barrier_post((unsigned*)(ws + WS_CTL) + 1024, bst);
    if (a.ph_lo > NPHASE) grid.sync();
#define SEAM(k) do { if ((k) < hi) xcd_barrier(xbar); } while (0)
    const int lo = a.ph_lo, hi = a.ph_hi;
    if (PHON(0)) { phase0(a, lds, tid, lane, wave);
        SEAM(0); }
    if (PHON(1)) { normmod_phase(a.in[0], a.in[1], a.in[11], MOD, 0 * DM, 1 * DM, (bf16_t*)(ws + WS_ACT), lane, wave); SEAM(1); }
    if (PHON(2)) {
        pg8::Gemm g{(const bf16_t*)(ws + WS_ACT), (const bf16_t*)(ws + WS_WIN), TT, NP, DM, DM}; pg8::StaticOrder S; S.init(TT, NP, gridDim.x, blockIdx.x);
        EpiP E{(bf16_t*)(ws + WS_P), NP};
        pg8::gemm_phase<EpiP, pg8::StaticOrder, true, true>((PG8_LAS unsigned char*)lds, g, S, E);
        { int rank, count; if (gemm_tail_rank(S.nwg, rank, count)) tail_wout(a, lds, rank, count, lane, wave); else if (count <= 0 && blockIdx.x == 0) tail_wout(a, lds, 0, 1, lane, wave); }
        SEAM(2);
    }
    const bool swap_order = ((blockIdx.x >> 3) & 1) != 0;
    if (PHON(3)) {
        if (swap_order) { gla_g1(a, lds, tid, lane, wave); __syncthreads(); post_rows(a, lds, tid, lane, wave); }
        else { post_rows(a, lds, tid, lane, wave); gla_g1(a, lds, tid, lane, wave); }
        SEAM(3); }
    if (PHON(4)) { gla_g2(a, tid); idx_phase(a, lds, tid, lane, wave); SEAM(4); }
    if (PHON(5)) {
        attn_phase(a, lds, lane, wave); __syncthreads(); gla_g3(a, lds, tid, lane, wave);
        SEAM(5); }
    if (PHON(6)) {
        pg8::Gemm g{(const bf16_t*)(ws + WS_P), (const bf16_t*)(ws + WS_WOUT), TT, DM, DM, NP}; pg8::StaticOrder S; S.init(TT, DM, gridDim.x, blockIdx.x);
        EpiRes E{a.in[0], a.in[1], a.out + O_Y, MOD + 2 * DM};
        pg8::gemm_phase<EpiRes, pg8::StaticOrder, true, true>((PG8_LAS unsigned char*)lds, g, S, E);
        { int rank, count; if (gemm_tail_rank(S.nwg, rank, count)) tail_wup_wdn(a, lds, rank, count, lane, wave); else if (count <= 0 && blockIdx.x == 0) tail_wup_wdn(a, lds, 0, 1, lane, wave); }
        SEAM(6);
    }
    if (PHON(7)) { normmod_phase(a.out + O_Y, a.out + O_Y + (size_t)TP * DM, a.in[12], MOD, 3 * DM, 4 * DM, (bf16_t*)(ws + WS_ACT), lane, wave); SEAM(7); }
    if (PHON(8)) {
        pg8::Gemm g{(const bf16_t*)(ws + WS_ACT), (const bf16_t*)(ws + WS_WUP), TT, NUP, DM, DM}; pg8::StaticOrder S; S.init(TT, NUP, gridDim.x, blockIdx.x);
        EpiUp E{(bf16_t*)(ws + WS_P), (bf16_t*)(ws + WS_UF), (bf16_t*)(ws + WS_UH), a.in[21], a.in[22]};
        pg8::gemm_phase<EpiUp, pg8::StaticOrder, true, true>((PG8_LAS unsigned char*)lds, g, S, E);
        SEAM(8);
    }
    if (PHON(9)) { fixup_phase(a, tid); SEAM(9); }
    if (PHON(10)) {
        pg8::Gemm g{(const bf16_t*)(ws + WS_P), (const bf16_t*)(ws + WS_WDN), TT, DM, DFF, DFF}; pg8::StaticOrder S; S.init(TT, DM, gridDim.x, blockIdx.x);
        EpiRes E{a.out + O_Y, a.out + O_Y + (size_t)TP * DM, a.out + O_Y, MOD + 5 * DM};
        pg8::gemm_phase<EpiRes, pg8::StaticOrder, true, true>((PG8_LAS unsigned char*)lds, g, S, E);
    }
}

#ifndef MK_MULTI
#define MK_MULTI 0
#endif
extern "C" void kernel_launch(void* const* d_in, const int* in_sizes, int n_in, void* d_out, int out_size, void* d_ws, size_t ws_size, hipStream_t stream) {
    static int grid = 0;
    if (grid == 0) {
        if (n_in != 24 || (size_t)out_size != O_TOTAL || ws_size < WS_END) { fprintf(stderr, "kernel_launch: unexpected shapes: n_in %d out %d ws %zu\n", n_in, out_size, ws_size); grid = -1; return; }
        int dev = 0, cus = 0, per_cu = 0;
        hipGetDevice(&dev); hipDeviceGetAttribute(&cus, hipDeviceAttributeMultiprocessorCount, dev);
        if (hipFuncSetAttribute((const void*)mega_fwd, hipFuncAttributeMaxDynamicSharedMemorySize, LDS_BYTES) != hipSuccess) { fprintf(stderr, "kernel_launch: hipFuncSetAttribute failed\n"); grid = -1; return; }
        hipOccupancyMaxActiveBlocksPerMultiprocessor(&per_cu, (const void*)mega_fwd, 512, LDS_BYTES);
        if (per_cu < 1) per_cu = 1;
        (void)hipGetLastError();
        grid = cus * 1;
        if (grid <= 0) grid = 256;
    }
    if (grid < 0) return;
    hipMemsetAsync((char*)d_ws + WS_CTL, 0, 32768, stream);
    Args a{};
    for (int i = 0; i < 24; ++i) a.in[i] = (const float*)d_in[i];
    a.out = (float*)d_out; a.ws = (unsigned char*)d_ws;
#if MK_MULTI
    for (int ph = 0; ph < NPHASE; ++ph) { a.ph_lo = ph; a.ph_hi = ph; hipLaunchKernelGGL(mega_fwd, dim3(grid), dim3(512), LDS_BYTES, stream, a); }
#else
    a.ph_lo = 0; a.ph_hi = NPHASE - 1;
    void* args[] = {&a};
    hipError_t e = hipLaunchCooperativeKernel((const void*)mega_fwd, dim3(grid), dim3(512), args, LDS_BYTES, stream);
    if (e != hipSuccess) fprintf(stderr, "cooperative launch failed: %s (grid %d)\n", hipGetErrorString(e), grid);
#endif
}
```

```cpp
#include <hip/hip_runtime.h>
#include <hip/hip_cooperative_groups.h>
#include <cstdio>
#include <cstdint>
namespace cg = cooperative_groups;
namespace pg8 {
#define PG8_LAS __attribute__((address_space(3)))
typedef unsigned short bf16_t;
typedef short bf16x8 __attribute__((ext_vector_type(8)));
typedef float f32x4 __attribute__((ext_vector_type(4)));
typedef unsigned u32x4 __attribute__((ext_vector_type(4)));
constexpr int BM = 256, BK = 64, HALF = 128, HTB = HALF * BK * 2  , STAGE_BYTES = 8 * HTB, NXCD = 8, WGM = 8;

__host__ __device__ __forceinline__ int lds_byte(int r, int c) { const int st = (r >> 4) * 2 + (c >> 5), rr = r & 15, cc = c & 31, ob = rr * 64 + cc * 2; return st * 1024 + (ob ^ (((ob >> 9) & 1) << 5)); }
__host__ __device__ __forceinline__ void stage_rc(int b, int& R, int& C) { const int st = b / 1024, sb = b % 1024, swz = sb ^ (((sb >> 9) & 1) << 5); R = (st >> 1) * 16 + swz / 64; C = (st & 1) * 32 + (swz % 64) / 2; }
__host__ __device__ __forceinline__ int perm32(int rho) { const int n = rho >> 4, i = rho & 15; return 8 * (i >> 2) + 4 * n + (i & 3); }

struct Unit { int pm, pn; };
struct Gemm { const bf16_t* A; const bf16_t* Bt; int M, N, K, lda; };

struct StaticOrder {
    int nM, nN, nwg, G, c;
    __host__ __device__ void init(int M, int N, int G_, int c_) { nM = M / BM; nN = N / BM; nwg = nM * nN; G = G_; c = c_; }
    __host__ __device__ bool next(int i, Unit& u) const {
        const long L = (long)i * G + c; if (L >= nwg) return false;
        int wgid = (int)L; { const int q = nwg / NXCD, r = nwg % NXCD, xcd = wgid % NXCD, off = wgid / NXCD; wgid = (xcd < r ? xcd * (q + 1) : r * (q + 1) + (xcd - r) * q) + off; }
        const int nig = WGM * nN, gid = wgid / nig, fm = gid * WGM, gsz = (nM - fm) < WGM ? (nM - fm) : WGM;
        u.pm = fm + ((wgid % nig) % gsz); u.pn = (wgid % nig) / gsz; return true;
    }
    __device__ __forceinline__ void a_ready(const Unit&) const {}
    __device__ __forceinline__ void done(const Unit&) const {}
};

__device__ __forceinline__ unsigned cvt_pk_bf16(float lo, float hi) { unsigned r; asm volatile("v_cvt_pk_bf16_f32 %0, %1, %2" : "=v"(r) : "v"(lo), "v"(hi)); return r; }
template <class Epi, class Sched, bool ALIGN_EPI = false, bool SP2 = false>
__device__ __forceinline__ void gemm_phase(PG8_LAS unsigned char* lds, const Gemm g, const Sched& S, const Epi& E) {
    const int tid = threadIdx.x, wid = __builtin_amdgcn_readfirstlane(tid >> 6), lane = tid & 63, wr = wid >> 2, wc = wid & 3, fr = lane & 15, fq = lane >> 4;
    const int K = g.K, nt = K / BK;
    unsigned voffA[2], voffB[2];
#pragma unroll
    for (int i = 0; i < 2; ++i) { int R, C; stage_rc(tid * 16 + i * 8192, R, C); const int Rb = Epi::PERM ? ((R & ~31) + perm32(R & 31)) : R;
        voffA[i] = (unsigned)(R * g.lda + C) * 2u; voffB[i] = (unsigned)(Rb * K + C) * 2u; }
    const size_t kstep = (size_t)(BK * 2);
    const size_t hstepA = (size_t)HALF * g.lda * 2, hstepB = (size_t)HALF * K * 2;
    const size_t tstepA = 2 * hstepA, tstepB = 2 * hstepB;
    const unsigned ldsw = (unsigned)wid * 1024u;
    const int aoff = lds_byte(wr * 64 + fr, fq * 8), boff = lds_byte(wc * 32 + fr, fq * 8);
#define PG8_SA(b, h) (((b) * 2 + (h)) * HTB)
#define PG8_SB(b, h) ((4 + (b) * 2 + (h)) * HTB)
#define PG8_STAGE(bufoff, gbase, voff) do { _Pragma("unroll") for (int _i = 0; _i < 2; ++_i) \
        __builtin_amdgcn_global_load_lds((const unsigned*)((const char*)(gbase) + (voff)[_i]), (PG8_LAS unsigned*)(lds + (bufoff) + ldsw + _i * 8192), 16, 0, 0); } while (0)
#define PG8_LDA(dst, b, h) do { _Pragma("unroll") for (int m = 0; m < 4; ++m) _Pragma("unroll") for (int k = 0; k < 2; ++k) dst[m][k] = *(const PG8_LAS bf16x8*)(lds + PG8_SA(b, h) + aoff + m * 2048 + k * 1024); } while (0)
#define PG8_LDB(dst, b, h) do { _Pragma("unroll") for (int n = 0; n < 2; ++n) _Pragma("unroll") for (int k = 0; k < 2; ++k) dst[n][k] = *(const PG8_LAS bf16x8*)(lds + PG8_SB(b, h) + boff + n * 2048 + k * 1024); } while (0)
#define PG8_MMA(ai, bj, At, Bt) do { __builtin_amdgcn_s_setprio(1); _Pragma("unroll") for (int m = 0; m < 4; ++m) _Pragma("unroll") for (int n = 0; n < 2; ++n) _Pragma("unroll") for (int k = 0; k < 2; ++k) \
        acc[ai][bj][m][n] = __builtin_amdgcn_mfma_f32_16x16x32_bf16(Bt[n][k], At[m][k], acc[ai][bj][m][n], 0, 0, 0); __builtin_amdgcn_s_setprio(0); } while (0)
#define PG8_WAIT_V(n) asm volatile("s_waitcnt vmcnt(" #n ")" ::: "memory")
#define PG8_WAIT_L(n) asm volatile("s_waitcnt lgkmcnt(" #n ")" ::: "memory")
#define PG8_BAR __builtin_amdgcn_s_barrier()
#define PG8_SCHED __builtin_amdgcn_sched_barrier(0)
    Unit cur, nxt; int ui = 0;
    if (!S.next(0, cur)) return;
    f32x4 acc[2][2][4][2];
#pragma unroll
    for (int a = 0; a < 2; ++a)
#pragma unroll
        for (int b = 0; b < 2; ++b)
#pragma unroll
            for (int m = 0; m < 4; ++m)
#pragma unroll
                for (int n = 0; n < 2; ++n) acc[a][b][m][n] = (f32x4){0.f, 0.f, 0.f, 0.f};
    bf16x8 At[4][2], B0[2][2], B1[2][2];
    const char* cA = (const char*)g.A + (size_t)cur.pm * tstepA; const char* cB = (const char*)g.Bt + (size_t)cur.pn * tstepB;
    S.a_ready(cur);
    if constexpr (SP2) {
        PG8_STAGE(PG8_SB(0, 0), cB, voffB); PG8_STAGE(PG8_SB(0, 1), cB + hstepB, voffB); PG8_STAGE(PG8_SA(0, 0), cA, voffA); PG8_STAGE(PG8_SA(0, 1), cA + hstepA, voffA);
        if (wr == 1) PG8_BAR;
        PG8_WAIT_V(2); PG8_BAR;
        PG8_STAGE(PG8_SB(1, 0), cB + kstep, voffB); PG8_STAGE(PG8_SA(1, 0), cA + kstep, voffA); PG8_STAGE(PG8_SB(1, 1), cB + hstepB + kstep, voffB);
        PG8_WAIT_V(6); PG8_BAR;
    } else {
        PG8_STAGE(PG8_SB(0, 0), cB, voffB); PG8_STAGE(PG8_SA(0, 0), cA, voffA); PG8_STAGE(PG8_SB(0, 1), cB + hstepB, voffB); PG8_STAGE(PG8_SA(0, 1), cA + hstepA, voffA);
        if (wr == 1) PG8_BAR;
        PG8_WAIT_V(4); PG8_BAR;
        PG8_STAGE(PG8_SB(1, 0), cB + kstep, voffB); PG8_STAGE(PG8_SA(1, 0), cA + kstep, voffA); PG8_STAGE(PG8_SB(1, 1), cB + hstepB + kstep, voffB);
        PG8_WAIT_V(6); PG8_BAR;
    }
    for (;;) {
        const bool has_next = S.next(ui + 1, nxt);
        const char* nA = has_next ? (const char*)g.A + (size_t)nxt.pm * tstepA : cA; const char* nB = has_next ? (const char*)g.Bt + (size_t)nxt.pn * tstepB : cB;
        for (int t = 0; t < nt; t += 2) {
            const bool last = (t == nt - 2);
            const char* a1 = cA + (size_t)(t + 1) * kstep;
            const char* a2 = last ? nA : cA + (size_t)(t + 2) * kstep; const char* b2 = last ? nB : cB + (size_t)(t + 2) * kstep;
            const char* a3 = a2 + kstep; const char* b3 = b2 + kstep;
            if (last && has_next) S.a_ready(nxt);
            if constexpr (SP2) {
            PG8_LDB(B0, 0, 0); PG8_LDB(B1, 0, 1); PG8_SCHED; PG8_LDA(At, 0, 0); PG8_STAGE(PG8_SA(1, 1), a1 + hstepA, voffA);
            PG8_WAIT_V(8); PG8_WAIT_L(0); PG8_BAR; PG8_MMA(0, 0, At, B0); PG8_MMA(0, 1, At, B1); PG8_BAR; PG8_SCHED;
            PG8_LDA(At, 0, 1); PG8_STAGE(PG8_SB(0, 0), b2, voffB); PG8_STAGE(PG8_SB(0, 1), b2 + hstepB, voffB); PG8_STAGE(PG8_SA(0, 0), a2, voffA);
            PG8_WAIT_V(8); PG8_WAIT_L(0); PG8_BAR; PG8_MMA(1, 0, At, B0); PG8_MMA(1, 1, At, B1); PG8_BAR; PG8_SCHED;
            PG8_LDB(B0, 1, 0); PG8_LDB(B1, 1, 1); PG8_SCHED; PG8_LDA(At, 1, 0); PG8_STAGE(PG8_SA(0, 1), a2 + hstepA, voffA);
            PG8_WAIT_V(8); PG8_WAIT_L(0); PG8_BAR; PG8_MMA(0, 0, At, B0); PG8_MMA(0, 1, At, B1); PG8_BAR; PG8_SCHED;
            PG8_LDA(At, 1, 1); PG8_STAGE(PG8_SB(1, 0), b3, voffB); PG8_STAGE(PG8_SB(1, 1), b3 + hstepB, voffB); PG8_STAGE(PG8_SA(1, 0), a3, voffA);
            PG8_WAIT_V(8); PG8_WAIT_L(0); PG8_BAR; PG8_MMA(1, 0, At, B0); PG8_MMA(1, 1, At, B1); PG8_BAR; PG8_SCHED;
            } else {
            PG8_LDB(B0, 0, 0); PG8_SCHED; PG8_LDA(At, 0, 0); PG8_STAGE(PG8_SA(1, 1), a1 + hstepA, voffA);
            PG8_WAIT_L(8); PG8_BAR; PG8_WAIT_L(0); PG8_MMA(0, 0, At, B0); PG8_BAR; PG8_SCHED;
            PG8_LDB(B1, 0, 1); PG8_STAGE(PG8_SB(0, 0), b2, voffB);
            PG8_BAR; PG8_WAIT_L(0); PG8_MMA(0, 1, At, B1); PG8_BAR;
            PG8_LDA(At, 0, 1); PG8_STAGE(PG8_SA(0, 0), a2, voffA);
            PG8_BAR; PG8_WAIT_L(0); PG8_MMA(1, 0, At, B0); PG8_BAR; PG8_SCHED;
            PG8_STAGE(PG8_SB(0, 1), b2 + hstepB, voffB);
            PG8_WAIT_V(6); PG8_BAR; PG8_MMA(1, 1, At, B1); PG8_BAR;
            PG8_LDB(B0, 1, 0); PG8_SCHED; PG8_LDA(At, 1, 0); PG8_STAGE(PG8_SA(0, 1), a2 + hstepA, voffA);
            PG8_WAIT_L(8); PG8_BAR; PG8_WAIT_L(0); PG8_MMA(0, 0, At, B0); PG8_BAR; PG8_SCHED;
            PG8_LDB(B1, 1, 1); PG8_STAGE(PG8_SB(1, 0), b3, voffB);
            PG8_BAR; PG8_WAIT_L(0); PG8_MMA(0, 1, At, B1); PG8_BAR;
            PG8_LDA(At, 1, 1); PG8_STAGE(PG8_SA(1, 0), a3, voffA);
            PG8_BAR; PG8_WAIT_L(0); PG8_MMA(1, 0, At, B0); PG8_BAR; PG8_SCHED;
            PG8_STAGE(PG8_SB(1, 1), b3 + hstepB, voffB);
            PG8_WAIT_V(6); PG8_BAR; PG8_MMA(1, 1, At, B1); PG8_BAR;
            }
        }
        if constexpr (ALIGN_EPI) { if (wr == 0) PG8_BAR; }
        if constexpr (!Epi::AFTER_DRAIN) { E(acc, cur, wr, wc, fr, fq); S.done(cur); }
        if (!has_next) break;
#pragma unroll
        for (int a = 0; a < 2; ++a)
#pragma unroll
            for (int b = 0; b < 2; ++b)
#pragma unroll
                for (int m = 0; m < 4; ++m)
#pragma unroll
                    for (int n = 0; n < 2; ++n) acc[a][b][m][n] = (f32x4){0.f, 0.f, 0.f, 0.f};
        cur = nxt; cA = nA; cB = nB; ++ui;
        if constexpr (ALIGN_EPI) { if (wr == 1) PG8_BAR; }
    }
    PG8_WAIT_V(0);
    if constexpr (!ALIGN_EPI) { if (wr == 0) PG8_BAR; }
    PG8_BAR;
    if constexpr (Epi::AFTER_DRAIN) { E.fused(acc, cur, wr, wc, fr, fq, lds, wid, lane); S.done(cur); }
#undef PG8_SA
#undef PG8_SB
#undef PG8_STAGE
#undef PG8_LDA
#undef PG8_LDB
#undef PG8_MMA
#undef PG8_WAIT_V
#undef PG8_WAIT_L
#undef PG8_BAR
#undef PG8_SCHED
}
}
using pg8::bf16_t; using pg8::bf16x8; using pg8::f32x4; using pg8::u32x4;
typedef float f32x16 __attribute__((ext_vector_type(16)));
typedef unsigned long long u64;

constexpr int DM = 2048, TP = 16384, TS = 512, TT = TP + TS, NBATCH = 9, MODW = 6 * DM;
constexpr int NP = 7424;
constexpr int C_AQ = 0, C_IQ = 1024, C_AK = 2048, C_AV = 3072, C_GQ = 4096, C_GK = 4608, C_GV = 5120, C_GR = 6144, C_IK = 7168, C_IW = 7232, C_GLR = 7248, C_END = 7264;
constexpr int DFF = 5632, NUP = 11264, WIN_N = 7264;
constexpr int NCH = 264;
constexpr float EPS = 1e-6f;
constexpr size_t O_Y = 0, O_KP = 34603008, O_VP = 51380224, O_IKP = 68157440, O_GSP = 69206016, O_FCP = 69337088,
                 O_KS = 69359616, O_VS = 69883904, O_IKS = 70408192, O_GSS = 70440960, O_FCS = 71489536, O_TOTAL = 71669760;
constexpr size_t MiB = 1u << 20;
constexpr size_t WS_CTL = 0, WS_MOD = 1 * MiB, WS_D = 2 * MiB, WS_WIN = 4 * MiB, WS_WOUT = 33 * MiB, WS_WUP = 41 * MiB, WS_WDN = 85 * MiB,
                 WS_ACT = 107 * MiB, WS_P = 173 * MiB, WS_CK = 413 * MiB, WS_CV = 429 * MiB, WS_CIK = 445 * MiB, WS_KV8 = 446 * MiB, WS_CKV8 = 479 * MiB, WS_END = 495 * MiB;
constexpr size_t WS_BC = WS_WUP;
constexpr size_t WS_IKC = WS_CK;
constexpr size_t WS_UF = WS_CK, WS_UH = WS_CK + 12 * MiB;
constexpr int LDS_BYTES = 149568;
constexpr int NPHASE = 11;
constexpr int IDX_ITEMS = 5184;

struct Args { const float* in[24]; float* out; unsigned char* ws; int ph_lo, ph_hi; };

__device__ __forceinline__ unsigned f2bf(float f) { unsigned u = __builtin_bit_cast(unsigned, f); return (u + 0x7fffu + ((u >> 16) & 1u)) >> 16; }
typedef float f32x2v __attribute__((ext_vector_type(2))); typedef __bf16 bf16x2v __attribute__((ext_vector_type(2)));
__device__ __forceinline__ unsigned pk2(float lo, float hi) { const f32x2v v = {lo, hi}; const bf16x2v b = __builtin_convertvector(v, bf16x2v); return __builtin_bit_cast(unsigned, b); }
__device__ __forceinline__ float bflo(unsigned w) { return __builtin_bit_cast(float, w << 16); }
__device__ __forceinline__ float bfhi(unsigned w) { return __builtin_bit_cast(float, w & 0xffff0000u); }
__device__ __forceinline__ float bf1(bf16_t h) { return __builtin_bit_cast(float, ((unsigned)h) << 16); }
__device__ __forceinline__ void unpack8(u32x4 w, float* v) { v[0] = bflo(w.x); v[1] = bfhi(w.x); v[2] = bflo(w.y); v[3] = bfhi(w.y); v[4] = bflo(w.z); v[5] = bfhi(w.z); v[6] = bflo(w.w); v[7] = bfhi(w.w); }
__device__ __forceinline__ u32x4 pack8(const float* v) { u32x4 w; w.x = pk2(v[0], v[1]); w.y = pk2(v[2], v[3]); w.z = pk2(v[4], v[5]); w.w = pk2(v[6], v[7]); return w; }
__device__ __forceinline__ float wave_sum(float v) {
#pragma unroll
    for (int o = 1; o < 64; o <<= 1) v += __shfl_xor(v, o);
    return v;
}
__device__ __forceinline__ float siluf(float x) { return x * __builtin_amdgcn_rcpf(1.f + __expf(-x)); }
typedef float f32x2 __attribute__((ext_vector_type(2)));
__device__ __forceinline__ unsigned pk4_fp8(float a, float b, float c, float d) { int w = 0; w = __builtin_amdgcn_cvt_pk_fp8_f32(a, b, w, false); w = __builtin_amdgcn_cvt_pk_fp8_f32(c, d, w, true); return (unsigned)w; }
__device__ __forceinline__ u32x4 pack16_fp8(const float* v) { u32x4 w; w.x = pk4_fp8(v[0], v[1], v[2], v[3]); w.y = pk4_fp8(v[4], v[5], v[6], v[7]); w.z = pk4_fp8(v[8], v[9], v[10], v[11]); w.w = pk4_fp8(v[12], v[13], v[14], v[15]); return w; }
__device__ __forceinline__ void unpack16_fp8(u32x4 w, float* v) {
#pragma unroll
    for (int i = 0; i < 4; ++i) { const f32x2 lo = __builtin_amdgcn_cvt_pk_f32_fp8((int)w[i], false), hi = __builtin_amdgcn_cvt_pk_f32_fp8((int)w[i], true); v[4 * i] = lo.x; v[4 * i + 1] = lo.y; v[4 * i + 2] = hi.x; v[4 * i + 3] = hi.y; }
}

template <int MAPID> __device__ __forceinline__ int colmap(int n) {
    if (MAPID == 0) return n;
    if (MAPID == 1) {
        if (n < 1024) return n;
        if (n < 2048) return 3072 + (n - 1024);
        if (n < 3072) return 1024 + (n - 2048);
        if (n < 4096) return 2048 + (n - 3072);
        if (n < 4608) return 4176 + (n - 4096);
        if (n < 5120) return 4688 + (n - 4608);
        if (n < 6144) return 5200 + (n - 5120);
        if (n < 7168) return 6224 + (n - 6144);
        if (n < 7232) return 4096 + (n - 7168);
        if (n < 7248) return 4160 + (n - 7232);
        if (n < 7264) return n;
        return -1;
    }
    { const int pn = n >> 8, w = n & 255; return w < 128 ? pn * 128 + w : DFF + pn * 128 + (w - 128); }
}
template <int MAPID> __device__ __forceinline__ void transpose_item(const float* __restrict__ W, int K, int Nsrc, bf16_t* __restrict__ WT, int nblk, float* scr, int item, int lane) {
    const int kb = item / nblk, nb = item % nblk, k0 = 64 * kb, n0 = 32 * nb;
    const int srcc = colmap<MAPID>(n0 + (lane & 31));
#pragma unroll 8
    for (int i = 0; i < 32; ++i) { const int kk = 2 * i + (lane >> 5); scr[kk * 33 + (lane & 31)] = srcc >= 0 ? __builtin_nontemporal_load(W + (size_t)(k0 + kk) * Nsrc + srcc) : 0.f; }
    asm volatile("s_waitcnt lgkmcnt(0)" ::: "memory");
    const int c = lane & 7;
#pragma unroll
    for (int j = 0; j < 4; ++j) { const int n = (lane >> 3) + 8 * j; const float* s = scr + (8 * c) * 33 + n;
        u32x4 o; o.x = pk2(s[0 * 33], s[1 * 33]); o.y = pk2(s[2 * 33], s[3 * 33]); o.z = pk2(s[4 * 33], s[5 * 33]); o.w = pk2(s[6 * 33], s[7 * 33]);
        *(u32x4*)(WT + (size_t)(n0 + n) * K + k0 + 8 * c) = o; }
    asm volatile("s_waitcnt lgkmcnt(0)" ::: "memory");
}

__device__ __forceinline__ void phase0(const Args& a, unsigned char* lds, int tid, int lane, int wave) {
    unsigned char* ws = a.ws;
    if ((int)blockIdx.x < 192 || gridDim.x < 192) {
        float* sc = (float*)lds;
        float* red = (float*)(lds + 73728);
        for (int i = tid; i < NBATCH * DM; i += 512) { const int b = i >> 11, k = i & 2047; const float c = b == 0 ? a.in[2][k] : a.in[3][(b - 1) * DM + k]; sc[i] = c / (1.f + __expf(-c)); }
        __syncthreads();
        for (int item = blockIdx.x; item < 192; item += gridDim.x) {
            const int col = item * 64 + lane, k0 = wave * 256;
            float acc[NBATCH];
#pragma unroll
            for (int b = 0; b < NBATCH; ++b) acc[b] = 0.f;
            const float* wp = a.in[9] + (size_t)k0 * MODW + col;
            for (int k = 0; k < 256; k += 32) {
                float wv[32];
#pragma unroll
                for (int i = 0; i < 32; ++i) wv[i] = __builtin_nontemporal_load(wp + (size_t)(k + i) * MODW);
#pragma unroll
                for (int i = 0; i < 32; ++i)
#pragma unroll
                    for (int b = 0; b < NBATCH; ++b) acc[b] += sc[b * DM + k0 + k + i] * wv[i]; }
#pragma unroll
            for (int b = 0; b < NBATCH; ++b) red[(wave * NBATCH + b) * 64 + lane] = acc[b];
            __syncthreads();
            for (int i = tid; i < NBATCH * 64; i += 512) { const int b = i >> 6, l = i & 63; float s = a.in[10][item * 64 + l];
#pragma unroll
                for (int w = 0; w < 8; ++w) s += red[(w * NBATCH + b) * 64 + l];
                ((float*)(ws + WS_MOD))[b * MODW + item * 64 + l] = s; }
            __syncthreads();
        }
    }
    __syncthreads();
    {
        float* scr = (float*)(lds + wave * 8448);
        const int gw = blockIdx.x * 8 + wave, NGW = gridDim.x * 8;
        constexpr int I_IN = 32 * (NP / 32);
        for (int it = gw; it < I_IN; it += NGW) transpose_item<1>(a.in[13], DM, WIN_N, (bf16_t*)(ws + WS_WIN), NP / 32, scr, it, lane);
    }
    {
        const size_t gt = (size_t)blockIdx.x * 512 + tid, GT = (size_t)gridDim.x * 512;
        for (size_t i = gt; i < 8388608 / 16; i += GT) {
            const size_t row = i >> 6, chk = i & 63; float v[16];
            const f32x4* s = (const f32x4*)(a.in[4] + row * 1024 + chk * 16);
#pragma unroll
            for (int j = 0; j < 4; ++j) { const f32x4 x = __builtin_nontemporal_load(s + j); v[4 * j] = x.x; v[4 * j + 1] = x.y; v[4 * j + 2] = x.z; v[4 * j + 3] = x.w; }
            *(u32x4*)(ws + WS_CKV8 + row * 2048 + chk * 16) = pack16_fp8(v);
            s = (const f32x4*)(a.in[5] + row * 1024 + chk * 16);
#pragma unroll
            for (int j = 0; j < 4; ++j) { const f32x4 x = __builtin_nontemporal_load(s + j); v[4 * j] = x.x; v[4 * j + 1] = x.y; v[4 * j + 2] = x.z; v[4 * j + 3] = x.w; }
            *(u32x4*)(ws + WS_CKV8 + row * 2048 + 1024 + chk * 16) = pack16_fp8(v); }
        for (size_t i = gt; i < 524288 / 8; i += GT) {
            const f32x4* s = (const f32x4*)a.in[6] + 2 * i; f32x4 x = s[0], y = s[1]; u32x4 o; o.x = pk2(x.x, x.y); o.y = pk2(x.z, x.w); o.z = pk2(y.x, y.y); o.w = pk2(y.z, y.w); ((u32x4*)(ws + WS_CIK))[i] = o; }
    }
}

__device__ __forceinline__ bool gemm_tail_rank(int nwg, int& rank, int& count) {
    const int G = gridDim.x, c = blockIdx.x, rounds = (nwg + G - 1) / G, nbusy = nwg - (rounds - 1) * G;
    rank = c - nbusy; count = G - nbusy; return c >= nbusy;
}
__device__ __forceinline__ void tail_wout(const Args& a, unsigned char* lds, int rank, int count, int lane, int wave) {
    float* scr = (float*)(lds + wave * 8448);
    for (int it = rank * 8 + wave; it < 32 * 64; it += count * 8) transpose_item<0>(a.in[19], DM, DM, (bf16_t*)(a.ws + WS_WOUT), 64, scr, it, lane);
}
__device__ __forceinline__ void tail_wup_wdn(const Args& a, unsigned char* lds, int rank, int count, int lane, int wave) {
    float* scr = (float*)(lds + wave * 8448);
    constexpr int I_UP = 32 * (NUP / 32), I_DN = (DFF / 64) * 64;
    for (int it = rank * 8 + wave; it < I_UP + I_DN; it += count * 8) {
        if (it < I_UP) transpose_item<2>(a.in[20], DM, NUP, (bf16_t*)(a.ws + WS_WUP), NUP / 32, scr, it, lane);
        else transpose_item<0>(a.in[23], DFF, DM, (bf16_t*)(a.ws + WS_WDN), 64, scr, it - I_UP, lane);
    }
}

__device__ __forceinline__ void normmod_phase(const float* xp, const float* xs, const float* g, const float* mod, int sh_off, int sc_off, bf16_t* dst, int lane, int wave) {
    const int gw = blockIdx.x * 8 + wave, NGW = gridDim.x * 8;
    for (int r = gw; r < TT; r += NGW) {
        const float* xrow = r < TP ? xp + (size_t)r * DM : xs + (size_t)(r - TP) * DM;
        const int b = r < TP ? 0 : 1 + ((r - TP) >> 6);
        const f32x4* xr = (const f32x4*)xrow + lane;
        f32x4 v[8]; float s = 0.f;
#pragma unroll
        for (int j = 0; j < 8; ++j) { v[j] = __builtin_nontemporal_load(xr + 64 * j); s += (v[j].x * v[j].x + v[j].y * v[j].y) + (v[j].z * v[j].z + v[j].w * v[j].w); }
        const float rstd = rsqrtf(wave_sum(s) * (1.f / DM) + EPS);
        const f32x4* gp = (const f32x4*)g + lane; const f32x4* scp = (const f32x4*)(mod + (size_t)b * MODW + sc_off) + lane; const f32x4* shp = (const f32x4*)(mod + (size_t)b * MODW + sh_off) + lane;
        u64* o8 = (u64*)(dst + (size_t)r * DM) + lane;
#pragma unroll
        for (int j = 0; j < 8; ++j) { const f32x4 gg = gp[64 * j], sc = scp[64 * j], sh = shp[64 * j];
            const f32x4 y = v[j] * rstd * gg * (sc + 1.f) + sh;
            o8[64 * j] = (u64)pk2(y.x, y.y) | ((u64)pk2(y.z, y.w) << 32); }
    }
}

struct EpiP {
    static constexpr bool PERM = true, AFTER_DRAIN = false;
    bf16_t* O; int ldc;
    __device__ __forceinline__ void operator()(const f32x4 (&acc)[2][2][4][2], const pg8::Unit& u, int wr, int wc, int fr, int fq) const {
        const int row0 = u.pm * 256 + wr * 64 + fr, col0 = u.pn * 256 + wc * 32 + 8 * fq;
#pragma unroll
        for (int ai = 0; ai < 2; ++ai)
#pragma unroll
            for (int m = 0; m < 4; ++m) { bf16_t* rowp = O + (size_t)(row0 + ai * 128 + m * 16) * ldc + col0;
#pragma unroll
                for (int bj = 0; bj < 2; ++bj) { const f32x4 v0 = acc[ai][bj][m][0], v1 = acc[ai][bj][m][1]; u32x4 w;
                    w.x = pg8::cvt_pk_bf16(v0[0], v0[1]); w.y = pg8::cvt_pk_bf16(v0[2], v0[3]); w.z = pg8::cvt_pk_bf16(v1[0], v1[1]); w.w = pg8::cvt_pk_bf16(v1[2], v1[3]);
                    *(u32x4*)(rowp + bj * 128) = w; } }
    }
};
struct EpiRes {
    static constexpr bool PERM = true, AFTER_DRAIN = false;
    const float* srcP; const float* srcS; float* dst; const float* gate;
    __device__ __forceinline__ void operator()(const f32x4 (&acc)[2][2][4][2], const pg8::Unit& u, int wr, int wc, int fr, int fq) const {
        const int col0 = u.pn * 256 + wc * 32 + 8 * fq;
#pragma unroll
        for (int ai = 0; ai < 2; ++ai)
#pragma unroll
            for (int m = 0; m < 4; ++m) {
                const int row = u.pm * 256 + ai * 128 + wr * 64 + m * 16 + fr;
                const int b = row < TP ? 0 : 1 + ((row - TP) >> 6);
                const float* sp = (row < TP ? srcP + (size_t)row * DM : srcS + (size_t)(row - TP) * DM) + col0;
                const float* gp = gate + (size_t)b * MODW + col0; float* dp = dst + (size_t)row * DM + col0;
#pragma unroll
                for (int bj = 0; bj < 2; ++bj)
#pragma unroll
                    for (int n = 0; n < 2; ++n) { const f32x4 x = *(const f32x4*)(sp + bj * 128 + 4 * n), gg = *(const f32x4*)(gp + bj * 128 + 4 * n);
                        *(f32x4*)(dp + bj * 128 + 4 * n) = x + gg * acc[ai][bj][m][n]; }
            }
    }
};
template <int CTRL> __device__ __forceinline__ float dpp_ror(float v) {
    return __builtin_bit_cast(float, __builtin_amdgcn_update_dpp(0, __builtin_bit_cast(int, v), CTRL, 0xf, 0xf, false));
}
struct EpiUp {
    static constexpr bool PERM = true, AFTER_DRAIN = false;
    bf16_t* ACTF; bf16_t* Uf; bf16_t* Uh; const float* wconv; const float* bconv;
    __device__ __forceinline__ void operator()(const f32x4 (&acc)[2][2][4][2], const pg8::Unit& u, int wr, int wc, int fr, int fq) const {
        const int lane = fr + 16 * fq;
        const int ch0 = u.pn * 128 + wc * 32 + 8 * fq;
        const int src1 = (lane & 48) | ((fr + 15) & 15), src2 = (lane & 48) | ((fr + 14) & 15);
        unsigned outp[2][4][4];
#pragma unroll
        for (int cp = 0; cp < 4; ++cp) {
            const int chp = ch0 + 2 * cp;
            const f32x2 wa0 = *(const f32x2*)(wconv + chp), wa1 = *(const f32x2*)(wconv + NUP + chp), wa2 = *(const f32x2*)(wconv + 2 * NUP + chp), ba = *(const f32x2*)(bconv + chp);
            const f32x2 wb0 = *(const f32x2*)(wconv + DFF + chp), wb1 = *(const f32x2*)(wconv + NUP + DFF + chp), wb2 = *(const f32x2*)(wconv + 2 * NUP + DFF + chp), bb = *(const f32x2*)(bconv + DFF + chp);
#pragma unroll
            for (int ai = 0; ai < 2; ++ai) {
                float rr[4][2];
#pragma unroll
                for (int ii = 0; ii < 2; ++ii) {
                    const int c8 = 2 * cp + ii, n = c8 >> 2, i = c8 & 3;
                    float ua[4], ub[4], r1a[4], r2a[4], r1b[4], r2b[4];
#pragma unroll
                    for (int m = 0; m < 4; ++m) { ua[m] = acc[ai][0][m][n][i]; ub[m] = acc[ai][1][m][n][i];
                        r1a[m] = dpp_ror<0x121>(ua[m]); r2a[m] = dpp_ror<0x122>(ua[m]); r1b[m] = dpp_ror<0x121>(ub[m]); r2b[m] = dpp_ror<0x122>(ub[m]); }
#pragma unroll
                    for (int m = 0; m < 4; ++m) {
                        const float p1a = fr >= 1 ? r1a[m] : r1a[(m + 3) & 3], p2a = fr >= 2 ? r2a[m] : r2a[(m + 3) & 3];
                        const float p1b = fr >= 1 ? r1b[m] : r1b[(m + 3) & 3], p2b = fr >= 2 ? r2b[m] : r2b[(m + 3) & 3];
                        const float ca = ba[ii] + wa2[ii] * ua[m] + wa1[ii] * p1a + wa0[ii] * p2a;
                        const float cb = bb[ii] + wb2[ii] * ub[m] + wb1[ii] * p1b + wb0[ii] * p2b;
                        rr[m][ii] = siluf(ca) * cb;
                    }
                }
#pragma unroll
                for (int m = 0; m < 4; ++m) outp[ai][m][cp] = pg8::cvt_pk_bf16(rr[m][0], rr[m][1]);
            }
        }
#pragma unroll
        for (int ai = 0; ai < 2; ++ai) {
            const int g = u.pm * 4 + ai * 2 + wr;
#pragma unroll
            for (int m = 0; m < 4; ++m) { const int row = g * 64 + 16 * m + fr;
                u32x4 w; w.x = outp[ai][m][0]; w.y = outp[ai][m][1]; w.z = outp[ai][m][2]; w.w = outp[ai][m][3];
                *(u32x4*)(ACTF + (size_t)row * DFF + ch0) = w; }
            if (fr < 2) { bf16_t* p = Uf + (size_t)(g * 2 + fr) * NUP + ch0;
#pragma unroll
                for (int bj = 0; bj < 2; ++bj) { const f32x4 v0 = acc[ai][bj][0][0], v1 = acc[ai][bj][0][1]; u32x4 w;
                    w.x = pg8::cvt_pk_bf16(v0[0], v0[1]); w.y = pg8::cvt_pk_bf16(v0[2], v0[3]); w.z = pg8::cvt_pk_bf16(v1[0], v1[1]); w.w = pg8::cvt_pk_bf16(v1[2], v1[3]);
                    *(u32x4*)(p + bj * DFF) = w; } }
            if (fr >= 14) { bf16_t* p = Uh + (size_t)(g * 2 + fr - 14) * NUP + ch0;
#pragma unroll
                for (int bj = 0; bj < 2; ++bj) { const f32x4 v0 = acc[ai][bj][3][0], v1 = acc[ai][bj][3][1]; u32x4 w;
                    w.x = pg8::cvt_pk_bf16(v0[0], v0[1]); w.y = pg8::cvt_pk_bf16(v0[2], v0[3]); w.z = pg8::cvt_pk_bf16(v1[0], v1[1]); w.w = pg8::cvt_pk_bf16(v1[2], v1[3]);
                    *(u32x4*)(p + bj * DFF) = w; } }
        }
    }
};

__device__ __forceinline__ void post_rows(const Args& a, unsigned char* lds, int tid, int lane, int wave) {
    double* inv16 = (double*)lds; double* inv8 = inv16 + 16;
    if (tid < 16) inv16[tid] = exp(-(double)tid * (1.0 / 16.0) * 13.122363377404328);
    else if (tid < 24) inv8[tid - 16] = exp(-(double)(tid - 16) * (1.0 / 8.0) * 13.122363377404328);
    __syncthreads();
    bf16_t* P = (bf16_t*)(a.ws + WS_P);
    const float* gq = a.in[14]; const float* gk = a.in[15];
    const int sub = lane & 7;
    float gqv[16], gkv[16];
#pragma unroll
    for (int i = 0; i < 16; ++i) { gqv[i] = gq[sub * 16 + i]; gkv[i] = gk[sub * 16 + i]; }
    const int gw = blockIdx.x * 8 + wave, NGW = gridDim.x * 8;
    for (int r = gw; r < TT; r += NGW) {
        bf16_t* prow = P + (size_t)r * NP;
        const int pos = r < TP ? r : 1024 + ((r - TP) & 63);
        float* kout = r < TP ? a.out + O_KP + (size_t)r * 1024 : a.out + O_KS + (size_t)(r - TP) * 1024;
        float* vout = r < TP ? a.out + O_VP + (size_t)r * 1024 : a.out + O_VS + (size_t)(r - TP) * 1024;
        float* ikout = r < TP ? a.out + O_IKP + (size_t)r * 64 : a.out + O_IKS + (size_t)(r - TP) * 64;
        float cs[16], sn[16];
#pragma unroll
        for (int i = 0; i < 16; ++i) { double rev = (double)pos * inv16[i] * 0.15915494309189535; rev -= rint(rev); const float rf = (float)rev; cs[i] = __builtin_amdgcn_cosf(rf); sn[i] = __builtin_amdgcn_sinf(rf); }
#pragma unroll
        for (int which = 0; which < 2; ++which) {
            bf16_t* p = prow + (which ? C_AK : C_AQ) + lane * 16;
            float v[16]; unpack8(*(const u32x4*)p, v); unpack8(*(const u32x4*)(p + 8), v + 8);
            float ss = 0.f;
#pragma unroll
            for (int i = 0; i < 16; ++i) ss += v[i] * v[i];
            ss += __shfl_xor(ss, 1); ss += __shfl_xor(ss, 2); ss += __shfl_xor(ss, 4);
            const float rstd = rsqrtf(ss * (1.f / 128.f) + EPS);
#pragma unroll
            for (int i = 0; i < 16; ++i) v[i] = v[i] * rstd * (which ? gkv[i] : gqv[i]);
#pragma unroll
            for (int i = 0; i < 16; ++i) { const float pv = __shfl_xor(v[i], 1);
                if (sub == 0) v[i] = v[i] * cs[i] - pv * sn[i]; else if (sub == 1) v[i] = v[i] * cs[i] + pv * sn[i]; }
            if (which) {
#pragma unroll
                for (int i = 0; i < 4; ++i) __builtin_nontemporal_store((f32x4){v[4 * i], v[4 * i + 1], v[4 * i + 2], v[4 * i + 3]}, (f32x4*)(kout + lane * 16 + 4 * i));
                *(u32x4*)(a.ws + WS_KV8 + (size_t)r * 2048 + lane * 16) = pack16_fp8(v);
            } else {
#pragma unroll
                for (int i = 0; i < 16; ++i) v[i] *= 0.12751743074602468f;
            }
            *(u32x4*)p = pack8(v); *(u32x4*)(p + 8) = pack8(v + 8);
        }
        {
            const bf16_t* p = prow + C_AV + lane * 16; float v[16]; unpack8(*(const u32x4*)p, v); unpack8(*(const u32x4*)(p + 8), v + 8);
#pragma unroll
            for (int i = 0; i < 4; ++i) __builtin_nontemporal_store((f32x4){v[4 * i], v[4 * i + 1], v[4 * i + 2], v[4 * i + 3]}, (f32x4*)(vout + lane * 16 + 4 * i));
            *(u32x4*)(a.ws + WS_KV8 + (size_t)r * 2048 + 1024 + lane * 16) = pack16_fp8(v);
        }
        float c8[8], s8[8];
#pragma unroll
        for (int i = 0; i < 8; ++i) { double rev = (double)pos * inv8[i] * 0.15915494309189535; rev -= rint(rev); const float rf = (float)rev; c8[i] = __builtin_amdgcn_cosf(rf); s8[i] = __builtin_amdgcn_sinf(rf); }
        {
            bf16_t* p = prow + C_IQ + lane * 16; float v[16]; unpack8(*(const u32x4*)p, v); unpack8(*(const u32x4*)(p + 8), v + 8);
            if ((lane & 3) == 0) {
#pragma unroll
                for (int i = 0; i < 8; ++i) { const float x1 = v[i], x2 = v[i + 8]; v[i] = x1 * c8[i] - x2 * s8[i]; v[i + 8] = x2 * c8[i] + x1 * s8[i]; }
                *(u32x4*)p = pack8(v); *(u32x4*)(p + 8) = pack8(v + 8);
            }
        }
        if (lane < 4) {
            bf16_t* p = prow + C_IK + lane * 16; float v[16]; unpack8(*(const u32x4*)p, v); unpack8(*(const u32x4*)(p + 8), v + 8);
            if (lane == 0) {
#pragma unroll
                for (int i = 0; i < 8; ++i) { const float x1 = v[i], x2 = v[i + 8]; v[i] = x1 * c8[i] - x2 * s8[i]; v[i + 8] = x2 * c8[i] + x1 * s8[i]; }
                *(u32x4*)p = pack8(v); *(u32x4*)(p + 8) = pack8(v + 8);
            }
            { bf16_t* pc = (bf16_t*)(a.ws + WS_IKC) + (size_t)r * 64 + lane * 16; *(u32x4*)pc = pack8(v); *(u32x4*)(pc + 8) = pack8(v + 8); }
#pragma unroll
            for (int i = 0; i < 4; ++i) __builtin_nontemporal_store((f32x4){v[4 * i], v[4 * i + 1], v[4 * i + 2], v[4 * i + 3]}, (f32x4*)(ikout + lane * 16 + 4 * i));
        }
    }
    __syncthreads();
}

__device__ __forceinline__ f32x4 mfma16(bf16x8 a, bf16x8 b, f32x4 c) { return __builtin_amdgcn_mfma_f32_16x16x32_bf16(a, b, c, 0, 0, 0); }
constexpr int L_GLR = 0, L_BC = 4096, L_TOT = 36864, L_A = 38912;
__device__ __forceinline__ int tsw(int row) { return ((row >> 3) & 7) << 3; }
__device__ __forceinline__ void gla_bcum(const Args& a, unsigned char* lds, int n, int h, int tid) {
    const bf16_t* P = (const bf16_t*)(a.ws + WS_P);
    float* glr = (float*)(lds + L_GLR); float* bc = (float*)(lds + L_BC); float* tot = (float*)(lds + L_TOT);
    for (int e = tid; e < 1024; e += 512) { const int t = e >> 4, rr = e & 15; glr[e] = bf1(P[(size_t)(n * 64 + t) * NP + C_GLR + rr]); }
    __syncthreads();
    const int dk = tid & 127, tq = tid >> 7;
    float w[16];
#pragma unroll
    for (int rr = 0; rr < 16; ++rr) w[rr] = a.in[16][rr * 512 + h * 128 + dk];
    const float bias = a.in[17][h * 128 + dk];
    float run = 0.f;
#pragma unroll 4
    for (int tt = 0; tt < 16; ++tt) { const int t = tq * 16 + tt; float x = bias;
#pragma unroll
        for (int rr = 0; rr < 16; ++rr) x += glr[t * 16 + rr] * w[rr];
        const float ls = fminf(x, 0.f) - log1pf(__expf(-fabsf(x)));
        run += ls * (1.f / 16.f); bc[t * 128 + dk] = run; }
    tot[tq * 128 + dk] = run;
    __syncthreads();
    float off = 0.f;
    for (int g = 0; g < tq; ++g) off += tot[g * 128 + dk];
    if (tq > 0) { for (int tt = 0; tt < 16; ++tt) bc[(tq * 16 + tt) * 128 + dk] += off; }
    __syncthreads();
}
__device__ __forceinline__ void gla_g1(const Args& a, unsigned char* lds, int tid, int lane, int wave) {
    const bf16_t* P = (const bf16_t*)(a.ws + WS_P);
    float* Dd = (float*)(a.ws + WS_D);
    const float* bc = (const float*)(lds + L_BC);
    bf16_t* KT = (bf16_t*)(lds + L_A);
    bf16_t* VT = (bf16_t*)(lds + L_A + 18432);
    for (int it = blockIdx.x; it < NCH * 4; it += gridDim.x) {
        const int n = it >> 2, h = it & 3;
        gla_bcum(a, lds, n, h, tid);
        { f32x4* bcg = (f32x4*)(a.ws + WS_BC) + (size_t)it * 2048;
#pragma unroll
          for (int i = 0; i < 4; ++i) bcg[tid + 512 * i] = ((const f32x4*)bc)[tid + 512 * i]; }
        for (int ch = tid; ch < 1024; ch += 512) { const int s = ch >> 4, d0 = (ch & 15) * 8; float v[8]; unpack8(*(const u32x4*)(P + (size_t)(n * 64 + s) * NP + C_GK + h * 128 + d0), v);
#pragma unroll
            for (int i = 0; i < 8; ++i) KT[(d0 + i) * 72 + (s ^ tsw(d0))] = (bf16_t)f2bf(v[i] * __expf(bc[63 * 128 + d0 + i] - bc[s * 128 + d0 + i])); }
        for (int ch = tid; ch < 2048; ch += 512) { const int s = ch >> 5, d0 = (ch & 31) * 8; const u32x4 w = *(const u32x4*)(P + (size_t)(n * 64 + s) * NP + C_GV + h * 256 + d0);
            VT[(d0 + 0) * 72 + (s ^ tsw(d0))] = (bf16_t)(w.x & 0xffff); VT[(d0 + 1) * 72 + (s ^ tsw(d0))] = (bf16_t)(w.x >> 16); VT[(d0 + 2) * 72 + (s ^ tsw(d0))] = (bf16_t)(w.y & 0xffff); VT[(d0 + 3) * 72 + (s ^ tsw(d0))] = (bf16_t)(w.y >> 16);
            VT[(d0 + 4) * 72 + (s ^ tsw(d0))] = (bf16_t)(w.z & 0xffff); VT[(d0 + 5) * 72 + (s ^ tsw(d0))] = (bf16_t)(w.z >> 16); VT[(d0 + 6) * 72 + (s ^ tsw(d0))] = (bf16_t)(w.w & 0xffff); VT[(d0 + 7) * 72 + (s ^ tsw(d0))] = (bf16_t)(w.w >> 16); }
        if (tid < 128) Dd[it * 128 + tid] = __expf(bc[63 * 128 + tid]);
        __syncthreads();
        const int l15 = lane & 15, q = lane >> 4;
        bf16_t* Uo = (bf16_t*)a.out + (size_t)it * 32768;
        {   const int mt = wave;
            const int kr = mt * 16 + l15; const bf16x8 a0 = *(const bf16x8*)(KT + kr * 72 + ((q * 8) ^ tsw(kr))), a1 = *(const bf16x8*)(KT + kr * 72 + ((32 + q * 8) ^ tsw(kr)));
#pragma unroll
            for (int nt = 0; nt < 16; ++nt) {
                const int vr = nt * 16 + l15; const bf16x8 b0 = *(const bf16x8*)(VT + vr * 72 + ((q * 8) ^ tsw(vr))), b1 = *(const bf16x8*)(VT + vr * 72 + ((32 + q * 8) ^ tsw(vr)));
                f32x4 c = {0.f, 0.f, 0.f, 0.f}; c = mfma16(a0, b0, c); c = mfma16(a1, b1, c);
                *(u64*)(Uo + (nt * 16 + l15) * 128 + mt * 16 + q * 4) = (u64)pk2(c[0], c[1]) | ((u64)pk2(c[2], c[3]) << 32);
            } }
        __syncthreads();
    }
}
__device__ __forceinline__ void gla_g2(const Args& a, int tid) {
    unsigned* US2 = (unsigned*)a.out;
    const float* Dd = (const float*)(a.ws + WS_D);
    const size_t gt = (size_t)blockIdx.x * 512 + tid, GT = (size_t)gridDim.x * 512;
    for (size_t e = gt; e < 65536; e += GT) {
        const int h = (int)(e >> 14), rem2 = (int)(e & 16383), dk = (2 * rem2) & 127, dv = (2 * rem2) >> 7;
        float S0 = 0.f, S1 = 0.f;
        for (int n0 = 0; n0 < 256; n0 += 32) {
            unsigned u[32]; f32x2 d[32];
#pragma unroll
            for (int i = 0; i < 32; ++i) { const int it = (n0 + i) * 4 + h; u[i] = US2[(size_t)it * 16384 + rem2]; d[i] = *(const f32x2*)(Dd + it * 128 + dk); }
#pragma unroll
            for (int i = 0; i < 32; ++i) { const int it = (n0 + i) * 4 + h; US2[(size_t)it * 16384 + rem2] = pk2(S0, S1); S0 = d[i].x * S0 + bflo(u[i]); S1 = d[i].y * S1 + bfhi(u[i]); }
        }
        a.out[O_GSP + (size_t)h * 32768 + dk * 256 + dv] = S0; a.out[O_GSP + (size_t)h * 32768 + (dk + 1) * 256 + dv] = S1;
    }
    for (size_t e2 = gt; e2 < 8 * 65536; e2 += GT) {
        const int b = (int)(e2 >> 16), e = (int)(e2 & 65535), h = e >> 14, rem2 = e & 16383, dk = (2 * rem2) & 127, dv = (2 * rem2) >> 7;
        const int it = (256 + b) * 4 + h;
        const size_t so = ((size_t)(b * 4 + h) * 128 + dk) * 256 + dv;
        const float S0 = a.in[7][so], S1 = a.in[7][so + 256]; const unsigned u = US2[(size_t)it * 16384 + rem2];
        US2[(size_t)it * 16384 + rem2] = pk2(S0, S1);
        const f32x2 d = *(const f32x2*)(Dd + it * 128 + dk);
        a.out[O_GSS + so] = d.x * S0 + bflo(u); a.out[O_GSS + so + 256] = d.y * S1 + bfhi(u);
    }
}
__device__ __forceinline__ void gla_g3(const Args& a, unsigned char* lds, int tid, int lane, int wave) {
    bf16_t* P = (bf16_t*)(a.ws + WS_P);
    const float* bc = (const float*)(lds + L_BC);
    bf16_t* Q = (bf16_t*)(lds + L_A);
    bf16_t* Kk = (bf16_t*)(lds + L_A + 17408);
    bf16_t* VT = (bf16_t*)(lds + L_A + 34816);
    bf16_t* ATS = (bf16_t*)(lds + L_A + 71680);
    float* RS = (float*)(lds + L_A + 80896);
    bf16_t* OUTS = (bf16_t*)(lds + L_A);
    const int l15 = lane & 15, q = lane >> 4;
    for (int it = gridDim.x - 1 - blockIdx.x; it < NCH * 4; it += gridDim.x) {
        const int n = it >> 2, h = it & 3;
        { const f32x4* bcg = (const f32x4*)(a.ws + WS_BC) + (size_t)it * 2048; f32x4* bcl = (f32x4*)(lds + L_BC);
#pragma unroll
          for (int i = 0; i < 4; ++i) bcl[tid + 512 * i] = bcg[tid + 512 * i]; }
        __syncthreads();
        for (int ch = tid; ch < 1024; ch += 512) { const int s = ch >> 4, d0 = (ch & 15) * 8; float v[8], o[8];
            unpack8(*(const u32x4*)(P + (size_t)(n * 64 + s) * NP + C_GQ + h * 128 + d0), v);
#pragma unroll
            for (int i = 0; i < 8; ++i) o[i] = v[i] * 0.08838834764831845f * __expf(bc[s * 128 + d0 + i]);
            *(u32x4*)(Q + s * 136 + d0) = pack8(o);
            unpack8(*(const u32x4*)(P + (size_t)(n * 64 + s) * NP + C_GK + h * 128 + d0), v);
#pragma unroll
            for (int i = 0; i < 8; ++i) o[i] = v[i] * __expf(-bc[s * 128 + d0 + i]);
            *(u32x4*)(Kk + s * 136 + d0) = pack8(o); }
        for (int ch = tid; ch < 2048; ch += 512) { const int s = ch >> 5, d0 = (ch & 31) * 8; const u32x4 w = *(const u32x4*)(P + (size_t)(n * 64 + s) * NP + C_GV + h * 256 + d0);
            VT[(d0 + 0) * 72 + (s ^ tsw(d0))] = (bf16_t)(w.x & 0xffff); VT[(d0 + 1) * 72 + (s ^ tsw(d0))] = (bf16_t)(w.x >> 16); VT[(d0 + 2) * 72 + (s ^ tsw(d0))] = (bf16_t)(w.y & 0xffff); VT[(d0 + 3) * 72 + (s ^ tsw(d0))] = (bf16_t)(w.y >> 16);
            VT[(d0 + 4) * 72 + (s ^ tsw(d0))] = (bf16_t)(w.z & 0xffff); VT[(d0 + 5) * 72 + (s ^ tsw(d0))] = (bf16_t)(w.z >> 16); VT[(d0 + 6) * 72 + (s ^ tsw(d0))] = (bf16_t)(w.w & 0xffff); VT[(d0 + 7) * 72 + (s ^ tsw(d0))] = (bf16_t)(w.w >> 16); }
        __syncthreads();
#pragma unroll
        for (int ti = 0; ti < 2; ++ti) { const int id = wave * 2 + ti, mt = id >> 2, nt = id & 3;
            f32x4 c = {0.f, 0.f, 0.f, 0.f};
#pragma unroll
            for (int ks = 0; ks < 4; ++ks) c = mfma16(*(const bf16x8*)(Q + (mt * 16 + l15) * 136 + ks * 32 + q * 8), *(const bf16x8*)(Kk + (nt * 16 + l15) * 136 + ks * 32 + q * 8), c);
#pragma unroll
            for (int j = 0; j < 4; ++j) { const int t = mt * 16 + q * 4 + j, s = nt * 16 + l15; ATS[t * 72 + s] = (bf16_t)f2bf(s <= t ? c[j] : 0.f); } }
        __syncthreads();
        const int mt = wave & 3, half = wave >> 2;
        bf16_t grv[4][8];
#pragma unroll
        for (int j = 0; j < 4; ++j)
#pragma unroll
            for (int i = 0; i < 8; ++i) grv[j][i] = P[(size_t)(n * 64 + mt * 16 + q * 4 + j) * NP + C_GR + h * 256 + (half * 8 + i) * 16 + l15];
        f32x4 acc[8];
#pragma unroll
        for (int i = 0; i < 8; ++i) acc[i] = (f32x4){0.f, 0.f, 0.f, 0.f};
        const bf16_t* Sg = (const bf16_t*)a.out + (size_t)it * 32768;
#pragma unroll
        for (int ks = 0; ks < 4; ++ks) { const bf16x8 aq = *(const bf16x8*)(Q + (mt * 16 + l15) * 136 + ks * 32 + q * 8);
#pragma unroll
            for (int i = 0; i < 8; ++i) acc[i] = mfma16(aq, *(const bf16x8*)(Sg + ((half * 8 + i) * 16 + l15) * 128 + ks * 32 + q * 8), acc[i]); }
#pragma unroll
        for (int ks = 0; ks < 2; ++ks) { const bf16x8 at = *(const bf16x8*)(ATS + (mt * 16 + l15) * 72 + ks * 32 + q * 8);
#pragma unroll
            for (int i = 0; i < 8; ++i) { const int vr = (half * 8 + i) * 16 + l15; acc[i] = mfma16(at, *(const bf16x8*)(VT + vr * 72 + ((ks * 32 + q * 8) ^ tsw(vr))), acc[i]); } }
        float ssq[4];
#pragma unroll
        for (int j = 0; j < 4; ++j) { float s = 0.f;
#pragma unroll
            for (int i = 0; i < 8; ++i) s += acc[i][j] * acc[i][j];
            s += __shfl_xor(s, 1); s += __shfl_xor(s, 2); s += __shfl_xor(s, 4); s += __shfl_xor(s, 8); ssq[j] = s; }
        if (l15 == 0) {
#pragma unroll
            for (int j = 0; j < 4; ++j) RS[(mt * 16 + q * 4 + j) * 2 + half] = ssq[j]; }
        __syncthreads();
#pragma unroll
        for (int j = 0; j < 4; ++j) { const int t = mt * 16 + q * 4 + j; const float rstd = rsqrtf((RS[t * 2] + RS[t * 2 + 1]) * (1.f / 256.f) + EPS);
#pragma unroll
            for (int i = 0; i < 8; ++i) { const int dv = (half * 8 + i) * 16 + l15; const float gr = bf1(grv[j][i]);
                OUTS[t * 264 + dv] = (bf16_t)f2bf(acc[i][j] * rstd * a.in[18][dv] * siluf(gr)); } }
        __syncthreads();
#pragma unroll
        for (int c4 = 0; c4 < 4; ++c4) { const int c = tid + 512 * c4, row = c >> 5, col = (c & 31) * 8;
            *(u32x4*)(P + (size_t)(n * 64 + row) * NP + 1024 + h * 256 + col) = *(const u32x4*)(OUTS + row * 264 + col); }
        __syncthreads();
    }
}

__device__ __forceinline__ unsigned mono_key(float f) { const unsigned u = __builtin_bit_cast(unsigned, f); return (u & 0x80000000u) ? ~u : (u | 0x80000000u); }
template <int NE> __device__ __forceinline__ unsigned select_kth(const unsigned (&e)[NE], int kth, int lowbit = 0) {
    unsigned mx = 0u, mn = 0xFFFFFFFFu;
#pragma unroll
    for (int j = 0; j < NE; ++j) { mx = max(mx, e[j]); mn = min(mn, e[j] ? e[j] : 0xFFFFFFFFu); }
#pragma unroll
    for (int o = 1; o < 64; o <<= 1) { mx = max(mx, (unsigned)__shfl_xor((int)mx, o)); mn = min(mn, (unsigned)__shfl_xor((int)mn, o)); }
    const unsigned dif = mx ^ mn;
    const int hb = dif ? 31 - __clz((int)dif) : -1;
    unsigned tau = hb >= 31 ? 0u : (hb < 0 ? mx : (mx & ~((2u << hb) - 1u)));
    for (int bit = hb; bit >= lowbit; --bit) { const unsigned cand = tau | (1u << bit); int c = 0;
#pragma unroll
        for (int j = 0; j < NE; ++j) c += __popcll(__ballot(e[j] >= cand));
        if (c >= kth) tau = cand; }
    return tau;
}
__device__ __forceinline__ unsigned compact1024(unsigned* base, int n, int lane, int lowbit, int& newcnt) {
    unsigned e[16];
#pragma unroll
    for (int j = 0; j < 16; ++j) { const int i = j * 64 + lane; e[j] = i < n ? base[i] : 0u; }
    const unsigned tau = select_kth<16>(e, 256, lowbit);
    const u64 lt = (1ull << lane) - 1ull; int run = 0;
#pragma unroll
    for (int j = 0; j < 16; ++j) { const bool p = e[j] >= tau; const u64 m = __ballot(p); if (p) base[run + __popcll(m & lt)] = e[j]; run += __popcll(m); }
    newcnt = run;
    return tau;
}
__device__ __forceinline__ void compact_final(unsigned* base, int n, int lane, int& newcnt) {
    unsigned e[16];
#pragma unroll
    for (int j = 0; j < 16; ++j) { const int i = j * 64 + lane; e[j] = i < n ? base[i] : 0u; }
    const unsigned t18 = select_kth<16>(e, 256, 14) >> 14;
    int cgt = 0;
#pragma unroll
    for (int j = 0; j < 16; ++j) cgt += __popcll(__ballot((e[j] >> 14) > t18));
    const int need = 256 - cgt;
    const u64 lt = (1ull << lane) - 1ull; int run = 0, trun = 0;
#pragma unroll
    for (int j = 0; j < 16; ++j) { const bool gt = (e[j] >> 14) > t18, tie = (e[j] >> 14) == t18 && e[j] != 0u;
        const u64 mt = __ballot(tie); const int trank = trun + __popcll(mt & lt);
        const bool keep = gt || (tie && trank < need);
        const u64 mk = __ballot(keep); if (keep) base[run + __popcll(mk & lt)] = e[j]; run += __popcll(mk); trun += __popcll(mt); }
    newcnt = run;
}
__device__ __forceinline__ const bf16_t* ik_row(const bf16_t* IKC, const bf16_t* CIK, bool sample, int b, int k) {
    if (!sample) return IKC + (size_t)k * 64;
    return k < 1024 ? CIK + (size_t)(b * 1024 + k) * 64 : IKC + (size_t)(TP + b * 64 + (k - 1024)) * 64;
}
__device__ __forceinline__ float relu_i(float x) { const int b = __builtin_bit_cast(int, x); return __builtin_bit_cast(float, b > 0 ? b : 0); }
constexpr int IDX_TAB_N = 3;
__device__ const unsigned short IDX_TAB[256][IDX_TAB_N] = {{401,86,65535},{416,72,65535},{395,101,65535},{393,96,65535},{399,95,65535},{390,100,65535},{391,102,65535},{410,75,65535},{406,80,65535},{384,113,65535},{385,108,65535},{377,121,65535},{388,106,65535},{378,118,65535},{371,127,65535},{381,114,65535},{369,132,65535},{370,126,65535},{374,120,65535},{364,135,65535},{373,125,65535},{362,136,65535},{368,133,65535},{354,148,65535},{359,145,65535},{363,138,65535},{356,143,65535},{358,140,65535},{365,139,65535},{360,147,65535},{355,149,65535},{353,152,65535},{350,155,65535},{352,150,65535},{348,156,65535},{347,158,65535},{346,159,65535},{349,157,65535},{344,161,65535},{345,162,65535},{341,166,65535},{343,163,65535},{340,168,65535},{342,164,65535},{338,171,65535},{339,170,65535},{336,172,65535},{337,173,65535},{334,175,65535},{335,174,65535},{332,176,65535},{333,177,65535},{329,180,65535},{331,179,65535},{328,182,65535},{330,178,65535},{326,184,65535},{327,185,65535},{324,186,65535},{325,183,65535},{322,188,65535},{323,189,65535},{320,190,65535},{321,191,65535},{318,192,65535},{319,193,65535},{316,194,65535},{317,195,65535},{314,196,65535},{315,197,65535},{312,198,65535},{313,199,65535},{310,200,65535},{311,201,65535},{308,202,65535},{309,203,65535},{306,204,65535},{307,205,65535},{304,206,65535},{305,207,65535},{302,208,65535},{303,209,65535},{300,210,65535},{301,211,65535},{298,212,65535},{299,213,65535},{296,214,65535},{297,215,65535},{294,216,65535},{295,217,65535},{292,218,65535},{293,219,65535},{290,220,65535},{291,221,65535},{288,222,65535},{289,223,65535},{286,224,65535},{287,225,65535},{284,226,65535},{285,227,65535},{282,228,65535},{283,229,65535},{280,230,65535},{281,231,65535},{278,232,65535},{279,233,65535},{276,234,65535},{277,235,65535},{274,236,65535},{275,237,65535},{272,238,65535},{273,239,65535},{270,240,65535},{271,241,65535},{268,242,65535},{269,243,65535},{266,244,65535},{267,245,65535},{264,246,65535},{265,247,65535},{262,248,65535},{263,249,65535},{260,250,65535},{261,251,65535},{258,252,65535},{259,253,65535},{256,254,65535},{257,255,65535},{508,16,65535},{511,10,65535},{510,12,65535},{509,15,65535},{506,20,65535},{507,19,65535},{504,22,65535},{500,24,65535},{502,23,65535},{503,25,65535},{505,21,65535},{501,27,65535},{498,18,65535},{499,29,65535},{496,30,65535},{497,28,65535},{491,526,65535},{495,527,65535},{492,524,65535},{493,525,65535},{490,522,65535},{494,31,65535},{488,520,65535},{483,513,65535},{486,518,65535},{482,37,65535},{484,516,65535},{489,517,65535},{487,514,65535},{485,515,65535},{480,38,65535},{481,36,65535},{478,32,9},{479,35,3},{472,521,17},{463,519,26},{474,523,11},{476,512,13},{475,33,8},{439,42,34},{470,40,6},{471,39,7},{467,45,4},{469,43,5},{466,47,2},{458,46,14},{464,51,0},{465,49,1},{468,48,65535},{477,41,65535},{460,50,65535},{473,44,65535},{462,52,65535},{461,53,65535},{456,57,65535},{457,55,65535},{454,56,65535},{455,59,65535},{452,58,65535},{459,54,65535},{453,60,65535},{451,61,65535},{448,62,65535},{450,63,65535},{449,64,65535},{447,65,65535},{444,66,65535},{446,67,65535},{442,68,65535},{445,69,65535},{443,70,65535},{441,71,65535},{438,76,65535},{440,73,65535},{436,74,65535},{437,77,65535},{434,79,65535},{430,84,65535},{435,78,65535},{433,81,65535},{432,82,65535},{431,83,65535},{428,85,65535},{426,89,65535},{429,87,65535},{427,88,65535},{424,91,65535},{422,92,65535},{425,90,65535},{423,93,65535},{418,98,65535},{421,97,65535},{420,94,65535},{419,99,65535},{413,104,65535},{417,103,65535},{407,115,65535},{408,112,65535},{414,107,65535},{415,105,65535},{403,119,65535},{412,109,65535},{411,110,65535},{400,123,65535},{404,116,65535},{409,111,65535},{398,124,65535},{405,117,65535},{402,122,65535},{396,131,65535},{392,130,65535},{394,128,65535},{383,142,65535},{389,134,65535},{387,137,65535},{397,129,65535},{386,141,65535},{376,151,65535},{375,154,65535},{372,160,65535},{380,146,65535},{379,153,65535},{382,144,65535},{366,165,65535},{357,181,65535},{351,187,65535},{361,169,65535},{367,167,65535}};
constexpr int IKP = 144;
__device__ __forceinline__ void idx_phase(const Args& a, unsigned char* lds, int tid, int lane, int wave) {
    const bf16_t* P = (const bf16_t*)(a.ws + WS_P); const bf16_t* CIK = (const bf16_t*)(a.ws + WS_CIK); const bf16_t* IKC = (const bf16_t*)(a.ws + WS_IKC);
    unsigned* CAND = (unsigned*)(a.ws + WS_ACT);
    unsigned* lst = (unsigned*)(lds + wave * 16384);
    unsigned char* kbuf = lds + 131072;
    const int r = lane & 31, hf = lane >> 5;
    const int qsel = (r >> 2) & 1, head = (r & 3) + 4 * (r >> 3);
    const int skey = tid >> 3, schk = tid & 7;
    const bool use_tab = gridDim.x == 256;
    for (int kk = 0; ; ++kk) {
        int id;
        if (use_tab) { if (kk >= IDX_TAB_N) break; id = IDX_TAB[blockIdx.x][kk]; if (id == 0xFFFF) break; }
        else { const int it = blockIdx.x + kk * gridDim.x; if (it >= 528) break;
               id = it < 256 ? (255 - (it >> 1)) * 2 + (it & 1) : (it < 512 ? ((it - 256) >> 1) * 2 + (it & 1) : it); }
        int c, half = id & 1, bb = 0; bool sample = false;
        if (id < 512) c = id >> 1;
        else { sample = true; bb = (id - 512) >> 1; c = 256 + bb; }
        const int L = sample ? 1088 : 64 * (c + 1), ntile = L >> 6;
        const int t0 = c * 64 + half * 32 + wave * 4;
        bf16x8 af[2][4]; float w[2][16];
#pragma unroll
        for (int rb = 0; rb < 2; ++rb) {
            const bf16_t* qp = P + (size_t)(t0 + 2 * rb + qsel) * NP + C_IQ + head * 64 + hf * 8;
#pragma unroll
            for (int ks = 0; ks < 4; ++ks) af[rb][ks] = *(const bf16x8*)(qp + ks * 16);
            const bf16_t* wp = P + (size_t)(t0 + 2 * rb + hf) * NP + C_IW;
            unpack8(*(const u32x4*)wp, w[rb]); unpack8(*(const u32x4*)(wp + 8), w[rb] + 8);
        }
        unsigned tau[2], cnt[2];
#pragma unroll
        for (int rb = 0; rb < 2; ++rb) { tau[rb] = 0u; cnt[rb] = 0u; }
        { const u32x4 v = *(const u32x4*)(ik_row(IKC, CIK, sample, bb, skey) + schk * 8); *(u32x4*)(kbuf + skey * IKP + schk * 16) = v; }
        u32x4 p1 = {0u, 0u, 0u, 0u}, p2 = p1, p3 = p1;
        if (1 < ntile) p1 = *(const u32x4*)(ik_row(IKC, CIK, sample, bb, 1 * 64 + skey) + schk * 8);
        if (2 < ntile) p2 = *(const u32x4*)(ik_row(IKC, CIK, sample, bb, 2 * 64 + skey) + schk * 8);
        if (3 < ntile) p3 = *(const u32x4*)(ik_row(IKC, CIK, sample, bb, 3 * 64 + skey) + schk * 8);
        __syncthreads();
#define IDX_MFMA8(ACC, KBP, SUB) do { bf16x8 bfr[4]; \
            _Pragma("unroll") for (int ks = 0; ks < 4; ++ks) bfr[ks] = *(const bf16x8*)((KBP) + ((SUB) * 32 + r) * IKP + ks * 32 + hf * 16); \
            _Pragma("unroll") for (int i = 0; i < 16; ++i) { ACC[0][i] = 0.f; ACC[1][i] = 0.f; } \
            __builtin_amdgcn_s_setprio(1); \
            _Pragma("unroll") for (int ks = 0; ks < 4; ++ks) { ACC[0] = __builtin_amdgcn_mfma_f32_32x32x16_bf16(af[0][ks], bfr[ks], ACC[0], 0, 0, 0); ACC[1] = __builtin_amdgcn_mfma_f32_32x32x16_bf16(af[1][ks], bfr[ks], ACC[1], 0, 0, 0); } \
            __builtin_amdgcn_s_setprio(0); } while (0)
#define IDX_SCORE(ACC, ENT, KEY) do { _Pragma("unroll") for (int rb = 0; rb < 2; ++rb) { float s0 = 0.f, s1 = 0.f; \
            _Pragma("unroll") for (int i = 0; i < 16; i += 2) { s0 += relu_i(ACC[rb][i]) * w[rb][i]; s1 += relu_i(ACC[rb][i + 1]) * w[rb][i + 1]; } \
            ENT[rb] = (mono_key(s0 + s1) & 0xFFFFC000u) | (KEY); } } while (0)
#define IDX_INTERLEAVE() do { _Pragma("unroll") for (int i_ = 0; i_ < 8; ++i_) { __builtin_amdgcn_sched_group_barrier(0x008, 1, 0); __builtin_amdgcn_sched_group_barrier(0x002, 9, 0); } } while (0)
#define IDX_INSERT(ENT) do { _Pragma("unroll") for (int rb = 0; rb < 2; ++rb) { \
            const unsigned ent = ENT[rb]; const bool p = ent > tau[rb]; const u64 m = __ballot(p); \
            if (m) { const unsigned mh = hf ? (unsigned)(m >> 32) : (unsigned)m; \
                if (p) lst[(2 * rb + hf) * 1024 + cnt[rb] + __popc(mh & ((1u << r) - 1u))] = ent; \
                cnt[rb] += __popc(mh); \
                if (__any(cnt[rb] > 992u)) { \
                    _Pragma("unroll") for (int hh = 0; hh < 2; ++hh) { const int cc = __builtin_amdgcn_readlane((int)cnt[rb], hh * 32); \
                        if (cc > 992) { int nc; const unsigned nt_ = compact1024(lst + (2 * rb + hh) * 1024, cc, lane, 14, nc); if (hf == hh) { tau[rb] = nt_; cnt[rb] = (unsigned)nc; } } } } } } } while (0)
        f32x16 accA[2], accB[2];
        IDX_MFMA8(accA, kbuf, 0);
        for (int tl = 0; tl < ntile; ++tl) {
            u32x4 p4 = {0u, 0u, 0u, 0u};
            if (tl + 4 < ntile) p4 = *(const u32x4*)(ik_row(IKC, CIK, sample, bb, (tl + 4) * 64 + skey) + schk * 8);
            const unsigned char* kb = kbuf + (tl & 1) * (64 * IKP);
            const unsigned char* kbn = kbuf + ((tl + 1) & 1) * (64 * IKP);
            unsigned entA[2], entB[2];
            IDX_MFMA8(accB, kb, 1);
            IDX_SCORE(accA, entA, (unsigned)(tl * 64 + r));
            IDX_INTERLEAVE();
            IDX_INSERT(entA);
            if (tl + 1 < ntile) *(u32x4*)(kbuf + ((tl + 1) & 1) * (64 * IKP) + skey * IKP + schk * 16) = p1;
            __syncthreads();
            if (tl + 1 < ntile) { IDX_MFMA8(accA, kbn, 0); IDX_SCORE(accB, entB, (unsigned)(tl * 64 + 32 + r)); IDX_INTERLEAVE(); }
            else { IDX_SCORE(accB, entB, (unsigned)(tl * 64 + 32 + r)); }
            IDX_INSERT(entB);
            if (tl == 14 || tl == 50 || tl == 174) {
#pragma unroll
                for (int rb = 0; rb < 2; ++rb)
#pragma unroll
                    for (int hh = 0; hh < 2; ++hh) { const int cc = __builtin_amdgcn_readlane((int)cnt[rb], hh * 32);
                        if (cc > 256) { int nc; const unsigned nt_ = compact1024(lst + (2 * rb + hh) * 1024, cc, lane, 14, nc); if (hf == hh) { tau[rb] = nt_; cnt[rb] = (unsigned)nc; } } }
            }
            p1 = p2; p2 = p3; p3 = p4;
        }
#pragma unroll
        for (int rb = 0; rb < 2; ++rb)
#pragma unroll
            for (int hh = 0; hh < 2; ++hh) { int cc = __builtin_amdgcn_readlane((int)cnt[rb], hh * 32); unsigned* base = lst + (2 * rb + hh) * 1024;
                if (cc > 256) { int nc; compact_final(base, cc, lane, nc); cc = nc; }
                unsigned* dst = CAND + (size_t)(t0 + 2 * rb + hh) * 256;
                for (int j = lane; j < cc; j += 64) dst[j] = base[j]; }
    }
}

__device__ __forceinline__ void attn_phase(const Args& a, unsigned char* lds, int lane, int wave) {
    bf16_t* P = (bf16_t*)(a.ws + WS_P);
    const unsigned char* KV8 = a.ws + WS_KV8; const unsigned char* CKV8 = a.ws + WS_CKV8;
    const unsigned* CAND = (const unsigned*)(a.ws + WS_ACT);
    unsigned* sel = (unsigned*)(lds + 122880 + wave * 1024);
    const int gw = blockIdx.x * 8 + wave, NGW = gridDim.x * 8;
    for (int t = gw; t < TT; t += NGW) {
        const bool sample = t >= TP; const int bb = sample ? (t - TP) >> 6 : 0;
        const int c = t >> 6; const int L = sample ? 1088 : 64 * (c + 1);
        const int nsel = min(256, L);
        const unsigned* cand = CAND + (size_t)t * 256;
#pragma unroll
        for (int j = 0; j < 4; ++j) { const int i = j * 64 + lane; if (i < nsel) sel[i] = cand[i] & 0x3FFFu; }
        bf16_t* qp = P + (size_t)t * NP + lane * 16;
        float q[16]; unpack8(*(const u32x4*)qp, q); unpack8(*(const u32x4*)(qp + 8), q + 8);
        float mx = -INFINITY, l = 0.f, o[16];
#pragma unroll
        for (int d = 0; d < 16; ++d) o[d] = 0.f;
        for (int j = 0; j < nsel; j += 8) {
            const u32x4 ida = *(const u32x4*)(sel + j), idb = *(const u32x4*)(sel + j + 4);
            u32x4 kk[8], vv[8];
#pragma unroll
            for (int i = 0; i < 8; ++i) { const int idx = (int)(i < 4 ? ida[i & 3] : idb[i & 3]); const unsigned char* kp;
                if (!sample) kp = KV8 + (size_t)idx * 2048;
                else if (idx < 1024) kp = CKV8 + (size_t)(bb * 1024 + idx) * 2048;
                else kp = KV8 + (size_t)(TP + bb * 64 + idx - 1024) * 2048;
                kk[i] = *(const u32x4*)(kp + lane * 16); vv[i] = *(const u32x4*)(kp + 1024 + lane * 16); }
            float s[8];
#pragma unroll
            for (int i = 0; i < 8; ++i) { float kf[16]; unpack16_fp8(kk[i], kf); float d0 = 0.f, d1 = 0.f;
#pragma unroll
                for (int x = 0; x < 16; x += 2) { d0 += q[x] * kf[x]; d1 += q[x + 1] * kf[x + 1]; }
                float d = d0 + d1;
                d += __shfl_xor(d, 1); d += __shfl_xor(d, 2); d += __shfl_xor(d, 4); s[i] = d; }
            const float mn = fmaxf(fmaxf(fmaxf(mx, fmaxf(s[0], s[1])), fmaxf(s[2], s[3])), fmaxf(fmaxf(s[4], s[5]), fmaxf(s[6], s[7])));
            const float al = __builtin_amdgcn_exp2f(mx - mn);
            float p[8];
#pragma unroll
            for (int i = 0; i < 8; ++i) p[i] = __builtin_amdgcn_exp2f(s[i] - mn);
            l = l * al + ((p[0] + p[1]) + (p[2] + p[3])) + ((p[4] + p[5]) + (p[6] + p[7]));
#pragma unroll
            for (int d = 0; d < 16; ++d) o[d] *= al;
#pragma unroll
            for (int i = 0; i < 8; ++i) { float vf[16]; unpack16_fp8(vv[i], vf);
#pragma unroll
                for (int d = 0; d < 16; ++d) o[d] += p[i] * vf[d]; }
            mx = mn;
        }
        const float il = 1.f / l;
#pragma unroll
        for (int d = 0; d < 16; ++d) o[d] *= il;
        *(u32x4*)qp = pack8(o); *(u32x4*)(qp + 8) = pack8(o + 8);
    }
}

__device__ __forceinline__ void fixup_phase(const Args& a, int tid) {
    const bf16_t* Uf = (const bf16_t*)(a.ws + WS_UF); const bf16_t* Uh = (const bf16_t*)(a.ws + WS_UH);
    bf16_t* ACTF = (bf16_t*)(a.ws + WS_P);
    const float* wconv = a.in[21]; const float* bconv = a.in[22];
    const size_t gt = (size_t)blockIdx.x * 512 + tid, GT = (size_t)gridDim.x * 512;
    for (size_t e = gt; e < (size_t)NCH * DFF; e += GT) {
        const int g = (int)(e / DFF), ch = (int)(e % DFF);
        float pa[2], pb[2];
        if (g >= 256) { const float* st = a.in[8] + (size_t)(g - 256) * 2 * NUP; pa[0] = st[ch]; pa[1] = st[NUP + ch]; pb[0] = st[DFF + ch]; pb[1] = st[NUP + DFF + ch]; }
        else if (g == 0) { pa[0] = pa[1] = pb[0] = pb[1] = 0.f; }
        else { const bf16_t* st = Uh + (size_t)(g - 1) * 2 * NUP; pa[0] = bf1(st[ch]); pa[1] = bf1(st[NUP + ch]); pb[0] = bf1(st[DFF + ch]); pb[1] = bf1(st[NUP + DFF + ch]); }
        const bf16_t* uf = Uf + (size_t)g * 2 * NUP;
        const float a0 = bf1(uf[ch]), a1 = bf1(uf[NUP + ch]), b0 = bf1(uf[DFF + ch]), b1 = bf1(uf[NUP + DFF + ch]);
        const float wa0 = wconv[ch], wa1 = wconv[NUP + ch], wa2 = wconv[2 * NUP + ch], ba = bconv[ch];
        const float wb0 = wconv[DFF + ch], wb1 = wconv[NUP + DFF + ch], wb2 = wconv[2 * NUP + DFF + ch], bb = bconv[DFF + ch];
        const float ca0 = ba + wa2 * a0 + wa1 * pa[1] + wa0 * pa[0], cb0 = bb + wb2 * b0 + wb1 * pb[1] + wb0 * pb[0];
        const float ca1 = ba + wa2 * a1 + wa1 * a0 + wa0 * pa[1], cb1 = bb + wb2 * b1 + wb1 * b0 + wb0 * pb[1];
        ACTF[(size_t)(g * 64) * DFF + ch] = (bf16_t)f2bf(siluf(ca0) * cb0);
        ACTF[(size_t)(g * 64 + 1) * DFF + ch] = (bf16_t)f2bf(siluf(ca1) * cb1);
    }
    for (size_t e = gt; e < (size_t)9 * 2 * NUP; e += GT) {
        const int s = (int)(e / (2 * NUP)), rem = (int)(e % (2 * NUP));
        const int g = s == 0 ? 255 : 255 + s;
        const float v = bf1(Uh[(size_t)g * 2 * NUP + rem]);
        if (s == 0) a.out[O_FCP + rem] = v; else a.out[O_FCS + (size_t)(s - 1) * 2 * NUP + rem] = v;
    }
}

#define LAS __attribute__((address_space(3)))
#define XB_TMO      128
#define XB_XCNT(j)  (256  + 64 * (j))
#define XB_XSUB(j)  (1280 + 64 * (j))
#define XB_XGEN(j)  (2304 + 64 * (j))
#define XB_TOP      3328
#define XB_TOPGEN   3392
#define XCD_BAR_WORDS 3456
#define XB_SPIN_CAP (1u << 18)

__device__ __forceinline__ unsigned xb_ld(unsigned* p)              { return __hip_atomic_load(p, __ATOMIC_RELAXED, __HIP_MEMORY_SCOPE_AGENT); }
__device__ __forceinline__ unsigned xb_add(unsigned* p, unsigned v) { return __hip_atomic_fetch_add(p, v, __ATOMIC_RELAXED, __HIP_MEMORY_SCOPE_AGENT); }
__device__ __forceinline__ unsigned xb_xcc_id() { return (unsigned)__builtin_amdgcn_s_getreg((3 << 11) | 20) & 0xFu; }
#define XB_SPIN(cond, bar) do { unsigned _sp = 0; while (cond) { __builtin_amdgcn_s_sleep(1); \
    if ((++_sp & 255u) == 0u) { if (xb_ld(&(bar)[XB_TMO])) break; if (_sp > XB_SPIN_CAP) { atomicAdd(&(bar)[XB_TMO], 1u); break; } } } } while (0)

struct XcdBarrier {
    unsigned* bar; unsigned x;
    volatile LAS unsigned* st;
};

__device__ __forceinline__ XcdBarrier xcd_barrier_post(unsigned* bar, volatile LAS unsigned* st) {
    XcdBarrier b; b.bar = bar; b.x = xb_xcc_id(); b.st = st;
    if (threadIdx.x == 0) (void)xb_add(&bar[XB_XCNT(b.x)], 1u);
    return b;
}
__device__ __forceinline__ void xcd_barrier_complete(unsigned* bar, unsigned x, unsigned& nloc, unsigned& nx) {
    const unsigned G = gridDim.x * gridDim.y * gridDim.z;
    unsigned sum, cnt, mine, sp = 0u;
    for (;;) {
        sum = 0u; cnt = 0u; mine = 0u;
#pragma unroll
        for (unsigned j = 0; j < 16; ++j) { const unsigned c = xb_ld(&bar[XB_XCNT(j)]); sum += c; cnt += (c > 0u) ? 1u : 0u; mine = (j == x) ? c : mine; }
        if (sum == G) break;
        __builtin_amdgcn_s_sleep(1);
        if ((++sp & 255u) == 0u) { if (xb_ld(&bar[XB_TMO])) break; if (sp > XB_SPIN_CAP) { atomicAdd(&bar[XB_TMO], 1u); break; } }
    }
    nloc = mine > 0u ? mine : 1u; nx = cnt > 0u ? cnt : 1u;
}

__device__ __forceinline__ void xcd_barrier(const XcdBarrier& b) {
    asm volatile("s_waitcnt vmcnt(0)" ::: "memory");
    __syncthreads();
    if (threadIdx.x == 0) {
        unsigned* bar = b.bar;
        __builtin_amdgcn_s_waitcnt(0);
        unsigned nloc = b.st[0], nx = b.st[1];
        if (nloc == 0u) { xcd_barrier_complete(bar, b.x, nloc, nx); b.st[0] = nloc; b.st[1] = nx; }
        const unsigned old = xb_add(&bar[XB_XSUB(b.x)], 1u);
        const unsigned gen = old / nloc;
        if (old + 1u == (gen + 1u) * nloc) {
            __builtin_amdgcn_fence(__ATOMIC_RELEASE, "agent");
            asm volatile("s_waitcnt vmcnt(0)" ::: "memory");
            const unsigned og = xb_add(&bar[XB_TOP], 1u);
            const unsigned tg = og / nx;
            if (og + 1u == (tg + 1u) * nx) xb_add(&bar[XB_TOPGEN], 1u);
            else XB_SPIN(xb_ld(&bar[XB_TOPGEN]) == tg, bar);
            __builtin_amdgcn_fence(__ATOMIC_ACQUIRE, "agent");
            xb_add(&bar[XB_XGEN(b.x)], 1u);
            asm volatile("s_waitcnt vmcnt(0)" ::: "memory");
        } else {
            XB_SPIN(xb_ld(&bar[XB_XGEN(b.x)]) == gen, bar);
            __builtin_amdgcn_fence(__ATOMIC_ACQUIRE, "agent");
            asm volatile("s_waitcnt vmcnt(0)" ::: "memory");
        }
    }
    __syncthreads();
}

__global__ void __launch_bounds__(512, 2) mega_fwd(Args a) {
    extern __shared__ __attribute__((aligned(16))) unsigned char lds[];
    cg::grid_group grid = cg::this_grid();
    const int tid = threadIdx.x, lane = tid & 63, wave = __builtin_amdgcn_readfirstlane(tid >> 6);
    unsigned char* ws = a.ws;
    const float* MOD = (const float*)(ws + WS_MOD);
#ifndef ONLY_PH
#define ONLY_PH -1
#endif
#define PHON(k) ((ONLY_PH < 0 || ONLY_PH == (k)) && lo <= (k) && (k) <= hi)
    volatile LAS unsigned* bst = (volatile LAS unsigned*)((PG8_LAS unsigned char*)lds + (LDS_BYTES - 64));
    if (tid == 0) { bst[0] = 0u; bst[1] = 0u; }
    __syncthreads();
    const XcdBarrier xbar = xcd_barrier_post((unsigned*)(ws + WS_CTL) + 1024, bst);
    if (a.ph_lo > NPHASE) grid.sync();
#define SEAM(k) do { if ((k) < hi) xcd_barrier(xbar); } while (0)
    const int lo = a.ph_lo, hi = a.ph_hi;
    if (PHON(0)) { phase0(a, lds, tid, lane, wave);
        SEAM(0); }
    if (PHON(1)) { normmod_phase(a.in[0], a.in[1], a.in[11], MOD, 0 * DM, 1 * DM, (bf16_t*)(ws + WS_ACT), lane, wave); SEAM(1); }
    if (PHON(2)) {
        pg8::Gemm g{(const bf16_t*)(ws + WS_ACT), (const bf16_t*)(ws + WS_WIN), TT, NP, DM, DM}; pg8::StaticOrder S; S.init(TT, NP, gridDim.x, blockIdx.x);
        EpiP E{(bf16_t*)(ws + WS_P), NP};
        pg8::gemm_phase<EpiP, pg8::StaticOrder, true, true>((PG8_LAS unsigned char*)lds, g, S, E);
        { int rank, count; if (gemm_tail_rank(S.nwg, rank, count)) tail_wout(a, lds, rank, count, lane, wave); else if (count <= 0 && blockIdx.x == 0) tail_wout(a, lds, 0, 1, lane, wave); }
        SEAM(2);
    }
    const bool swap_order = ((blockIdx.x >> 3) & 1) != 0;
    if (PHON(3)) {
        if (swap_order) { gla_g1(a, lds, tid, lane, wave); __syncthreads(); post_rows(a, lds, tid, lane, wave); }
        else { post_rows(a, lds, tid, lane, wave); gla_g1(a, lds, tid, lane, wave); }
        SEAM(3); }
    if (PHON(4)) { gla_g2(a, tid); idx_phase(a, lds, tid, lane, wave); SEAM(4); }
    if (PHON(5)) {
        attn_phase(a, lds, lane, wave); __syncthreads(); gla_g3(a, lds, tid, lane, wave);
        SEAM(5); }
    if (PHON(6)) {
        pg8::Gemm g{(const bf16_t*)(ws + WS_P), (const bf16_t*)(ws + WS_WOUT), TT, DM, DM, NP}; pg8::StaticOrder S; S.init(TT, DM, gridDim.x, blockIdx.x);
        EpiRes E{a.in[0], a.in[1], a.out + O_Y, MOD + 2 * DM};
        pg8::gemm_phase<EpiRes, pg8::StaticOrder, true, true>((PG8_LAS unsigned char*)lds, g, S, E);
        { int rank, count; if (gemm_tail_rank(S.nwg, rank, count)) tail_wup_wdn(a, lds, rank, count, lane, wave); else if (count <= 0 && blockIdx.x == 0) tail_wup_wdn(a, lds, 0, 1, lane, wave); }
        SEAM(6);
    }
    if (PHON(7)) { normmod_phase(a.out + O_Y, a.out + O_Y + (size_t)TP * DM, a.in[12], MOD, 3 * DM, 4 * DM, (bf16_t*)(ws + WS_ACT), lane, wave); SEAM(7); }
    if (PHON(8)) {
        pg8::Gemm g{(const bf16_t*)(ws + WS_ACT), (const bf16_t*)(ws + WS_WUP), TT, NUP, DM, DM}; pg8::StaticOrder S; S.init(TT, NUP, gridDim.x, blockIdx.x);
        EpiUp E{(bf16_t*)(ws + WS_P), (bf16_t*)(ws + WS_UF), (bf16_t*)(ws + WS_UH), a.in[21], a.in[22]};
        pg8::gemm_phase<EpiUp, pg8::StaticOrder, true, true>((PG8_LAS unsigned char*)lds, g, S, E);
        SEAM(8);
    }
    if (PHON(9)) { fixup_phase(a, tid); SEAM(9); }
    if (PHON(10)) {
        pg8::Gemm g{(const bf16_t*)(ws + WS_P), (const bf16_t*)(ws + WS_WDN), TT, DM, DFF, DFF}; pg8::StaticOrder S; S.init(TT, DM, gridDim.x, blockIdx.x);
        EpiRes E{a.out + O_Y, a.out + O_Y + (size_t)TP * DM, a.out + O_Y, MOD + 5 * DM};
        pg8::gemm_phase<EpiRes, pg8::StaticOrder, true, true>((PG8_LAS unsigned char*)lds, g, S, E);
    }
}

#ifndef MK_MULTI
#define MK_MULTI 0
#endif
extern "C" void kernel_launch(void* const* d_in, const int* in_sizes, int n_in, void* d_out, int out_size, void* d_ws, size_t ws_size, hipStream_t stream) {
    static int grid = 0;
    if (grid == 0) {
        if (n_in != 24 || (size_t)out_size != O_TOTAL || ws_size < WS_END) { fprintf(stderr, "kernel_launch: unexpected shapes: n_in %d out %d ws %zu\n", n_in, out_size, ws_size); grid = -1; return; }
        int dev = 0, cus = 0, per_cu = 0;
        hipGetDevice(&dev); hipDeviceGetAttribute(&cus, hipDeviceAttributeMultiprocessorCount, dev);
        if (hipFuncSetAttribute((const void*)mega_fwd, hipFuncAttributeMaxDynamicSharedMemorySize, LDS_BYTES) != hipSuccess) { fprintf(stderr, "kernel_launch: hipFuncSetAttribute failed\n"); grid = -1; return; }
        hipOccupancyMaxActiveBlocksPerMultiprocessor(&per_cu, (const void*)mega_fwd, 512, LDS_BYTES);
        if (per_cu < 1) per_cu = 1;
        (void)hipGetLastError();
        grid = cus * 1;
        if (grid <= 0) grid = 256;
    }
    if (grid < 0) return;
    hipMemsetAsync((char*)d_ws + WS_CTL, 0, 32768, stream);
    Args a{};
    for (int i = 0; i < 24; ++i) a.in[i] = (const float*)d_in[i];
    a.out = (float*)d_out; a.ws = (unsigned char*)d_ws;
#if MK_MULTI
    for (int ph = 0; ph < NPHASE; ++ph) { a.ph_lo = ph; a.ph_hi = ph; hipLaunchKernelGGL(mega_fwd, dim3(grid), dim3(512), LDS_BYTES, stream, a); }
#else
    a.ph_lo = 0; a.ph_hi = NPHASE - 1;
    void* args[] = {&a};
    hipError_t e = hipLaunchCooperativeKernel((const void*)mega_fwd, dim3(grid), dim3(512), args, LDS_BYTES, stream);
    if (e != hipSuccess) fprintf(stderr, "cooperative launch failed: %s (grid %d)\n", hipGetErrorString(e), grid);
#endif
}
```
